# Optimizing an MI355X kernel written in HIP

```python
import jax, jax.numpy as jnp
from jax import lax
import numpy as np

D_MODEL = 1024
BATCH = 8
SEQ = 2048
DEPTH = 1

NSA_HEADS = 8
NSA_KV_GROUPS = 2
NSA_HEAD_DIM = 64
CMP_BLOCK = 32
CMP_STRIDE = 16
CMP_HIDDEN = 128
SEL_BLOCK = 64
SEL_TOPK = 8
WINDOW = 512
Q_BLOCK = 128
GLA_HEADS = 4
GLA_DK = 64
GLA_DV = 128
GLA_CHUNK = 64
GLA_LOWRANK = 16
GLA_TAU = 16.0
D_FF = 2816
EPS = 1e-6
NEG_INF = -1e30
FORCE = 1e9

NSA_Q_W = NSA_HEADS * NSA_HEAD_DIM
NSA_KV_W = NSA_KV_GROUPS * NSA_HEAD_DIM
GLA_K_W = GLA_HEADS * GLA_DK
GLA_V_W = GLA_HEADS * GLA_DV
D_MIX = NSA_Q_W + GLA_V_W
IN_SPLITS = (NSA_Q_W, NSA_KV_W, NSA_KV_W, NSA_KV_W, NSA_KV_W, NSA_KV_W, NSA_KV_W, NSA_HEADS * 3, GLA_K_W, GLA_K_W, GLA_V_W, GLA_V_W, GLA_LOWRANK)
D_IN_PROJ = sum(IN_SPLITS)

kernel_name = 'nsa_gla_macaron_hybrid'


def rmsnorm(x, g):
    xf = x.astype(jnp.float32)
    y = xf * lax.rsqrt(jnp.mean(xf * xf, axis=-1, keepdims=True) + EPS)
    return (y * g.astype(jnp.float32)).astype(x.dtype)


def swiglu_ffn(x, w_gate, w_up, w_down):
    return (jax.nn.silu(x @ w_gate) * (x @ w_up)) @ w_down


def split_columns(y, sizes):
    offsets = [int(o) for o in np.cumsum(sizes)[:-1]]
    return jnp.split(y, offsets, axis=-1)


def compress_blocks(kv, pe, w1, w2):
    B, T, G, dh = kv.shape
    n_cmp = (T - CMP_BLOCK) // CMP_STRIDE + 1
    idx = jnp.arange(n_cmp)[:, None] * CMP_STRIDE + jnp.arange(CMP_BLOCK)[None, :]
    blocks = kv[:, idx] + pe[None, None, :, None, :]
    blocks = blocks.transpose(0, 1, 3, 2, 4).reshape(B, n_cmp, G, CMP_BLOCK * dh)
    return jax.nn.gelu(blocks @ w1) @ w2


def nsa_attention(q, k_cmp, v_cmp, k_slc, v_slc, k_win, v_win, gates, pe_k, w1_k, w2_k, pe_v, w1_v, w2_v):
    B, T, H, dh = q.shape
    G = NSA_KV_GROUPS
    R = H // G
    f32 = jnp.float32
    scale = dh ** -0.5
    slopes = jnp.exp2(-8.0 * jnp.arange(1, H + 1, dtype=f32) / H).reshape(G, R)

    kc = compress_blocks(k_cmp, pe_k, w1_k, w2_k)
    vc = compress_blocks(v_cmp, pe_v, w1_v, w2_v)
    n_cmp = kc.shape[1]
    cmp_start = jnp.arange(n_cmp, dtype=jnp.int32) * CMP_STRIDE
    cmp_end = cmp_start + CMP_BLOCK - 1
    cmp_center = cmp_start.astype(f32) + (CMP_BLOCK - 1) / 2.0

    n_sel_blocks = T // SEL_BLOCK
    top_n = min(SEL_TOPK, n_sel_blocks)
    sel_start = jnp.arange(n_sel_blocks, dtype=jnp.int32) * SEL_BLOCK
    overlap = ((cmp_start[:, None] < sel_start[None, :] + SEL_BLOCK)
               & (cmp_start[:, None] + CMP_BLOCK > sel_start[None, :])).astype(f32)
    k_blk = k_slc.reshape(B, n_sel_blocks, SEL_BLOCK, G, dh).transpose(0, 3, 1, 2, 4)
    v_blk = v_slc.reshape(B, n_sel_blocks, SEL_BLOCK, G, dh).transpose(0, 3, 1, 2, 4)

    k_pad = jnp.pad(k_win, ((0, 0), (WINDOW, 0), (0, 0), (0, 0)))
    v_pad = jnp.pad(v_win, ((0, 0), (WINDOW, 0), (0, 0), (0, 0)))

    n_qb = T // Q_BLOCK
    q_blocks = q.reshape(B, n_qb, Q_BLOCK, G, R, dh).transpose(1, 0, 2, 3, 4, 5)
    g_blocks = gates.reshape(B, n_qb, Q_BLOCK, G, R, 3).transpose(1, 0, 2, 3, 4, 5)
    b_ix = jnp.arange(B)[:, None, None, None]
    g_ix = jnp.arange(G)[None, :, None, None]
    win_off = jnp.arange(WINDOW + Q_BLOCK, dtype=jnp.int32) - WINDOW
    sel_off = jnp.arange(SEL_BLOCK, dtype=jnp.int32)
    j_blk = jnp.arange(n_sel_blocks, dtype=jnp.int32)

    def block_fn(args):
        qb, gb, blk = args
        t = blk * Q_BLOCK + jnp.arange(Q_BLOCK, dtype=jnp.int32)
        tf = t.astype(f32)
        qs = qb * scale

        s = jnp.einsum('bqgrd,bngd->bgrqn', qs, kc).astype(f32)
        s = s - slopes[:, :, None, None] * (tf[:, None] - cmp_center[None, :])
        valid_c = cmp_end[None, :] <= t[:, None]
        s = jnp.where(valid_c, s, NEG_INF)
        p_c = jax.nn.softmax(s, axis=-1) * valid_c
        o_cmp = jnp.einsum('bgrqn,bngd->bqgrd', p_c.astype(vc.dtype), vc)

        imp = jnp.einsum('bgrqn,ns->bgqs', p_c, overlap)
        cur = t // SEL_BLOCK
        forced = (j_blk[None, :] == 0) | (j_blk[None, :] == cur[:, None]) | (j_blk[None, :] == cur[:, None] - 1)
        causal_blk = j_blk[None, :] <= cur[:, None]
        imp = jnp.where(forced, FORCE, imp)
        imp = jnp.where(causal_blk, imp, -FORCE)
        _, sel = lax.top_k(imp, top_n)
        k_sel = k_blk[b_ix, g_ix, sel]
        v_sel = v_blk[b_ix, g_ix, sel]
        kpos = sel[..., None] * SEL_BLOCK + sel_off
        dist = t[None, None, :, None, None] - kpos
        s = jnp.einsum('bqgrd,bgqnkd->bgrqnk', qs, k_sel).astype(f32)
        s = s - slopes[None, :, :, None, None, None] * dist[:, :, None].astype(f32)
        s = jnp.where((dist >= 0)[:, :, None], s, NEG_INF)
        p_s = jax.nn.softmax(s.reshape(B, G, R, Q_BLOCK, top_n * SEL_BLOCK), axis=-1).reshape(s.shape)
        o_slc = jnp.einsum('bgrqnk,bgqnkd->bqgrd', p_s.astype(v_sel.dtype), v_sel)

        kw = lax.dynamic_slice_in_dim(k_pad, blk * Q_BLOCK, WINDOW + Q_BLOCK, axis=1)
        vw = lax.dynamic_slice_in_dim(v_pad, blk * Q_BLOCK, WINDOW + Q_BLOCK, axis=1)
        kpos_w = blk * Q_BLOCK + win_off
        dist_w = t[:, None] - kpos_w[None, :]
        mask_w = (dist_w >= 0) & (dist_w < WINDOW) & (kpos_w[None, :] >= 0)
        s = jnp.einsum('bqgrd,bkgd->bgrqk', qs, kw).astype(f32)
        s = s - slopes[:, :, None, None] * dist_w.astype(f32)
        s = jnp.where(mask_w, s, NEG_INF)
        p_w = jax.nn.softmax(s, axis=-1)
        o_win = jnp.einsum('bgrqk,bkgd->bqgrd', p_w.astype(vw.dtype), vw)

        o = gb[..., 0:1] * o_cmp + gb[..., 1:2] * o_slc + gb[..., 2:3] * o_win
        return o.reshape(B, Q_BLOCK, H * dh)

    out = lax.map(block_fn, (q_blocks, g_blocks, jnp.arange(n_qb, dtype=jnp.int32)))
    return out.transpose(1, 0, 2, 3).reshape(B, T, H * dh)


def gla_attention(q, k, v, log_a):
    B, T, Hh, dk = q.shape
    dv = v.shape[-1]
    C = GLA_CHUNK
    N = T // C
    f32 = jnp.float32

    def chunks(z):
        return z.astype(f32).reshape(B, N, C, Hh, z.shape[-1]).transpose(1, 0, 3, 2, 4)

    qc = chunks(q) * (dk ** -0.5)
    kc = chunks(k)
    vc = chunks(v)
    b = jnp.cumsum(chunks(log_a), axis=3)
    b_last = b[:, :, :, -1:]
    q_in = qc * jnp.exp(b)
    k_in = kc * jnp.exp(-b)
    k_st = kc * jnp.exp(b_last - b)
    tril = jnp.tril(jnp.ones((C, C), dtype=bool))
    A = jnp.where(tril, jnp.einsum('nbhid,nbhjd->nbhij', q_in, k_in), 0.0)
    o_intra = jnp.einsum('nbhij,nbhjv->nbhiv', A, vc)

    def step(S, xs):
        qi, ki, vi, bl = xs
        o = jnp.einsum('bhid,bhdv->bhiv', qi, S)
        S = S * jnp.exp(bl)[:, :, 0, :, None] + jnp.einsum('bhjd,bhjv->bhdv', ki, vi)
        return S, o

    S0 = jnp.zeros((B, Hh, dk, dv), f32)
    _, o_inter = lax.scan(step, S0, (q_in, k_st, vc, b_last))
    o = o_intra + o_inter
    return o.transpose(1, 0, 3, 2, 4).reshape(B, T, Hh, dv)


def hybrid_mixer(h, w_in, pe_k, w1_k, w2_k, pe_v, w1_v, w2_v, w_a2, b_a, gla_g, w_out):
    B, T, _ = h.shape
    proj = h @ w_in
    (q, kc, vc, ks, vs, kw, vw, g_nsa, gq, gk, gv, gr, ga) = split_columns(proj, IN_SPLITS)
    kv = lambda z: z.reshape(B, T, NSA_KV_GROUPS, NSA_HEAD_DIM)
    gates = jax.nn.sigmoid(g_nsa.astype(jnp.float32)).astype(h.dtype).reshape(B, T, NSA_HEADS, 3)
    o_nsa = nsa_attention(q.reshape(B, T, NSA_HEADS, NSA_HEAD_DIM), kv(kc), kv(vc), kv(ks), kv(vs), kv(kw), kv(vw),
                          gates, pe_k, w1_k, w2_k, pe_v, w1_v, w2_v)

    log_a = jax.nn.log_sigmoid((ga @ w_a2 + b_a).astype(jnp.float32)) / GLA_TAU
    o_gla = gla_attention(gq.reshape(B, T, GLA_HEADS, GLA_DK), gk.reshape(B, T, GLA_HEADS, GLA_DK),
                          gv.reshape(B, T, GLA_HEADS, GLA_DV), log_a.reshape(B, T, GLA_HEADS, GLA_DK))
    o_gla = rmsnorm(o_gla, gla_g) * jax.nn.silu(gr.astype(jnp.float32)).reshape(B, T, GLA_HEADS, GLA_DV)
    o_gla = o_gla.reshape(B, T, GLA_V_W).astype(h.dtype)

    return jnp.concatenate([o_nsa, o_gla], axis=-1) @ w_out


def setup_inputs(seed: int = 0) -> dict:
    key = jax.random.key(seed)
    ks = jax.random.split(key, 24)
    f32 = jnp.float32

    def nrm(k, shape, scale):
        return jax.random.normal(k, shape, f32) * scale

    def gain(k, n):
        return 1.0 + 0.02 * jax.random.normal(k, (DEPTH, n), f32)

    L = DEPTH
    return {
        'x': nrm(ks[0], (BATCH, SEQ, D_MODEL), 1.0),
        'ffn1_norm': gain(ks[1], D_MODEL),
        'ffn1_w_gate': nrm(ks[2], (L, D_MODEL, D_FF), D_MODEL ** -0.5),
        'ffn1_w_up': nrm(ks[3], (L, D_MODEL, D_FF), D_MODEL ** -0.5),
        'ffn1_w_down': nrm(ks[4], (L, D_FF, D_MODEL), D_FF ** -0.5),
        'mix_norm': gain(ks[5], D_MODEL),
        'w_in': nrm(ks[6], (L, D_MODEL, D_IN_PROJ), D_MODEL ** -0.5),
        'nsa_pe_k': nrm(ks[7], (L, CMP_BLOCK, NSA_HEAD_DIM), 0.02),
        'nsa_w1_k': nrm(ks[8], (L, CMP_BLOCK * NSA_HEAD_DIM, CMP_HIDDEN), (CMP_BLOCK * NSA_HEAD_DIM) ** -0.5),
        'nsa_w2_k': nrm(ks[9], (L, CMP_HIDDEN, NSA_HEAD_DIM), CMP_HIDDEN ** -0.5),
        'nsa_pe_v': nrm(ks[10], (L, CMP_BLOCK, NSA_HEAD_DIM), 0.02),
        'nsa_w1_v': nrm(ks[11], (L, CMP_BLOCK * NSA_HEAD_DIM, CMP_HIDDEN), (CMP_BLOCK * NSA_HEAD_DIM) ** -0.5),
        'nsa_w2_v': nrm(ks[12], (L, CMP_HIDDEN, NSA_HEAD_DIM), CMP_HIDDEN ** -0.5),
        'gla_w_a2': nrm(ks[13], (L, GLA_LOWRANK, GLA_K_W), GLA_LOWRANK ** -0.5),
        'gla_b_a': nrm(ks[14], (L, GLA_K_W), 0.1),
        'gla_norm': gain(ks[15], GLA_DV),
        'w_out': nrm(ks[16], (L, D_MIX, D_MODEL), D_MIX ** -0.5),
        'ffn2_norm': gain(ks[17], D_MODEL),
        'ffn2_w_gate': nrm(ks[18], (L, D_MODEL, D_FF), D_MODEL ** -0.5),
        'ffn2_w_up': nrm(ks[19], (L, D_MODEL, D_FF), D_MODEL ** -0.5),
        'ffn2_w_down': nrm(ks[20], (L, D_FF, D_MODEL), D_FF ** -0.5),
        'final_norm': 1.0 + 0.02 * jax.random.normal(ks[21], (D_MODEL,), f32),
    }


def reference(x, ffn1_norm, ffn1_w_gate, ffn1_w_up, ffn1_w_down, mix_norm, w_in,
              nsa_pe_k, nsa_w1_k, nsa_w2_k, nsa_pe_v, nsa_w1_v, nsa_w2_v,
              gla_w_a2, gla_b_a, gla_norm, w_out,
              ffn2_norm, ffn2_w_gate, ffn2_w_up, ffn2_w_down, final_norm):
    for l in range(DEPTH):
        x = x + 0.5 * swiglu_ffn(rmsnorm(x, ffn1_norm[l]), ffn1_w_gate[l], ffn1_w_up[l], ffn1_w_down[l])
        x = x + hybrid_mixer(rmsnorm(x, mix_norm[l]), w_in[l],
                             nsa_pe_k[l], nsa_w1_k[l], nsa_w2_k[l], nsa_pe_v[l], nsa_w1_v[l], nsa_w2_v[l],
                             gla_w_a2[l], gla_b_a[l], gla_norm[l], w_out[l])
        x = x + 0.5 * swiglu_ffn(rmsnorm(x, ffn2_norm[l]), ffn2_w_gate[l], ffn2_w_up[l], ffn2_w_down[l])
    return rmsnorm(x, final_norm)
```

```cpp
#include <hip/hip_runtime.h>
#include <cstdio>
#include <cstdint>
namespace pg8 {
#define PG8_LAS __attribute__((address_space(3)))
typedef unsigned short bf16_t;
typedef short bf16x8 __attribute__((ext_vector_type(8)));
typedef float f32x4 __attribute__((ext_vector_type(4)));
typedef unsigned u32x4 __attribute__((ext_vector_type(4)));
constexpr int BM = 256, BK = 64, HALF = 128, HTB = HALF * BK * 2  , STAGE_BYTES = 8 * HTB, NXCD = 8, WGM = 8;

__host__ __device__ __forceinline__ int lds_byte(int r, int c) { const int st = (r >> 4) * 2 + (c >> 5), rr = r & 15, cc = c & 31, ob = rr * 64 + cc * 2; return st * 1024 + (ob ^ (((ob >> 9) & 1) << 5)); }
__host__ __device__ __forceinline__ void stage_rc(int b, int& R, int& C) { const int st = b / 1024, sb = b % 1024, swz = sb ^ (((sb >> 9) & 1) << 5); R = (st >> 1) * 16 + swz / 64; C = (st & 1) * 32 + (swz % 64) / 2; }
__host__ __device__ __forceinline__ int perm32(int rho) { const int n = rho >> 4, i = rho & 15; return 8 * (i >> 2) + 4 * n + (i & 3); }

struct Unit { int pm, pn; };
struct Gemm { const bf16_t* A; const bf16_t* Bt; int M, N, K; };

struct StaticOrder {
    int nM, nN, nwg, G, c;
    __host__ __device__ void init(int M, int N, int G_, int c_) { nM = M / BM; nN = N / BM; nwg = nM * nN; G = G_; c = c_; }
    __host__ __device__ bool next(int i, Unit& u) const {
        const long L = (long)i * G + c; if (L >= nwg) return false;
        int wgid = (int)L; { const int q = nwg / NXCD, r = nwg % NXCD, xcd = wgid % NXCD, off = wgid / NXCD; wgid = (xcd < r ? xcd * (q + 1) : r * (q + 1) + (xcd - r) * q) + off; }
        const int nig = WGM * nN, gid = wgid / nig, fm = gid * WGM, gsz = (nM - fm) < WGM ? (nM - fm) : WGM;
        u.pm = fm + ((wgid % nig) % gsz); u.pn = (wgid % nig) / gsz; return true;
    }
    __device__ __forceinline__ void a_ready(const Unit&) const {}
    __device__ __forceinline__ void done(const Unit&) const {}
};
__device__ __forceinline__ unsigned cvt_pk_bf16(float lo, float hi) { unsigned r; asm volatile("v_cvt_pk_bf16_f32 %0, %1, %2" : "=v"(r) : "v"(lo), "v"(hi)); return r; }
typedef float f32x2 __attribute__((ext_vector_type(2)));
typedef unsigned u32x2 __attribute__((ext_vector_type(2)));
constexpr float RMS_EPS = 1e-6f;
template <int NPARTS> __device__ __forceinline__ float row_rstd(const float* ssq, int row) {
    float s;
    if (NPARTS == 1) s = ssq[row];
    else { const f32x4* p = (const f32x4*)(ssq + (size_t)row * 16); const f32x4 a = p[0], b = p[1], c = p[2], d = p[3]; const f32x4 t = (a + b) + (c + d); s = (t[0] + t[1]) + (t[2] + t[3]); }
    return __builtin_amdgcn_rsqf(s * (1.0f / 1024.0f) + RMS_EPS);
}
__device__ __forceinline__ float silu_f(float x) { return x * __builtin_amdgcn_rcpf(1.0f + __builtin_amdgcn_exp2f(-1.4426950408889634f * x)); }
template <int NPARTS> struct EpiSwiGLU {
    static constexpr bool PERM = true, AFTER_DRAIN = false;
    bf16_t* H; int ldh; const float* ssq;
    __device__ __forceinline__ void operator()(const f32x4 (&acc)[2][2][4][2], const Unit& u, int wr, int wc, int fr, int fq) const {
        const int row0 = u.pm * BM + wr * 64 + fr, col0 = u.pn * 128 + wc * 32 + 8 * fq;
#pragma unroll
        for (int ai = 0; ai < 2; ++ai)
#pragma unroll
            for (int m = 0; m < 4; ++m) { const int row = row0 + ai * HALF + m * 16; const float rs = row_rstd<NPARTS>(ssq, row);
                const f32x4 g0 = acc[ai][0][m][0] * rs, g1 = acc[ai][0][m][1] * rs, u0 = acc[ai][1][m][0] * rs, u1 = acc[ai][1][m][1] * rs;
                u32x4 w;
                w.x = cvt_pk_bf16(silu_f(g0[0]) * u0[0], silu_f(g0[1]) * u0[1]); w.y = cvt_pk_bf16(silu_f(g0[2]) * u0[2], silu_f(g0[3]) * u0[3]);
                w.z = cvt_pk_bf16(silu_f(g1[0]) * u1[0], silu_f(g1[1]) * u1[1]); w.w = cvt_pk_bf16(silu_f(g1[2]) * u1[2], silu_f(g1[3]) * u1[3]);
                *(u32x4*)(H + (size_t)row * ldh + col0) = w; if (m & 1) asm volatile("" ::: "memory"); }
    }
};
template <int NPARTS> struct EpiProj {
    static constexpr bool PERM = true, AFTER_DRAIN = false;
    bf16_t* O; int ldc; const float* ssq;
    __device__ __forceinline__ void operator()(const f32x4 (&acc)[2][2][4][2], const Unit& u, int wr, int wc, int fr, int fq) const {
        const int row0 = u.pm * BM + wr * 64 + fr, col0 = u.pn * BM + wc * 32 + 8 * fq;
#pragma unroll
        for (int ai = 0; ai < 2; ++ai)
#pragma unroll
            for (int m = 0; m < 4; ++m) { const int row = row0 + ai * HALF + m * 16; const float rs = row_rstd<NPARTS>(ssq, row);
#pragma unroll
                for (int bj = 0; bj < 2; ++bj) { const f32x4 v0 = acc[ai][bj][m][0] * rs, v1 = acc[ai][bj][m][1] * rs; u32x4 w;
                    w.x = cvt_pk_bf16(v0[0], v0[1]); w.y = cvt_pk_bf16(v0[2], v0[3]); w.z = cvt_pk_bf16(v1[0], v1[1]); w.w = cvt_pk_bf16(v1[2], v1[3]);
                    *(u32x4*)(O + (size_t)row * ldc + col0 + bj * HALF) = w; } if (m & 1) asm volatile("" ::: "memory"); }
    }
};
template <bool WB> struct EpiResid {
    static constexpr bool PERM = false, AFTER_DRAIN = false;
    const float* rin; float* out; bf16_t* xb; float* ssqp; float alpha;
    __device__ __forceinline__ void operator()(const f32x4 (&acc)[2][2][4][2], const Unit& u, int wr, int wc, int fr, int fq) const {
        const int row0 = u.pm * BM + wr * 64 + fr, col0 = u.pn * BM + wc * 32 + 4 * fq;
#pragma unroll
        for (int ai = 0; ai < 2; ++ai)
#pragma unroll
            for (int m = 0; m < 4; ++m) { const int row = row0 + ai * HALF + m * 16; float ss = 0.f;
#pragma unroll
                for (int bj = 0; bj < 2; ++bj)
#pragma unroll
                    for (int n = 0; n < 2; ++n) { const size_t off = (size_t)row * 1024 + col0 + bj * HALF + n * 16;
                        const f32x4 o = *(const f32x4*)(rin + off) + acc[ai][bj][m][n] * alpha; *(f32x4*)(out + off) = o;
                        if (WB) { u32x2 w; w.x = cvt_pk_bf16(o[0], o[1]); w.y = cvt_pk_bf16(o[2], o[3]); *(u32x2*)(xb + off) = w; ss += (o[0] * o[0] + o[1] * o[1]) + (o[2] * o[2] + o[3] * o[3]); } }
                if (WB) { ss += __shfl_xor(ss, 16); ss += __shfl_xor(ss, 32); if (fq == 0) ssqp[(size_t)row * 16 + u.pn * 4 + wc] = ss; } asm volatile("" ::: "memory"); }
    }
};
template <class Epi, class Sched, bool ALIGN_EPI = false, bool SP2 = false>
__device__ __forceinline__ void gemm_phase(PG8_LAS unsigned char* lds, const Gemm g, const Sched& S, const Epi& E) {
    int tid_ = threadIdx.x; asm volatile("" : "+v"(tid_)); const int tid = tid_, wid = __builtin_amdgcn_readfirstlane(tid >> 6), lane = tid & 63, wr = wid >> 2, wc = wid & 3, fr = lane & 15, fq = lane >> 4;
    const int K = g.K, nt = K / BK;
    unsigned voffA[2], voffB[2];
#pragma unroll
    for (int i = 0; i < 2; ++i) { int R, C; stage_rc(tid * 16 + i * 8192, R, C); const int Rb = Epi::PERM ? ((R & ~31) + perm32(R & 31)) : R;
        voffA[i] = (unsigned)(R * K + C) * 2u; voffB[i] = (unsigned)(Rb * K + C) * 2u; }
    const size_t kstep = (size_t)(BK * 2);
    const size_t hstep = (size_t)HALF * K * 2;
    const size_t tstep = 2 * hstep;
    const unsigned ldsw = (unsigned)wid * 1024u;
    const int aoff = lds_byte(wr * 64 + fr, fq * 8), boff = lds_byte(wc * 32 + fr, fq * 8);
#define PG8_SA(b, h) (((b) * 2 + (h)) * HTB)
#define PG8_SB(b, h) ((4 + (b) * 2 + (h)) * HTB)
#define PG8_STAGE(bufoff, gbase, voff) do { _Pragma("unroll") for (int _i = 0; _i < 2; ++_i) \
        __builtin_amdgcn_global_load_lds((const unsigned*)((const char*)(gbase) + (voff)[_i]), (PG8_LAS unsigned*)(lds + (bufoff) + ldsw + _i * 8192), 16, 0, 0); } while (0)
#define PG8_LDA(dst, b, h) do { _Pragma("unroll") for (int m = 0; m < 4; ++m) _Pragma("unroll") for (int k = 0; k < 2; ++k) dst[m][k] = *(const PG8_LAS bf16x8*)(lds + PG8_SA(b, h) + aoff + m * 2048 + k * 1024); } while (0)
#define PG8_LDB(dst, b, h) do { _Pragma("unroll") for (int n = 0; n < 2; ++n) _Pragma("unroll") for (int k = 0; k < 2; ++k) dst[n][k] = *(const PG8_LAS bf16x8*)(lds + PG8_SB(b, h) + boff + n * 2048 + k * 1024); } while (0)
#define PG8_MMA(ai, bj, At, Bt) do { __builtin_amdgcn_s_setprio(1); _Pragma("unroll") for (int m = 0; m < 4; ++m) _Pragma("unroll") for (int n = 0; n < 2; ++n) _Pragma("unroll") for (int k = 0; k < 2; ++k) \
        acc[ai][bj][m][n] = __builtin_amdgcn_mfma_f32_16x16x32_bf16(Bt[n][k], At[m][k], acc[ai][bj][m][n], 0, 0, 0); __builtin_amdgcn_s_setprio(0); } while (0)
#define PG8_WAIT_V(n) asm volatile("s_waitcnt vmcnt(" #n ")" ::: "memory")
#define PG8_WAIT_L(n) asm volatile("s_waitcnt lgkmcnt(" #n ")" ::: "memory")
#define PG8_BAR __builtin_amdgcn_s_barrier()
#define PG8_SCHED __builtin_amdgcn_sched_barrier(0)
    Unit cur, nxt; int ui = 0;
    if (!S.next(0, cur)) return;
    f32x4 acc[2][2][4][2];
#pragma unroll
    for (int a = 0; a < 2; ++a)
#pragma unroll
        for (int b = 0; b < 2; ++b)
#pragma unroll
            for (int m = 0; m < 4; ++m)
#pragma unroll
                for (int n = 0; n < 2; ++n) acc[a][b][m][n] = (f32x4){0.f, 0.f, 0.f, 0.f};
    bf16x8 At[4][2], B0[2][2], B1[2][2];
    const char* cA = (const char*)g.A + (size_t)cur.pm * tstep; const char* cB = (const char*)g.Bt + (size_t)cur.pn * tstep;
    S.a_ready(cur);
    if constexpr (SP2) {
        PG8_STAGE(PG8_SB(0, 0), cB, voffB); PG8_STAGE(PG8_SB(0, 1), cB + hstep, voffB); PG8_STAGE(PG8_SA(0, 0), cA, voffA); PG8_STAGE(PG8_SA(0, 1), cA + hstep, voffA);
        if (wr == 1) PG8_BAR;
        PG8_WAIT_V(2); PG8_BAR;
        PG8_STAGE(PG8_SB(1, 0), cB + kstep, voffB); PG8_STAGE(PG8_SA(1, 0), cA + kstep, voffA); PG8_STAGE(PG8_SB(1, 1), cB + hstep + kstep, voffB);
        PG8_WAIT_V(6); PG8_BAR;
    } else {
        PG8_STAGE(PG8_SB(0, 0), cB, voffB); PG8_STAGE(PG8_SA(0, 0), cA, voffA); PG8_STAGE(PG8_SB(0, 1), cB + hstep, voffB); PG8_STAGE(PG8_SA(0, 1), cA + hstep, voffA);
        if (wr == 1) PG8_BAR;
        PG8_WAIT_V(4); PG8_BAR;
        PG8_STAGE(PG8_SB(1, 0), cB + kstep, voffB); PG8_STAGE(PG8_SA(1, 0), cA + kstep, voffA); PG8_STAGE(PG8_SB(1, 1), cB + hstep + kstep, voffB);
        PG8_WAIT_V(6); PG8_BAR;
    }
    for (;;) {
        const bool has_next = S.next(ui + 1, nxt);
        const char* nA = has_next ? (const char*)g.A + (size_t)nxt.pm * tstep : cA; const char* nB = has_next ? (const char*)g.Bt + (size_t)nxt.pn * tstep : cB;
        for (int t = 0; t < nt; t += 2) {
            const bool last = (t == nt - 2);
            const char* a1 = cA + (size_t)(t + 1) * kstep;
            const char* a2 = last ? nA : cA + (size_t)(t + 2) * kstep; const char* b2 = last ? nB : cB + (size_t)(t + 2) * kstep;
            const char* a3 = a2 + kstep; const char* b3 = b2 + kstep;
            if (last && has_next) S.a_ready(nxt);
            if constexpr (SP2) {
            PG8_LDB(B0, 0, 0); PG8_LDB(B1, 0, 1); PG8_SCHED; PG8_LDA(At, 0, 0); PG8_STAGE(PG8_SA(1, 1), a1 + hstep, voffA);
            PG8_WAIT_V(8); PG8_WAIT_L(0); PG8_BAR; PG8_MMA(0, 0, At, B0); PG8_MMA(0, 1, At, B1); PG8_BAR; PG8_SCHED;
            PG8_LDA(At, 0, 1); PG8_STAGE(PG8_SB(0, 0), b2, voffB); PG8_STAGE(PG8_SB(0, 1), b2 + hstep, voffB); PG8_STAGE(PG8_SA(0, 0), a2, voffA);
            PG8_WAIT_V(8); PG8_WAIT_L(0); PG8_BAR; PG8_MMA(1, 0, At, B0); PG8_MMA(1, 1, At, B1); PG8_BAR; PG8_SCHED;
            PG8_LDB(B0, 1, 0); PG8_LDB(B1, 1, 1); PG8_SCHED; PG8_LDA(At, 1, 0); PG8_STAGE(PG8_SA(0, 1), a2 + hstep, voffA);
            PG8_WAIT_V(8); PG8_WAIT_L(0); PG8_BAR; PG8_MMA(0, 0, At, B0); PG8_MMA(0, 1, At, B1); PG8_BAR; PG8_SCHED;
            PG8_LDA(At, 1, 1); PG8_STAGE(PG8_SB(1, 0), b3, voffB); PG8_STAGE(PG8_SB(1, 1), b3 + hstep, voffB); PG8_STAGE(PG8_SA(1, 0), a3, voffA);
            PG8_WAIT_V(8); PG8_WAIT_L(0); PG8_BAR; PG8_MMA(1, 0, At, B0); PG8_MMA(1, 1, At, B1); PG8_BAR; PG8_SCHED;
            } else {
            PG8_LDB(B0, 0, 0); PG8_SCHED; PG8_LDA(At, 0, 0); PG8_STAGE(PG8_SA(1, 1), a1 + hstep, voffA);
            PG8_WAIT_L(8); PG8_BAR; PG8_WAIT_L(0); PG8_MMA(0, 0, At, B0); PG8_BAR; PG8_SCHED;
            PG8_LDB(B1, 0, 1); PG8_STAGE(PG8_SB(0, 0), b2, voffB);
            PG8_BAR; PG8_WAIT_L(0); PG8_MMA(0, 1, At, B1); PG8_BAR;
            PG8_LDA(At, 0, 1); PG8_STAGE(PG8_SA(0, 0), a2, voffA);
            PG8_BAR; PG8_WAIT_L(0); PG8_MMA(1, 0, At, B0); PG8_BAR; PG8_SCHED;
            PG8_STAGE(PG8_SB(0, 1), b2 + hstep, voffB);
            PG8_WAIT_V(6); PG8_BAR; PG8_MMA(1, 1, At, B1); PG8_BAR;
            PG8_LDB(B0, 1, 0); PG8_SCHED; PG8_LDA(At, 1, 0); PG8_STAGE(PG8_SA(0, 1), a2 + hstep, voffA);
            PG8_WAIT_L(8); PG8_BAR; PG8_WAIT_L(0); PG8_MMA(0, 0, At, B0); PG8_BAR; PG8_SCHED;
            PG8_LDB(B1, 1, 1); PG8_STAGE(PG8_SB(1, 0), b3, voffB);
            PG8_BAR; PG8_WAIT_L(0); PG8_MMA(0, 1, At, B1); PG8_BAR;
            PG8_LDA(At, 1, 1); PG8_STAGE(PG8_SA(1, 0), a3, voffA);
            PG8_BAR; PG8_WAIT_L(0); PG8_MMA(1, 0, At, B0); PG8_BAR; PG8_SCHED;
            PG8_STAGE(PG8_SB(1, 1), b3 + hstep, voffB);
            PG8_WAIT_V(6); PG8_BAR; PG8_MMA(1, 1, At, B1); PG8_BAR;
            }
        }
        if constexpr (ALIGN_EPI) { if (wr == 0) PG8_BAR; }
        if constexpr (!Epi::AFTER_DRAIN) { E(acc, cur, wr, wc, fr, fq); S.done(cur); }
        if (!has_next) break;
#pragma unroll
        for (int a = 0; a < 2; ++a)
#pragma unroll
            for (int b = 0; b < 2; ++b)
#pragma unroll
                for (int m = 0; m < 4; ++m)
#pragma unroll
                    for (int n = 0; n < 2; ++n) acc[a][b][m][n] = (f32x4){0.f, 0.f, 0.f, 0.f};
        cur = nxt; cA = nA; cB = nB; ++ui;
        if constexpr (ALIGN_EPI) { if (wr == 1) PG8_BAR; }
    }
    PG8_WAIT_V(0);
    if constexpr (!ALIGN_EPI) { if (wr == 0) PG8_BAR; }
    PG8_BAR;
    if constexpr (Epi::AFTER_DRAIN) { E.fused(acc, cur, wr, wc, fr, fq, lds, wid, lane); S.done(cur); }
#undef PG8_SA
#undef PG8_SB
#undef PG8_STAGE
#undef PG8_LDA
#undef PG8_LDB
#undef PG8_MMA
#undef PG8_WAIT_V
#undef PG8_WAIT_L
#undef PG8_BAR
#undef PG8_SCHED
}
}

#define GAS __attribute__((address_space(1)))
#define LAS __attribute__((address_space(3)))
typedef unsigned short bf16;
typedef unsigned v4u __attribute__((ext_vector_type(4)));
typedef float f32x4 __attribute__((ext_vector_type(4)));
typedef short bf16x8 __attribute__((ext_vector_type(8)));
typedef GAS unsigned gu32;
typedef GAS unsigned long long gu64;
#define RLX_AGENT __ATOMIC_RELAXED, __HIP_MEMORY_SCOPE_AGENT
#define LDS_WAIT() asm volatile("s_waitcnt lgkmcnt(0)" ::: "memory")
#define VM_WAIT() asm volatile("s_waitcnt vmcnt(0)" ::: "memory")
__device__ __forceinline__ unsigned long long rt() { return __builtin_amdgcn_s_memrealtime(); }
__device__ __forceinline__ unsigned f2bf(float f) { unsigned u = __builtin_bit_cast(unsigned, f); return (u + 0x7fffu + ((u >> 16) & 1u)) >> 16; }
__device__ __forceinline__ unsigned pk2(float lo, float hi) { return f2bf(lo) | (f2bf(hi) << 16); }
#define XB_TMO      128
#define XB_XCNT(j)  (256  + 64 * (j))
#define XB_XSUB(j)  (1280 + 64 * (j))
#define XB_XGEN(j)  (2304 + 64 * (j))
#define XB_TOP      3328
#define XB_TOPGEN   3392
#define XCD_BAR_WORDS 3456
#define XB_SPIN_CAP (1u << 18)

__device__ __forceinline__ unsigned xb_ld(unsigned* p)              { return __hip_atomic_load(p, __ATOMIC_RELAXED, __HIP_MEMORY_SCOPE_AGENT); }
__device__ __forceinline__ unsigned xb_add(unsigned* p, unsigned v) { return __hip_atomic_fetch_add(p, v, __ATOMIC_RELAXED, __HIP_MEMORY_SCOPE_AGENT); }
__device__ __forceinline__ unsigned xb_xcc_id() { return (unsigned)__builtin_amdgcn_s_getreg((3 << 11) | 20) & 0xFu; }
#define XB_SPIN(cond, bar) do { unsigned _sp = 0; while (cond) { __builtin_amdgcn_s_sleep(1); \
    if ((++_sp & 255u) == 0u) { if (xb_ld(&(bar)[XB_TMO])) break; if (_sp > XB_SPIN_CAP) { atomicAdd(&(bar)[XB_TMO], 1u); break; } } } } while (0)

struct XcdBarrier {
    unsigned* bar; unsigned x;
    volatile LAS unsigned* st;
};

__device__ __forceinline__ XcdBarrier xcd_barrier_post(unsigned* bar, volatile LAS unsigned* st) {
    XcdBarrier b; b.bar = bar; b.x = xb_xcc_id(); b.st = st;
    if (threadIdx.x == 0) (void)xb_add(&bar[XB_XCNT(b.x)], 1u);
    return b;
}
__device__ __forceinline__ void xcd_barrier_complete(unsigned* bar, unsigned x, unsigned& nloc, unsigned& nx) {
    const unsigned G = gridDim.x * gridDim.y * gridDim.z;
    unsigned sum, cnt, mine, sp = 0u;
    for (;;) {
        sum = 0u; cnt = 0u; mine = 0u;
#pragma unroll
        for (unsigned j = 0; j < 16; ++j) { const unsigned c = xb_ld(&bar[XB_XCNT(j)]); sum += c; cnt += (c > 0u) ? 1u : 0u; mine = (j == x) ? c : mine; }
        if (sum == G) break;
        __builtin_amdgcn_s_sleep(1);
        if ((++sp & 255u) == 0u) { if (xb_ld(&bar[XB_TMO])) break; if (sp > XB_SPIN_CAP) { atomicAdd(&bar[XB_TMO], 1u); break; } }
    }
    nloc = mine > 0u ? mine : 1u; nx = cnt > 0u ? cnt : 1u;
}

__device__ __forceinline__ void xcd_barrier(const XcdBarrier& b) {
    asm volatile("s_waitcnt vmcnt(0)" ::: "memory");
    __syncthreads();
    if (threadIdx.x == 0) {
        unsigned* bar = b.bar;
        __builtin_amdgcn_s_waitcnt(0);
        unsigned nloc = b.st[0], nx = b.st[1];
        if (nloc == 0u) { xcd_barrier_complete(bar, b.x, nloc, nx); b.st[0] = nloc; b.st[1] = nx; }
        const unsigned old = xb_add(&bar[XB_XSUB(b.x)], 1u);
        const unsigned gen = old / nloc;
        if (old + 1u == (gen + 1u) * nloc) {
            __builtin_amdgcn_fence(__ATOMIC_RELEASE, "agent");
            asm volatile("s_waitcnt vmcnt(0)" ::: "memory");
            const unsigned og = xb_add(&bar[XB_TOP], 1u);
            const unsigned tg = og / nx;
            if (og + 1u == (tg + 1u) * nx) xb_add(&bar[XB_TOPGEN], 1u);
            else XB_SPIN(xb_ld(&bar[XB_TOPGEN]) == tg, bar);
            __builtin_amdgcn_fence(__ATOMIC_ACQUIRE, "agent");
            xb_add(&bar[XB_XGEN(b.x)], 1u);
            asm volatile("s_waitcnt vmcnt(0)" ::: "memory");
        } else {
            XB_SPIN(xb_ld(&bar[XB_XGEN(b.x)]) == gen, bar);
            __builtin_amdgcn_fence(__ATOMIC_ACQUIRE, "agent");
            asm volatile("s_waitcnt vmcnt(0)" ::: "memory");
        }
    }
    __syncthreads();
}

constexpr int NWAVES = 8;
using pg8::RMS_EPS;
constexpr int BATCH = 8, T = 2048, D = 1024, FF = 2816, M = BATCH * T, NP = 3072;
constexpr int C_Q = 0, C_KC = 512, C_VC = 640, C_KS = 768, C_VS = 896, C_KW = 1024, C_VW = 1152, C_GQ = 1280, C_GK = 1536, C_GV = 1792, C_GR = 2304, C_GN = 2816, C_GA = 2840;
constexpr int SRC_NIN = 2856;
constexpr size_t MiB = 1u << 20;
constexpr size_t WS_CTL = 0, CTL_ZERO_BYTES = 1 * MiB;
constexpr size_t WS_W1GU = 1 * MiB, WS_W1D = 12 * MiB, WS_WIN = 18 * MiB, WS_WOUT = 24 * MiB, WS_W2GU = 26 * MiB, WS_W2D = 37 * MiB;
constexpr size_t WS_WC1K = 43 * MiB, WS_WC1V = 43 * MiB + 512 * 1024;
constexpr size_t WS_WC2K = 44 * MiB, WS_WC2V = 44 * MiB + 16384, WS_CBIAS = 44 * MiB + 32768, WS_KC = 44 * MiB + 65536, WS_VTC = 44 * MiB + 65536 + 262144;
constexpr size_t WS_SSQ0 = 45 * MiB, WS_SSQA = 46 * MiB, WS_SSQB = 47 * MiB, WS_DEC = 48 * MiB;
constexpr size_t WS_XB = 50 * MiB, WS_KVT = WS_XB;
constexpr size_t WS_R = 82 * MiB;
constexpr size_t WS_MIX = 178 * MiB, WS_VTS = 210 * MiB, WS_VTW = 214 * MiB, WS_ST = 218 * MiB, WS_END = 234 * MiB;
constexpr int CW_BAR = 4096;
constexpr int RING_OFF = 0, RING_BYTES = 131072, LDSCTL_OFF = RING_BYTES, MISC_OFF = LDSCTL_OFF + 320, LDS_BYTES = 147456;

typedef unsigned u32x2 __attribute__((ext_vector_type(2)));
typedef float f32x2_t __attribute__((ext_vector_type(2))); typedef __bf16 bf16x2_t __attribute__((ext_vector_type(2)));
__device__ __forceinline__ unsigned cvtpk(float lo, float hi) { f32x2_t v = {lo, hi}; bf16x2_t b = __builtin_convertvector(v, bf16x2_t); return __builtin_bit_cast(unsigned, b); }
__device__ __forceinline__ bf16 f2b(float x) { return (bf16)(cvtpk(x, 0.f) & 0xffffu); }
__device__ __forceinline__ float bf2f(bf16 h) { return __builtin_bit_cast(float, (unsigned)h << 16); }
__device__ __forceinline__ float blo(unsigned w) { return __builtin_bit_cast(float, w << 16); }
__device__ __forceinline__ float bhi(unsigned w) { return __builtin_bit_cast(float, w & 0xffff0000u); }
__device__ __forceinline__ float fexp(float x) { return __builtin_amdgcn_exp2f(x * 1.4426950408889634f); }
__device__ __forceinline__ bf16x8 pack8(f32x4 a, f32x4 b) { v4u w; w.x = cvtpk(a[0], a[1]); w.y = cvtpk(a[2], a[3]); w.z = cvtpk(b[0], b[1]); w.w = cvtpk(b[2], b[3]); return __builtin_bit_cast(bf16x8, w); }
__device__ __forceinline__ bf16x8 ld2x8(const bf16* p0, const bf16* p1) { const u32x2 a = *(const u32x2*)p0, b = *(const u32x2*)p1; v4u w; w.x = a.x; w.y = a.y; w.z = b.x; w.w = b.y; return __builtin_bit_cast(bf16x8, w); }
__device__ __forceinline__ bf16x8 ldb16(const void* ub, unsigned boff) { return *(const bf16x8*)((const char*)ub + boff); }
__device__ __forceinline__ bf16x8 ldb8x2(const void* ub, unsigned boff) { const u32x2 a = *(const u32x2*)((const char*)ub + boff), b = *(const u32x2*)((const char*)ub + boff + 32); v4u w; w.x = a.x; w.y = a.y; w.z = b.x; w.w = b.y; return __builtin_bit_cast(bf16x8, w); }
__device__ __forceinline__ float ldb_bf(const void* ub, unsigned boff) { return bf2f(*(const bf16*)((const char*)ub + boff)); }
#define OPAQUE(x) asm volatile("" : "+v"(x))
#define MFMA16(a, b, c) __builtin_amdgcn_mfma_f32_16x16x32_bf16((a), (b), (c), 0, 0, 0)
#define WAVE_LDS_FENCE() asm volatile("s_waitcnt lgkmcnt(0)" ::: "memory")

struct Frame {
    LAS unsigned char* lds;
    volatile LAS unsigned* MISC;
    gu32* ctl;
    int tid, lane, wave, vcu, G;
    const float* in[22];
    float* out;
    bf16 *W1GU, *W1D, *WIN, *WOUT, *W2GU, *W2D, *WC1K, *WC1V, *WC2K, *WC2V, *KC, *VTC, *XB, *H, *PROJ, *MIX, *VTS, *VTW, *ST;
    float *CBIAS, *SSQ0, *SSQA, *SSQB, *DEC, *KVT;
};

__device__ __forceinline__ float wave_sum(float v) {
#pragma unroll
    for (int o = 1; o < 64; o <<= 1) v += __shfl_xor(v, o);
    return v;
}

__device__ __forceinline__ int win_src_col(int n) { return n < 1280 ? n : (n < 2816 ? n + 24 : (n < 2840 ? n - 1536 : (n < 2856 ? n : -1))); }
__device__ __forceinline__ void p0_tr_item(const float* W, const float* W2, const float* gain, int K, int Nsrc, int mode, bf16* WT, LAS float* scr, int kb, int nb, int lane) {
    const int k0 = 64 * kb, n0 = 32 * nb, nd = n0 + (lane & 31);
    const float* src = W; int sc = nd;
    if (mode == 1) { const int tile = nd >> 8, c = nd & 255; if (c >= 128) { src = W2; sc = tile * 128 + c - 128; } else sc = tile * 128 + c; }
    else if (mode == 2) sc = win_src_col(nd);
#pragma unroll 8
    for (int i = 0; i < 32; ++i) { const int kk = 2 * i + (lane >> 5); float v = 0.f; if (sc >= 0) v = src[(size_t)(k0 + kk) * Nsrc + sc]; if (gain) v *= gain[k0 + kk]; scr[kk * 33 + (lane & 31)] = v; }
    LDS_WAIT(); asm volatile("" ::: "memory");
    const int c = lane & 7;
#pragma unroll
    for (int j = 0; j < 4; ++j) { const int n = (lane >> 3) + 8 * j; const LAS float* s = scr + (8 * c) * 33 + n;
        v4u o; o.x = pk2(s[0 * 33], s[1 * 33]); o.y = pk2(s[2 * 33], s[3 * 33]); o.z = pk2(s[4 * 33], s[5 * 33]); o.w = pk2(s[6 * 33], s[7 * 33]);
        *(GAS v4u*)(WT + (size_t)(n0 + n) * K + k0 + 8 * c) = o; }
    LDS_WAIT(); asm volatile("" ::: "memory");
}
__device__ __forceinline__ void p0_prologue(Frame& F) {
    LAS float* scr = (LAS float*)(F.lds + RING_OFF + F.wave * 16384);
    const int gw = F.vcu * NWAVES + F.wave, NGW = F.G * NWAVES;
    constexpr int I_GU = 16 * 176, I_DN = 44 * 32, I_IN = 16 * 96, I_OUT = 16 * 32, I_C1 = 32 * 4, I_C2 = 2 * 2;
    constexpr int NITEMS = 2 * I_GU + 2 * I_DN + I_IN + I_OUT + 2 * I_C1 + 2 * I_C2;
    for (int it = gw; it < NITEMS; it += NGW) {
        int r = it;
        if (r < I_GU) { p0_tr_item(F.in[2], F.in[3], F.in[1], 1024, FF, 1, F.W1GU, scr, r / 176, r % 176, F.lane); continue; } r -= I_GU;
        if (r < I_GU) { p0_tr_item(F.in[18], F.in[19], F.in[17], 1024, FF, 1, F.W2GU, scr, r / 176, r % 176, F.lane); continue; } r -= I_GU;
        if (r < I_DN) { p0_tr_item(F.in[4], nullptr, nullptr, FF, 1024, 0, F.W1D, scr, r / 32, r % 32, F.lane); continue; } r -= I_DN;
        if (r < I_DN) { p0_tr_item(F.in[20], nullptr, nullptr, FF, 1024, 0, F.W2D, scr, r / 32, r % 32, F.lane); continue; } r -= I_DN;
        if (r < I_IN) { p0_tr_item(F.in[6], nullptr, F.in[5], 1024, SRC_NIN, 2, F.WIN, scr, r / 96, r % 96, F.lane); continue; } r -= I_IN;
        if (r < I_OUT) { p0_tr_item(F.in[16], nullptr, nullptr, 1024, 1024, 0, F.WOUT, scr, r / 32, r % 32, F.lane); continue; } r -= I_OUT;
        if (r < I_C1) { p0_tr_item(F.in[8], nullptr, nullptr, 2048, 128, 0, F.WC1K, scr, r / 4, r % 4, F.lane); continue; } r -= I_C1;
        if (r < I_C1) { p0_tr_item(F.in[11], nullptr, nullptr, 2048, 128, 0, F.WC1V, scr, r / 4, r % 4, F.lane); continue; } r -= I_C1;
        if (r < I_C2) { p0_tr_item(F.in[9], nullptr, nullptr, 128, 64, 0, F.WC2K, scr, r / 2, r % 2, F.lane); continue; } r -= I_C2;
        p0_tr_item(F.in[12], nullptr, nullptr, 128, 64, 0, F.WC2V, scr, r / 2, r % 2, F.lane);
    }
    for (int m = gw; m < M; m += NGW) {
        const GAS f32x4* xr = (const GAS f32x4*)(F.in[0] + (size_t)m * D) + F.lane;
        f32x4 v[4]; float s = 0.f;
#pragma unroll
        for (int j = 0; j < 4; ++j) { v[j] = xr[64 * j]; s += (v[j].x * v[j].x + v[j].y * v[j].y) + (v[j].z * v[j].z + v[j].w * v[j].w); }
        s = wave_sum(s);
        if (F.lane == 0) F.SSQ0[m] = s;
        GAS unsigned long long* o8 = (GAS unsigned long long*)(F.XB + (size_t)m * D) + F.lane;
#pragma unroll
        for (int j = 0; j < 4; ++j) o8[64 * j] = (unsigned long long)cvtpk(v[j].x, v[j].y) | ((unsigned long long)cvtpk(v[j].z, v[j].w) << 32);
    }
    __syncthreads();
    if (F.vcu < 2) {
        const int kv = F.vcu; const float* W = kv ? F.in[11] : F.in[8]; const float* pe = kv ? F.in[10] : F.in[7];
        const int n = F.tid & 127, part = F.tid >> 7; float s = 0.f;
        for (int k = part * 512; k < part * 512 + 512; ++k) s += pe[k] * W[(size_t)k * 128 + n];
        LAS float* red = (LAS float*)(F.lds + RING_OFF);
        red[part * 128 + n] = s; __syncthreads();
        if (F.tid < 128) F.CBIAS[kv * 128 + n] = (red[n] + red[128 + n]) + (red[256 + n] + red[384 + n]);
        __syncthreads();
    }
}

__device__ __forceinline__ void m1_compress(Frame& F, int ci) {
    const int kv = ci >> 7, b = (ci >> 4) & 7, g = (ci >> 3) & 1, rg = ci & 7;
    const int lane = F.lane, q = lane & 15, gl = lane >> 4, w = F.wave;
    LAS float* red = (LAS float*)(F.lds + RING_OFF);
    LAS bf16* hidb = (LAS bf16*)(F.lds + RING_OFF + 65536);
    const bf16* W1 = kv ? F.WC1V : F.WC1K; const bf16* W2 = kv ? F.WC2V : F.WC2K;
    const int ccol = (kv ? C_VC : C_KC) + g * 64;
    f32x4 acc[8];
#pragma unroll
    for (int nt = 0; nt < 8; ++nt) acc[nt] = (f32x4){0.f, 0.f, 0.f, 0.f};
#pragma unroll
    for (int ks = 0; ks < 8; ++ks) {
        const int l = 4 * w + (ks >> 1), dbase = 32 * (ks & 1) + 8 * gl;
        int tok = 16 * (16 * rg + q) + l; tok = tok > T - 1 ? T - 1 : tok;
        const bf16x8 a = *(const bf16x8*)(F.PROJ + ((size_t)b * T + tok) * NP + ccol + dbase);
        const int kg = 64 * l + dbase;
#pragma unroll
        for (int nt = 0; nt < 8; ++nt) { const bf16x8 bw = *(const bf16x8*)(W1 + (size_t)(16 * nt + q) * 2048 + kg); acc[nt] = MFMA16(a, bw, acc[nt]); }
    }
#pragma unroll
    for (int nt = 0; nt < 8; ++nt)
#pragma unroll
        for (int reg = 0; reg < 4; ++reg) red[(w * 16 + 4 * gl + reg) * 128 + 16 * nt + q] = acc[nt][reg];
    __syncthreads();
    {
        const int idx = F.tid * 4, r = idx >> 7, n = idx & 127;
        f32x4 s = *(const f32x4*)(F.CBIAS + kv * 128 + n);
#pragma unroll
        for (int ww = 0; ww < 8; ++ww) s += *(const LAS f32x4*)(red + (ww * 16 + r) * 128 + n);
        float o[4];
#pragma unroll
        for (int i = 0; i < 4; ++i) { const float x = s[i]; const float u2 = 2.0f * 0.7978845608028654f * (x + 0.044715f * x * x * x);
            const float th = 1.0f - 2.0f * __builtin_amdgcn_rcpf(fexp(u2) + 1.0f); o[i] = 0.5f * x * (1.0f + th); }
        u32x2 pw; pw.x = cvtpk(o[0], o[1]); pw.y = cvtpk(o[2], o[3]);
        *(LAS u32x2*)(hidb + r * 136 + n) = pw;
    }
    __syncthreads();
    if (w < 4) {
        f32x4 a2 = (f32x4){0.f, 0.f, 0.f, 0.f};
#pragma unroll
        for (int ks = 0; ks < 4; ++ks) { const bf16x8 a = *(const LAS bf16x8*)(hidb + q * 136 + 32 * ks + 8 * gl);
            const bf16x8 bw = *(const bf16x8*)(W2 + (size_t)(16 * w + q) * 128 + 32 * ks + 8 * gl); a2 = MFMA16(a, bw, a2); }
        const int d = 16 * w + q;
#pragma unroll
        for (int reg = 0; reg < 4; ++reg) { const int i = 16 * rg + 4 * gl + reg; const bf16 val = (i <= 126) ? f2b(a2[reg]) : (bf16)0;
            if (kv == 0) F.KC[((size_t)(b * 2 + g) * 128 + i) * 64 + d] = val; else F.VTC[((size_t)(b * 2 + g) * 64 + d) * 128 + i] = val; }
    }
    __syncthreads();
}

__device__ __forceinline__ void gla_prep(Frame& F, int b, int h, int n, LAS float* bm, LAS float* seg) {
    const int tid = F.tid, d = tid & 63, sg = tid >> 6;
    const float* wa = F.in[13] + h * 64 + d;
    float w[16];
#pragma unroll
    for (int r = 0; r < 16; ++r) w[r] = wa[r * 256];
    const float ba = F.in[14][h * 64 + d];
    float c[8]; float run = 0.f;
#pragma unroll
    for (int i = 0; i < 8; ++i) {
        const size_t row = (size_t)b * T + 64 * n + 8 * sg + i;
        const bf16* gp = F.PROJ + row * NP + C_GA;
        const v4u g0 = *(const v4u*)gp, g1 = *(const v4u*)(gp + 8);
        float z = ba;
        z += blo(g0.x) * w[0] + bhi(g0.x) * w[1] + blo(g0.y) * w[2] + bhi(g0.y) * w[3] + blo(g0.z) * w[4] + bhi(g0.z) * w[5] + blo(g0.w) * w[6] + bhi(g0.w) * w[7];
        z += blo(g1.x) * w[8] + bhi(g1.x) * w[9] + blo(g1.y) * w[10] + bhi(g1.y) * w[11] + blo(g1.z) * w[12] + bhi(g1.z) * w[13] + blo(g1.w) * w[14] + bhi(g1.w) * w[15];
        const float ls = fminf(z, 0.f) - __logf(1.0f + __expf(-fabsf(z)));
        run += ls * (1.0f / 16.0f); c[i] = run;
    }
    seg[sg * 64 + d] = run; __syncthreads();
    float pre = 0.f;
#pragma unroll
    for (int s2 = 0; s2 < 7; ++s2) pre += (s2 < sg) ? seg[s2 * 64 + d] : 0.f;
#pragma unroll
    for (int i = 0; i < 8; ++i) bm[(8 * sg + i) * 65 + d] = pre + c[i];
    __syncthreads();
}
__device__ __forceinline__ void gla_load_vt(Frame& F, size_t row, int h, int j, int c8, LAS bf16* VTl) {
    const bf16* vp = F.PROJ + row * NP + C_GV + h * 128 + 16 * c8;
    const v4u v0 = *(const v4u*)vp, v1 = *(const v4u*)(vp + 8);
    LAS bf16* dst = VTl + (16 * c8) * 72 + j;
    dst[0 * 72] = (bf16)(v0.x & 0xffffu); dst[1 * 72] = (bf16)(v0.x >> 16); dst[2 * 72] = (bf16)(v0.y & 0xffffu); dst[3 * 72] = (bf16)(v0.y >> 16);
    dst[4 * 72] = (bf16)(v0.z & 0xffffu); dst[5 * 72] = (bf16)(v0.z >> 16); dst[6 * 72] = (bf16)(v0.w & 0xffffu); dst[7 * 72] = (bf16)(v0.w >> 16);
    dst[8 * 72] = (bf16)(v1.x & 0xffffu); dst[9 * 72] = (bf16)(v1.x >> 16); dst[10 * 72] = (bf16)(v1.y & 0xffffu); dst[11 * 72] = (bf16)(v1.y >> 16);
    dst[12 * 72] = (bf16)(v1.z & 0xffffu); dst[13 * 72] = (bf16)(v1.z >> 16); dst[14 * 72] = (bf16)(v1.w & 0xffffu); dst[15 * 72] = (bf16)(v1.w >> 16);
}
__device__ __forceinline__ void m1_gla_kv(Frame& F, int item) {
    const int n = item & 31, h = (item >> 5) & 3, b = item >> 7;
    const int lane = F.lane, q = lane & 15, gl = lane >> 4, w = F.wave, tid = F.tid;
    LAS float* bm = (LAS float*)(F.lds + RING_OFF); LAS float* seg = (LAS float*)(F.lds + RING_OFF + 16640);
    LAS bf16* KstT = (LAS bf16*)(F.lds + RING_OFF + 18688); LAS bf16* VTl = (LAS bf16*)(F.lds + RING_OFF + 27904);
    gla_prep(F, b, h, n, bm, seg);
    const int j = tid >> 3, c8 = tid & 7; const size_t row = (size_t)b * T + 64 * n + j;
    {
        const v4u kk = *(const v4u*)(F.PROJ + row * NP + C_GK + h * 64 + 8 * c8);
        float kf[8] = {blo(kk.x), bhi(kk.x), blo(kk.y), bhi(kk.y), blo(kk.z), bhi(kk.z), blo(kk.w), bhi(kk.w)};
#pragma unroll
        for (int i = 0; i < 8; ++i) { const int d = 8 * c8 + i; const float e = fexp(bm[63 * 65 + d] - bm[j * 65 + d]); KstT[d * 72 + j] = f2b(kf[i] * e); }
    }
    gla_load_vt(F, row, h, j, c8, VTl);
    __syncthreads();
#pragma unroll
    for (int dt = 0; dt < 4; ++dt) {
        f32x4 acc = (f32x4){0.f, 0.f, 0.f, 0.f};
#pragma unroll
        for (int ks = 0; ks < 2; ++ks) { const bf16x8 a = *(const LAS bf16x8*)(KstT + (16 * dt + q) * 72 + 32 * ks + 8 * gl);
            const bf16x8 bv = *(const LAS bf16x8*)(VTl + (16 * w + q) * 72 + 32 * ks + 8 * gl); acc = MFMA16(a, bv, acc); }
        *(f32x4*)(F.KVT + ((size_t)item * 128 + 16 * w + q) * 64 + 16 * dt + 4 * gl) = acc;
    }
    if (tid < 64) F.DEC[(size_t)item * 64 + tid] = fexp(bm[63 * 65 + tid]);
    __syncthreads();
}
__device__ __forceinline__ void m1_transpose(Frame& F, int ti) {
    const int which = ti >> 9, rem = ti & 511, b = rem >> 6, g = (rem >> 5) & 1, tt = rem & 31;
    const bf16* src = F.PROJ + ((size_t)b * T + 64 * tt + F.lane) * NP + (which ? C_VW : C_VS) + g * 64;
    v4u x[8];
#pragma unroll
    for (int i = 0; i < 8; ++i) x[i] = *(const v4u*)(src + 8 * i);
    bf16* dst = (which ? F.VTW : F.VTS) + ((size_t)(b * 2 + g) * 64) * T + 64 * tt + F.lane;
#pragma unroll
    for (int d = 0; d < 64; ++d) { const unsigned wv = x[d >> 3][(d >> 1) & 3]; dst[(size_t)d * T] = (bf16)((d & 1) ? (wv >> 16) : (wv & 0xffffu)); }
}
__device__ __forceinline__ void m2_scan(Frame& F, int si) {
    const int bh = si >> 5, part = si & 31, qd = part * 64 + F.lane, v = qd >> 4, dq = qd & 15;
    f32x4 S = (f32x4){0.f, 0.f, 0.f, 0.f};
#pragma unroll 8
    for (int n = 0; n < 32; ++n) {
        const size_t item = (size_t)bh * 32 + n;
        const f32x4 kvv = *(const f32x4*)(F.KVT + (item * 128 + v) * 64 + 4 * dq);
        const f32x4 dc = *(const f32x4*)(F.DEC + item * 64 + 4 * dq);
        u32x2 wv; wv.x = cvtpk(S[0], S[1]); wv.y = cvtpk(S[2], S[3]);
        *(u32x2*)(F.ST + (item * 128 + v) * 64 + 4 * dq) = wv;
        S = S * dc + kvv;
    }
}
__device__ __forceinline__ void m3_gla_out(Frame& F, int item) {
    const int n = item & 31, h = (item >> 5) & 3, b = item >> 7;
    const int lane = F.lane, q = lane & 15, gl = lane >> 4, w = F.wave, tid = F.tid;
    LAS float* bm = (LAS float*)(F.lds + RING_OFF); LAS float* seg = (LAS float*)(F.lds + RING_OFF + 16640);
    LAS bf16* Qin = (LAS bf16*)(F.lds + RING_OFF + 18688); LAS bf16* Kin = (LAS bf16*)(F.lds + RING_OFF + 27904);
    LAS bf16* VTl = (LAS bf16*)(F.lds + RING_OFF + 37120); LAS bf16* Am = (LAS bf16*)(F.lds + RING_OFF + 55552);
    LAS float* ssqw = (LAS float*)(F.lds + RING_OFF + 64768);
    gla_prep(F, b, h, n, bm, seg);
    const int j = tid >> 3, c8 = tid & 7; const size_t row = (size_t)b * T + 64 * n + j;
    {
        const v4u qq = *(const v4u*)(F.PROJ + row * NP + C_GQ + h * 64 + 8 * c8);
        const v4u kk = *(const v4u*)(F.PROJ + row * NP + C_GK + h * 64 + 8 * c8);
        float qf[8] = {blo(qq.x), bhi(qq.x), blo(qq.y), bhi(qq.y), blo(qq.z), bhi(qq.z), blo(qq.w), bhi(qq.w)};
        float kf[8] = {blo(kk.x), bhi(kk.x), blo(kk.y), bhi(kk.y), blo(kk.z), bhi(kk.z), blo(kk.w), bhi(kk.w)};
#pragma unroll
        for (int i = 0; i < 8; ++i) { const float bb = bm[j * 65 + 8 * c8 + i]; qf[i] = qf[i] * 0.125f * fexp(bb); kf[i] = kf[i] * fexp(-bb); }
        v4u pq, pk; pq.x = cvtpk(qf[0], qf[1]); pq.y = cvtpk(qf[2], qf[3]); pq.z = cvtpk(qf[4], qf[5]); pq.w = cvtpk(qf[6], qf[7]);
        pk.x = cvtpk(kf[0], kf[1]); pk.y = cvtpk(kf[2], kf[3]); pk.z = cvtpk(kf[4], kf[5]); pk.w = cvtpk(kf[6], kf[7]);
        *(LAS v4u*)(Qin + j * 72 + 8 * c8) = pq; *(LAS v4u*)(Kin + j * 72 + 8 * c8) = pk;
    }
    gla_load_vt(F, row, h, j, c8, VTl);
    __syncthreads();
    {
        const int it = w >> 1;
#pragma unroll
        for (int jj = 0; jj < 2; ++jj) { const int jt = 2 * (w & 1) + jj; f32x4 a = (f32x4){0.f, 0.f, 0.f, 0.f};
            if (jt <= it) {
#pragma unroll
                for (int ks = 0; ks < 2; ++ks) a = MFMA16(*(const LAS bf16x8*)(Qin + (16 * it + q) * 72 + 32 * ks + 8 * gl), *(const LAS bf16x8*)(Kin + (16 * jt + q) * 72 + 32 * ks + 8 * gl), a);
            }
#pragma unroll
            for (int reg = 0; reg < 4; ++reg) { const int i = 16 * it + 4 * gl + reg, jx = 16 * jt + q; Am[i * 72 + jx] = (i >= jx) ? f2b(a[reg]) : (bf16)0; } }
    }
    __syncthreads();
    f32x4 acc[4];
#pragma unroll
    for (int it = 0; it < 4; ++it) acc[it] = (f32x4){0.f, 0.f, 0.f, 0.f};
#pragma unroll
    for (int ks = 0; ks < 2; ++ks) {
        const bf16x8 bv = *(const LAS bf16x8*)(VTl + (16 * w + q) * 72 + 32 * ks + 8 * gl);
        const bf16x8 bs = *(const bf16x8*)(F.ST + ((size_t)item * 128 + 16 * w + q) * 64 + 32 * ks + 8 * gl);
#pragma unroll
        for (int it = 0; it < 4; ++it) { acc[it] = MFMA16(*(const LAS bf16x8*)(Am + (16 * it + q) * 72 + 32 * ks + 8 * gl), bv, acc[it]);
            acc[it] = MFMA16(*(const LAS bf16x8*)(Qin + (16 * it + q) * 72 + 32 * ks + 8 * gl), bs, acc[it]); }
    }
#pragma unroll
    for (int it = 0; it < 4; ++it)
#pragma unroll
        for (int reg = 0; reg < 4; ++reg) { float s = acc[it][reg] * acc[it][reg]; s += __shfl_xor(s, 1); s += __shfl_xor(s, 2); s += __shfl_xor(s, 4); s += __shfl_xor(s, 8);
            if (q == 0) ssqw[w * 64 + 16 * it + 4 * gl + reg] = s; }
    __syncthreads();
    const float gg = F.in[15][16 * w + q];
#pragma unroll
    for (int it = 0; it < 4; ++it)
#pragma unroll
        for (int reg = 0; reg < 4; ++reg) { const int i = 16 * it + 4 * gl + reg; float tot = 0.f;
#pragma unroll
            for (int w2 = 0; w2 < 8; ++w2) tot += ssqw[w2 * 64 + i];
            const float rs = __builtin_amdgcn_rsqf(tot * (1.0f / 128.0f) + RMS_EPS);
            const size_t r2 = (size_t)b * T + 64 * n + i;
            const float gr = bf2f(F.PROJ[r2 * NP + C_GR + h * 128 + 16 * w + q]);
            const float sl = gr * __builtin_amdgcn_rcpf(1.0f + fexp(-gr));
            F.MIX[r2 * 1024 + 512 + h * 128 + 16 * w + q] = f2b(acc[it][reg] * rs * gg * sl); }
    __syncthreads();
}

template <int MODE>
__device__ __forceinline__ void nsa_branch(const bf16* Pq  , const bf16* Pg  , const bf16* Kb, const bf16* VTb,
                                           int pair, int t0, int t, int q, int gl, int g, unsigned mask, LAS float* wl, int lane) {
    unsigned voK = (unsigned)(q * NP + 8 * gl) * 2u, voV = (unsigned)(q * T + 4 * gl) * 2u;
    bf16x8 qf[2][2];
#pragma unroll
    for (int rr = 0; rr < 2; ++rr)
#pragma unroll
        for (int ks = 0; ks < 2; ++ks) qf[rr][ks] = ldb16(Pq + (2 * pair + rr) * 64 + 32 * ks, voK);
    float m[2], ls[2], slope[2]; f32x4 O[2][4];
#pragma unroll
    for (int rr = 0; rr < 2; ++rr) { m[rr] = -1e30f; ls[rr] = 0.f; slope[rr] = __builtin_amdgcn_exp2f(-(float)(4 * g + 2 * pair + rr + 1));
#pragma unroll
        for (int dt = 0; dt < 4; ++dt) O[rr][dt] = (f32x4){0.f, 0.f, 0.f, 0.f}; }
    const int kend = t0 + 15;
    int kstart = 0;
    if (MODE == 1) { kstart = (t0 - 511) & ~31; kstart = kstart < 0 ? 0 : kstart; }
    for (int key0 = kstart; key0 <= kend; key0 += 32) {
        const bool sel = (MODE == 0) ? (((mask >> (key0 >> 6)) & 1u) != 0u) : true;
        if (MODE == 0) { if (__ballot(sel) == 0ull) continue; }
        bf16x8 kf[2][2], vf[4];
        OPAQUE(voK); OPAQUE(voV);
        const bf16* ku = Kb + (size_t)key0 * NP; const bf16* vu = VTb + key0;
#pragma unroll
        for (int kt = 0; kt < 2; ++kt)
#pragma unroll
            for (int ks = 0; ks < 2; ++ks) kf[kt][ks] = ldb16(ku + (16 * kt * NP + 32 * ks), voK);
#pragma unroll
        for (int dt = 0; dt < 4; ++dt) vf[dt] = ldb8x2(vu + 16 * dt * T, voV);
#pragma unroll
        for (int rr = 0; rr < 2; ++rr) {
            const f32x4 z = (f32x4){0.f, 0.f, 0.f, 0.f};
            f32x4 s0 = MFMA16(kf[0][0], qf[rr][0], z); s0 = MFMA16(kf[0][1], qf[rr][1], s0);
            f32x4 s1 = MFMA16(kf[1][0], qf[rr][0], z); s1 = MFMA16(kf[1][1], qf[rr][1], s1);
            float tmax = -1e30f;
#pragma unroll
            for (int reg = 0; reg < 4; ++reg) {
                const int d0 = t - (key0 + 4 * gl + reg), d1 = d0 - 16;
                const bool ok0 = sel && d0 >= 0 && (MODE == 0 || d0 < 512), ok1 = sel && d1 >= 0 && (MODE == 0 || d1 < 512);
                s0[reg] = ok0 ? s0[reg] * 0.125f - slope[rr] * (float)d0 : -1e30f; s1[reg] = ok1 ? s1[reg] * 0.125f - slope[rr] * (float)d1 : -1e30f;
                tmax = fmaxf(tmax, fmaxf(s0[reg], s1[reg]));
            }
            tmax = fmaxf(tmax, __shfl_xor(tmax, 16)); tmax = fmaxf(tmax, __shfl_xor(tmax, 32));
            const float mn = fmaxf(m[rr], tmax), alpha = fexp(m[rr] - mn); m[rr] = mn;
            float ps = 0.f;
#pragma unroll
            for (int reg = 0; reg < 4; ++reg) { s0[reg] = (s0[reg] > -1e29f) ? fexp(s0[reg] - mn) : 0.f; s1[reg] = (s1[reg] > -1e29f) ? fexp(s1[reg] - mn) : 0.f; ps += s0[reg] + s1[reg]; }
            ls[rr] = ls[rr] * alpha + ps;
            const bf16x8 pb = pack8(s0, s1);
#pragma unroll
            for (int dt = 0; dt < 4; ++dt) { O[rr][dt] *= alpha; O[rr][dt] = MFMA16(vf[dt], pb, O[rr][dt]); }
        }
    }
#pragma unroll
    for (int rr = 0; rr < 2; ++rr) { const int r = 2 * pair + rr; float l = ls[rr]; l += __shfl_xor(l, 16); l += __shfl_xor(l, 32);
        const float gate = __builtin_amdgcn_rcpf(1.0f + fexp(-ldb_bf(Pg + r * 3 + 1 + MODE, (unsigned)(q * NP) * 2u)));
        const float sc = gate * __builtin_amdgcn_rcpf(l);
#pragma unroll
        for (int dt = 0; dt < 4; ++dt) { LAS f32x4* slot = (LAS f32x4*)wl + (r * 4 + dt) * 64 + lane; *slot = *slot + O[rr][dt] * sc; } }
}
__device__ __forceinline__ void m2_nsa(Frame& F, int b, int g, int tg) {
    const int lane = F.lane, q = lane & 15, gl = lane >> 4;
    const int t0 = tg * 16, t = t0 + q;
    const bf16* Pr = F.PROJ + ((size_t)b * T + t0) * NP;
    const bf16* Pq = Pr + C_Q + 4 * g * 64; const bf16* Pg = Pr + C_GN + 4 * g * 3;
    LAS float* wl = (LAS float*)(F.lds + RING_OFF + F.wave * 16384);
    const float tf = (float)t;
    unsigned mask;
    {
        f32x4 psum[8];
#pragma unroll
        for (int nt = 0; nt < 8; ++nt) psum[nt] = (f32x4){0.f, 0.f, 0.f, 0.f};
        const bf16* KC = F.KC + (size_t)(b * 2 + g) * 128 * 64; const bf16* VTC = F.VTC + (size_t)(b * 2 + g) * 64 * 128;
        unsigned voQ = (unsigned)(q * NP + 8 * gl) * 2u, voKC = (unsigned)(q * 64 + 8 * gl) * 2u, voVC = (unsigned)(q * 128 + 4 * gl) * 2u;
#pragma unroll 1
        for (int r = 0; r < 4; ++r) {
            OPAQUE(voQ); OPAQUE(voKC); OPAQUE(voVC);
            const bf16x8 qf0 = ldb16(Pq + r * 64, voQ), qf1 = ldb16(Pq + r * 64 + 32, voQ);
            const float slope = __builtin_amdgcn_exp2f(-(float)(4 * g + r + 1));
            f32x4 S[8]; const f32x4 z = (f32x4){0.f, 0.f, 0.f, 0.f};
#pragma unroll
            for (int nt = 0; nt < 8; ++nt) { const bf16* kp = KC + 16 * nt * 64; S[nt] = MFMA16(ldb16(kp, voKC), qf0, z); S[nt] = MFMA16(ldb16(kp + 32, voKC), qf1, S[nt]); if (nt & 1) __builtin_amdgcn_sched_barrier(0); }
            float mx = -1e30f;
#pragma unroll
            for (int nt = 0; nt < 8; ++nt)
#pragma unroll
                for (int reg = 0; reg < 4; ++reg) { const int n = 16 * nt + 4 * gl + reg; const bool valid = (16 * n + 31 <= t);
                    const float s = S[nt][reg] * 0.125f - slope * (tf - (16.0f * (float)n + 15.5f)); S[nt][reg] = valid ? s : -1e30f; mx = fmaxf(mx, S[nt][reg]); }
            mx = fmaxf(mx, __shfl_xor(mx, 16)); mx = fmaxf(mx, __shfl_xor(mx, 32));
            float sum = 0.f;
#pragma unroll
            for (int nt = 0; nt < 8; ++nt)
#pragma unroll
                for (int reg = 0; reg < 4; ++reg) { const float p = (S[nt][reg] > -1e29f) ? fexp(S[nt][reg] - mx) : 0.f; S[nt][reg] = p; sum += p; }
            sum += __shfl_xor(sum, 16); sum += __shfl_xor(sum, 32);
            const float inv = sum > 0.f ? 1.0f / sum : 0.f;
#pragma unroll
            for (int nt = 0; nt < 8; ++nt) { S[nt] = S[nt] * inv; psum[nt] += S[nt]; }
            f32x4 oc[4];
#pragma unroll
            for (int dt = 0; dt < 4; ++dt) oc[dt] = (f32x4){0.f, 0.f, 0.f, 0.f};
#pragma unroll
            for (int kp = 0; kp < 4; ++kp) { const bf16x8 pb = pack8(S[2 * kp], S[2 * kp + 1]);
#pragma unroll
                for (int dt = 0; dt < 4; ++dt) oc[dt] = MFMA16(ldb8x2(VTC + 16 * dt * 128 + 32 * kp, voVC), pb, oc[dt]); __builtin_amdgcn_sched_barrier(0); }
            const float gate = __builtin_amdgcn_rcpf(1.0f + fexp(-ldb_bf(Pg + r * 3, (unsigned)(q * NP) * 2u)));
#pragma unroll
            for (int dt = 0; dt < 4; ++dt) *((LAS f32x4*)wl + (r * 4 + dt) * 64 + lane) = oc[dt] * gate;
        }
        const int cur = t0 >> 6;
        if (cur <= 7) mask = (2u << cur) - 1u;
        else {
            float v[8]; float shp = 0.f;
#pragma unroll
            for (int nt = 0; nt < 8; ++nt) { const float sh = __shfl(psum[nt][3], (lane + 48) & 63);
                const float pterm = (gl > 0) ? sh : shp; shp = sh;
                v[nt] = pterm + ((psum[nt][0] + psum[nt][1]) + (psum[nt][2] + psum[nt][3])); }
            mask = 1u | (1u << cur) | (1u << (cur - 1));
            unsigned taken = 0u;
#pragma unroll
            for (int round = 0; round < 5; ++round) {
                float bv = -1.f; int bi = 99;
#pragma unroll
                for (int i = 0; i < 8; ++i) { const int s = 4 * i + gl; const bool ok = (s >= 1) && (s <= cur - 2) && (((taken >> i) & 1u) == 0u); if (ok && v[i] > bv) { bv = v[i]; bi = s; } }
#pragma unroll
                for (int off = 16; off <= 32; off <<= 1) { const float ov = __shfl_xor(bv, off); const int oi = __shfl_xor(bi, off); if (ov > bv || (ov == bv && oi < bi)) { bv = ov; bi = oi; } }
                if (bi < 32) { mask |= 1u << bi; if ((bi & 3) == gl) taken |= 1u << (bi >> 2); }
            }
        }
    }
    const bf16* Ks = F.PROJ + (size_t)b * T * NP + C_KS + g * 64; const bf16* Kw = F.PROJ + (size_t)b * T * NP + C_KW + g * 64;
    const bf16* VTs = F.VTS + (size_t)(b * 2 + g) * 64 * T; const bf16* VTw = F.VTW + (size_t)(b * 2 + g) * 64 * T;
#pragma unroll 1
    for (int pair = 0; pair < 2; ++pair) {
        nsa_branch<0>(Pq, Pg, Ks, VTs, pair, t0, t, q, gl, g, mask, wl, lane);
        nsa_branch<1>(Pq, Pg, Kw, VTw, pair, t0, t, q, gl, g, 0u, wl, lane);
    }
    bf16* Mo = F.MIX + ((size_t)b * T + t0) * 1024 + 4 * g * 64; const unsigned voM = (unsigned)(q * 1024 + 4 * gl) * 2u;
#pragma unroll
    for (int r = 0; r < 4; ++r)
#pragma unroll
        for (int dt = 0; dt < 4; ++dt) { const f32x4 o = *((const LAS f32x4*)wl + (r * 4 + dt) * 64 + lane); u32x2 wv; wv.x = cvtpk(o[0], o[1]); wv.y = cvtpk(o[2], o[3]);
            *(u32x2*)((char*)(Mo + r * 64 + 16 * dt) + voM) = wv; }
    WAVE_LDS_FENCE();
}

__device__ __forceinline__ void p8_final_norm(Frame& F) {
    const int gw = F.vcu * NWAVES + F.wave, NGW = F.G * NWAVES;
    const GAS f32x4* gp = (const GAS f32x4*)F.in[21] + F.lane;
    f32x4 gv[4];
#pragma unroll
    for (int j = 0; j < 4; ++j) gv[j] = gp[64 * j];
    for (int m = gw; m < M; m += NGW) {
        GAS f32x4* xr = (GAS f32x4*)(F.out + (size_t)m * D) + F.lane;
        f32x4 v[4]; float s = 0.f;
#pragma unroll
        for (int j = 0; j < 4; ++j) { v[j] = xr[64 * j]; s += (v[j].x * v[j].x + v[j].y * v[j].y) + (v[j].z * v[j].z + v[j].w * v[j].w); }
        const float rs = __builtin_amdgcn_rsqf(wave_sum(s) * (1.0f / 1024.0f) + RMS_EPS);
#pragma unroll
        for (int j = 0; j < 4; ++j) xr[64 * j] = v[j] * rs * gv[j];
    }
}

struct Args { const float* in[22]; float* out; unsigned char* ws; };
__global__ void __launch_bounds__(NWAVES * 64, 2) hybrid_fwd(Args args) {
    extern __shared__ __attribute__((aligned(16))) unsigned char lds[];
    Frame F;
    F.lds = (LAS unsigned char*)lds;
    F.MISC = (volatile LAS unsigned*)(F.lds + MISC_OFF);
    F.tid = threadIdx.x; F.lane = F.tid & 63; F.wave = __builtin_amdgcn_readfirstlane(F.tid >> 6);
    F.G = gridDim.x; { const int bx = blockIdx.x; F.vcu = (F.G % 8 == 0) ? (bx % 8) * (F.G / 8) + bx / 8 : bx; }
    unsigned char* ws = args.ws;
    F.ctl = (gu32*)(ws + WS_CTL);
#pragma unroll
    for (int i = 0; i < 22; ++i) F.in[i] = args.in[i];
    F.out = args.out;
    F.W1GU = (bf16*)(ws + WS_W1GU); F.W1D = (bf16*)(ws + WS_W1D); F.WIN = (bf16*)(ws + WS_WIN); F.WOUT = (bf16*)(ws + WS_WOUT); F.W2GU = (bf16*)(ws + WS_W2GU); F.W2D = (bf16*)(ws + WS_W2D);
    F.WC1K = (bf16*)(ws + WS_WC1K); F.WC1V = (bf16*)(ws + WS_WC1V); F.WC2K = (bf16*)(ws + WS_WC2K); F.WC2V = (bf16*)(ws + WS_WC2V);
    F.KC = (bf16*)(ws + WS_KC); F.VTC = (bf16*)(ws + WS_VTC); F.XB = (bf16*)(ws + WS_XB); F.H = (bf16*)(ws + WS_R); F.PROJ = (bf16*)(ws + WS_R);
    F.MIX = (bf16*)(ws + WS_MIX); F.VTS = (bf16*)(ws + WS_VTS); F.VTW = (bf16*)(ws + WS_VTW); F.ST = (bf16*)(ws + WS_ST);
    F.CBIAS = (float*)(ws + WS_CBIAS); F.SSQ0 = (float*)(ws + WS_SSQ0); F.SSQA = (float*)(ws + WS_SSQA); F.SSQB = (float*)(ws + WS_SSQB); F.DEC = (float*)(ws + WS_DEC); F.KVT = (float*)(ws + WS_KVT);
    for (int u = F.tid; u < (LDS_BYTES - LDSCTL_OFF) / 4; u += NWAVES * 64) ((LAS unsigned*)(F.lds + LDSCTL_OFF))[u] = 0u;
    __syncthreads();
    XcdBarrier bar = xcd_barrier_post((unsigned*)(F.ctl + CW_BAR), F.MISC + 8);
#define GRID_BAR() do { xcd_barrier(bar); asm volatile("" : "+v"(F.tid)); F.lane = F.tid & 63; } while (0)
    const int gw = F.vcu * NWAVES + F.wave, NGW = F.G * NWAVES;

#ifndef NO_P0
    p0_prologue(F);
#endif
    GRID_BAR();
#ifndef NO_GEMM
    { pg8::Gemm g{F.XB, F.W1GU, M, 2 * FF, D}; pg8::StaticOrder S; S.init(M, 2 * FF, F.G, (int)blockIdx.x);
      pg8::EpiSwiGLU<1> E{F.H, FF, F.SSQ0};
      pg8::gemm_phase<pg8::EpiSwiGLU<1>, pg8::StaticOrder, true, true>(F.lds + RING_OFF, g, S, E); }
#endif
    GRID_BAR();
#ifndef NO_GEMM
    { pg8::Gemm g{F.H, F.W1D, M, D, FF}; pg8::StaticOrder S; S.init(M, D, F.G, (int)blockIdx.x);
      pg8::EpiResid<true> E{F.in[0], F.out, F.XB, F.SSQA, 0.5f};
      pg8::gemm_phase<pg8::EpiResid<true>, pg8::StaticOrder, true, true>(F.lds + RING_OFF, g, S, E); }
#endif
    GRID_BAR();
#ifndef NO_GEMM
    { pg8::Gemm g{F.XB, F.WIN, M, NP, D}; pg8::StaticOrder S; S.init(M, NP, F.G, (int)blockIdx.x);
      pg8::EpiProj<16> E{F.PROJ, NP, F.SSQA};
      pg8::gemm_phase<pg8::EpiProj<16>, pg8::StaticOrder, true, true>(F.lds + RING_OFF, g, S, E); }
#endif
    GRID_BAR();
#ifndef NO_M1
    for (int ci = F.vcu; ci < 256; ci += F.G) m1_compress(F, ci);
    for (int it = F.vcu; it < 1024; it += F.G) m1_gla_kv(F, it);
    for (int ti = gw; ti < 1024; ti += NGW) m1_transpose(F, ti);
#endif
    GRID_BAR();
#ifndef NO_NSA
    for (int wi = F.vcu; wi < 256; wi += F.G) { const int b = wi >> 5, g = (wi >> 4) & 1, qb = wi & 15; m2_nsa(F, b, g, 8 * qb + F.wave); }
#endif
#ifndef NO_SCAN
    for (int k = gw; k < 2048; k += NGW) { const int wi = k >> 3; if ((wi & 15) < 8) m2_scan(F, (((wi >> 4) * 8 + (wi & 15)) * 8) + (k & 7)); }
#endif
    GRID_BAR();
#ifndef NO_GLA3
    for (int it = F.vcu; it < 1024; it += F.G) m3_gla_out(F, it);
#endif
    GRID_BAR();
#ifndef NO_GEMM
    { pg8::Gemm g{F.MIX, F.WOUT, M, D, D}; pg8::StaticOrder S; S.init(M, D, F.G, (int)blockIdx.x);
      pg8::EpiResid<true> E{F.out, F.out, F.XB, F.SSQB, 1.0f};
      pg8::gemm_phase<pg8::EpiResid<true>, pg8::StaticOrder, true, true>(F.lds + RING_OFF, g, S, E); }
#endif
    GRID_BAR();
#ifndef NO_GEMM
    { pg8::Gemm g{F.XB, F.W2GU, M, 2 * FF, D}; pg8::StaticOrder S; S.init(M, 2 * FF, F.G, (int)blockIdx.x);
      pg8::EpiSwiGLU<16> E{F.H, FF, F.SSQB};
      pg8::gemm_phase<pg8::EpiSwiGLU<16>, pg8::StaticOrder, true, true>(F.lds + RING_OFF, g, S, E); }
#endif
    GRID_BAR();
#ifndef NO_GEMM
    { pg8::Gemm g{F.H, F.W2D, M, D, FF}; pg8::StaticOrder S; S.init(M, D, F.G, (int)blockIdx.x);
      pg8::EpiResid<false> E{F.out, F.out, nullptr, nullptr, 0.5f};
      pg8::gemm_phase<pg8::EpiResid<false>, pg8::StaticOrder, true, true>(F.lds + RING_OFF, g, S, E); }
#endif
    GRID_BAR();
#ifndef NO_P8
    p8_final_norm(F);
#endif
}

extern "C" void kernel_launch(void* const* d_in, const int* in_sizes, int n_in, void* d_out, int out_size, void* d_ws, size_t ws_size, hipStream_t stream) {
    static int grid = 0;
    if (grid == 0) {
        if (n_in != 22 || in_sizes[0] != M * D || out_size != M * D || ws_size < WS_END) { fprintf(stderr, "kernel_launch: unexpected shapes (n_in %d, in0 %d, out %d, ws %zu); nothing launched\n", n_in, n_in > 0 ? in_sizes[0] : -1, out_size, ws_size); grid = -1; return; }
        int dev = 0, cus = 0;
        if (hipGetDevice(&dev) != hipSuccess || hipDeviceGetAttribute(&cus, hipDeviceAttributeMultiprocessorCount, dev) != hipSuccess) { fprintf(stderr, "kernel_launch: device query failed\n"); grid = -1; return; }
        if (hipFuncSetAttribute((const void*)hybrid_fwd, hipFuncAttributeMaxDynamicSharedMemorySize, LDS_BYTES) != hipSuccess) { fprintf(stderr, "kernel_launch: hipFuncSetAttribute failed\n"); grid = -1; return; }
        (void)hipGetLastError();
        grid = cus;
    }
    if (grid < 0) return;
    if (hipMemsetAsync((char*)d_ws + WS_CTL, 0, CTL_ZERO_BYTES, stream) != hipSuccess) { fprintf(stderr, "kernel_launch: hipMemsetAsync failed\n"); return; }
    Args a{};
    for (int i = 0; i < 22; ++i) a.in[i] = (const float*)d_in[i];
    a.out = (float*)d_out; a.ws = (unsigned char*)d_ws;
    hipLaunchKernelGGL(hybrid_fwd, dim3(grid), dim3(NWAVES * 64), LDS_BYTES, stream, a);
}
```

```cpp
#include <hip/hip_runtime.h>
#include <cstdio>
#include <cstdint>
namespace pg8 {
#define PG8_LAS __attribute__((address_space(3)))
typedef unsigned short bf16_t;
typedef short bf16x8 __attribute__((ext_vector_type(8)));
typedef float f32x4 __attribute__((ext_vector_type(4)));
typedef unsigned u32x4 __attribute__((ext_vector_type(4)));
constexpr int BM = 256, BK = 64, HALF = 128, HTB = HALF * BK * 2  , STAGE_BYTES = 8 * HTB, NXCD = 8, WGM = 8;

__host__ __device__ __forceinline__ int lds_byte(int r, int c) { const int st = (r >> 4) * 2 + (c >> 5), rr = r & 15, cc = c & 31, ob = rr * 64 + cc * 2; return st * 1024 + (ob ^ (((ob >> 9) & 1) << 5)); }
__host__ __device__ __forceinline__ void stage_rc(int b, int& R, int& C) { const int st = b / 1024, sb = b % 1024, swz = sb ^ (((sb >> 9) & 1) << 5); R = (st >> 1) * 16 + swz / 64; C = (st & 1) * 32 + (swz % 64) / 2; }
__host__ __device__ __forceinline__ int perm32(int rho) { const int n = rho >> 4, i = rho & 15; return 8 * (i >> 2) + 4 * n + (i & 3); }

struct Unit { int pm, pn; };
struct Gemm { const bf16_t* A; const bf16_t* Bt; int M, N, K; };

struct StaticOrder {
    int nM, nN, nwg, G, c;
    __host__ __device__ void init(int M, int N, int G_, int c_) { nM = M / BM; nN = N / BM; nwg = nM * nN; G = G_; c = c_; }
    __host__ __device__ bool next(int i, Unit& u) const {
        const long L = (long)i * G + c; if (L >= nwg) return false;
        int wgid = (int)L; { const int q = nwg / NXCD, r = nwg % NXCD, xcd = wgid % NXCD, off = wgid / NXCD; wgid = (xcd < r ? xcd * (q + 1) : r * (q + 1) + (xcd - r) * q) + off; }
        const int nig = WGM * nN, gid = wgid / nig, fm = gid * WGM, gsz = (nM - fm) < WGM ? (nM - fm) : WGM;
        u.pm = fm + ((wgid % nig) % gsz); u.pn = (wgid % nig) / gsz; return true;
    }
    __device__ __forceinline__ void a_ready(const Unit&) const {}
    __device__ __forceinline__ void done(const Unit&) const {}
};
__device__ __forceinline__ unsigned cvt_pk_bf16(float lo, float hi) { unsigned r; asm volatile("v_cvt_pk_bf16_f32 %0, %1, %2" : "=v"(r) : "v"(lo), "v"(hi)); return r; }
typedef float f32x2 __attribute__((ext_vector_type(2)));
typedef unsigned u32x2 __attribute__((ext_vector_type(2)));
constexpr float RMS_EPS = 1e-6f;
template <int NPARTS> __device__ __forceinline__ float row_rstd(const float* ssq, int row) {
    float s;
    if (NPARTS == 1) s = ssq[row];
    else { const f32x4* p = (const f32x4*)(ssq + (size_t)row * 16); const f32x4 a = p[0], b = p[1], c = p[2], d = p[3]; const f32x4 t = (a + b) + (c + d); s = (t[0] + t[1]) + (t[2] + t[3]); }
    return __builtin_amdgcn_rsqf(s * (1.0f / 1024.0f) + RMS_EPS);
}
__device__ __forceinline__ float silu_f(float x) { return x * __builtin_amdgcn_rcpf(1.0f + __builtin_amdgcn_exp2f(-1.4426950408889634f * x)); }
template <int NPARTS> struct EpiSwiGLU {
    static constexpr bool PERM = true, AFTER_DRAIN = false;
    bf16_t* H; int ldh; const float* ssq;
    __device__ __forceinline__ void operator()(const f32x4 (&acc)[2][2][4][2], const Unit& u, int wr, int wc, int fr, int fq) const {
        const int row0 = u.pm * BM + wr * 64 + fr, col0 = u.pn * 128 + wc * 32 + 8 * fq;
#pragma unroll
        for (int ai = 0; ai < 2; ++ai)
#pragma unroll
            for (int m = 0; m < 4; ++m) { const int row = row0 + ai * HALF + m * 16; const float rs = row_rstd<NPARTS>(ssq, row);
                const f32x4 g0 = acc[ai][0][m][0] * rs, g1 = acc[ai][0][m][1] * rs, u0 = acc[ai][1][m][0] * rs, u1 = acc[ai][1][m][1] * rs;
                u32x4 w;
                w.x = cvt_pk_bf16(silu_f(g0[0]) * u0[0], silu_f(g0[1]) * u0[1]); w.y = cvt_pk_bf16(silu_f(g0[2]) * u0[2], silu_f(g0[3]) * u0[3]);
                w.z = cvt_pk_bf16(silu_f(g1[0]) * u1[0], silu_f(g1[1]) * u1[1]); w.w = cvt_pk_bf16(silu_f(g1[2]) * u1[2], silu_f(g1[3]) * u1[3]);
                *(u32x4*)(H + (size_t)row * ldh + col0) = w; if (m & 1) asm volatile("" ::: "memory"); }
    }
};
template <int NPARTS> struct EpiProj {
    static constexpr bool PERM = true, AFTER_DRAIN = false;
    bf16_t* O; int ldc; const float* ssq;
    __device__ __forceinline__ void operator()(const f32x4 (&acc)[2][2][4][2], const Unit& u, int wr, int wc, int fr, int fq) const {
        const int row0 = u.pm * BM + wr * 64 + fr, col0 = u.pn * BM + wc * 32 + 8 * fq;
#pragma unroll
        for (int ai = 0; ai < 2; ++ai)
#pragma unroll
            for (int m = 0; m < 4; ++m) { const int row = row0 + ai * HALF + m * 16; const float rs = row_rstd<NPARTS>(ssq, row);
#pragma unroll
                for (int bj = 0; bj < 2; ++bj) { const f32x4 v0 = acc[ai][bj][m][0] * rs, v1 = acc[ai][bj][m][1] * rs; u32x4 w;
                    w.x = cvt_pk_bf16(v0[0], v0[1]); w.y = cvt_pk_bf16(v0[2], v0[3]); w.z = cvt_pk_bf16(v1[0], v1[1]); w.w = cvt_pk_bf16(v1[2], v1[3]);
                    *(u32x4*)(O + (size_t)row * ldc + col0 + bj * HALF) = w; } if (m & 1) asm volatile("" ::: "memory"); }
    }
};
template <bool WB> struct EpiResid {
    static constexpr bool PERM = false, AFTER_DRAIN = false;
    const float* rin; float* out; bf16_t* xb; float* ssqp; float alpha;
    __device__ __forceinline__ void operator()(const f32x4 (&acc)[2][2][4][2], const Unit& u, int wr, int wc, int fr, int fq) const {
        const int row0 = u.pm * BM + wr * 64 + fr, col0 = u.pn * BM + wc * 32 + 4 * fq;
#pragma unroll
        for (int ai = 0; ai < 2; ++ai)
#pragma unroll
            for (int m = 0; m < 4; ++m) { const int row = row0 + ai * HALF + m * 16; float ss = 0.f;
#pragma unroll
                for (int bj = 0; bj < 2; ++bj)
#pragma unroll
                    for (int n = 0; n < 2; ++n) { const size_t off = (size_t)row * 1024 + col0 + bj * HALF + n * 16;
                        const f32x4 o = *(const f32x4*)(rin + off) + acc[ai][bj][m][n] * alpha; *(f32x4*)(out + off) = o;
                        if (WB) { u32x2 w; w.x = cvt_pk_bf16(o[0], o[1]); w.y = cvt_pk_bf16(o[2], o[3]); *(u32x2*)(xb + off) = w; ss += (o[0] * o[0] + o[1] * o[1]) + (o[2] * o[2] + o[3] * o[3]); } }
                if (WB) { ss += __shfl_xor(ss, 16); ss += __shfl_xor(ss, 32); if (fq == 0) ssqp[(size_t)row * 16 + u.pn * 4 + wc] = ss; } asm volatile("" ::: "memory"); }
    }
};
template <class Epi, class Sched, bool ALIGN_EPI = false, bool SP2 = false>
__device__ __forceinline__ void gemm_phase(PG8_LAS unsigned char* lds, const Gemm g, const Sched& S, const Epi& E) {
    int tid_ = threadIdx.x; asm volatile("" : "+v"(tid_)); const int tid = tid_, wid = __builtin_amdgcn_readfirstlane(tid >> 6), lane = tid & 63, wr = wid >> 2, wc = wid & 3, fr = lane & 15, fq = lane >> 4;
    const int K = g.K, nt = K / BK;
    unsigned voffA[2], voffB[2];
#pragma unroll
    for (int i = 0; i < 2; ++i) { int R, C; stage_rc(tid * 16 + i * 8192, R, C); const int Rb = Epi::PERM ? ((R & ~31) + perm32(R & 31)) : R;
        voffA[i] = (unsigned)(R * K + C) * 2u; voffB[i] = (unsigned)(Rb * K + C) * 2u; }
    const size_t kstep = (size_t)(BK * 2);
    const size_t hstep = (size_t)HALF * K * 2;
    const size_t tstep = 2 * hstep;
    const unsigned ldsw = (unsigned)wid * 1024u;
    const int aoff = lds_byte(wr * 64 + fr, fq * 8), boff = lds_byte(wc * 32 + fr, fq * 8);
#define PG8_SA(b, h) (((b) * 2 + (h)) * HTB)
#define PG8_SB(b, h) ((4 + (b) * 2 + (h)) * HTB)
#define PG8_STAGE(bufoff, gbase, voff) do { _Pragma("unroll") for (int _i = 0; _i < 2; ++_i) \
        __builtin_amdgcn_global_load_lds((const unsigned*)((const char*)(gbase) + (voff)[_i]), (PG8_LAS unsigned*)(lds + (bufoff) + ldsw + _i * 8192), 16, 0, 0); } while (0)
#define PG8_LDA(dst, b, h) do { _Pragma("unroll") for (int m = 0; m < 4; ++m) _Pragma("unroll") for (int k = 0; k < 2; ++k) dst[m][k] = *(const PG8_LAS bf16x8*)(lds + PG8_SA(b, h) + aoff + m * 2048 + k * 1024); } while (0)
#define PG8_LDB(dst, b, h) do { _Pragma("unroll") for (int n = 0; n < 2; ++n) _Pragma("unroll") for (int k = 0; k < 2; ++k) dst[n][k] = *(const PG8_LAS bf16x8*)(lds + PG8_SB(b, h) + boff + n * 2048 + k * 1024); } while (0)
#define PG8_MMA(ai, bj, At, Bt) do { __builtin_amdgcn_s_setprio(1); _Pragma("unroll") for (int m = 0; m < 4; ++m) _Pragma("unroll") for (int n = 0; n < 2; ++n) _Pragma("unroll") for (int k = 0; k < 2; ++k) \
        acc[ai][bj][m][n] = __builtin_amdgcn_mfma_f32_16x16x32_bf16(Bt[n][k], At[m][k], acc[ai][bj][m][n], 0, 0, 0); __builtin_amdgcn_s_setprio(0); } while (0)
#define PG8_WAIT_V(n) asm volatile("s_waitcnt vmcnt(" #n ")" ::: "memory")
#define PG8_WAIT_L(n) asm volatile("s_waitcnt lgkmcnt(" #n ")" ::: "memory")
#define PG8_BAR __builtin_amdgcn_s_barrier()
#define PG8_SCHED __builtin_amdgcn_sched_barrier(0)
    Unit cur, nxt; int ui = 0;
    if (!S.next(0, cur)) return;
    f32x4 acc[2][2][4][2];
#pragma unroll
    for (int a = 0; a < 2; ++a)
#pragma unroll
        for (int b = 0; b < 2; ++b)
#pragma unroll
            for (int m = 0; m < 4; ++m)
#pragma unroll
                for (int n = 0; n < 2; ++n) acc[a][b][m][n] = (f32x4){0.f, 0.f, 0.f, 0.f};
    bf16x8 At[4][2], B0[2][2], B1[2][2];
    const char* cA = (const char*)g.A + (size_t)cur.pm * tstep; const char* cB = (const char*)g.Bt + (size_t)cur.pn * tstep;
    S.a_ready(cur);
    if constexpr (SP2) {
        PG8_STAGE(PG8_SB(0, 0), cB, voffB); PG8_STAGE(PG8_SB(0, 1), cB + hstep, voffB); PG8_STAGE(PG8_SA(0, 0), cA, voffA); PG8_STAGE(PG8_SA(0, 1), cA + hstep, voffA);
        if (wr == 1) PG8_BAR;
        PG8_WAIT_V(2); PG8_BAR;
        PG8_STAGE(PG8_SB(1, 0), cB + kstep, voffB); PG8_STAGE(PG8_SA(1, 0), cA + kstep, voffA); PG8_STAGE(PG8_SB(1, 1), cB + hstep + kstep, voffB);
        PG8_WAIT_V(6); PG8_BAR;
    } else {
        PG8_STAGE(PG8_SB(0, 0), cB, voffB); PG8_STAGE(PG8_SA(0, 0), cA, voffA); PG8_STAGE(PG8_SB(0, 1), cB + hstep, voffB); PG8_STAGE(PG8_SA(0, 1), cA + hstep, voffA);
        if (wr == 1) PG8_BAR;
        PG8_WAIT_V(4); PG8_BAR;
        PG8_STAGE(PG8_SB(1, 0), cB + kstep, voffB); PG8_STAGE(PG8_SA(1, 0), cA + kstep, voffA); PG8_STAGE(PG8_SB(1, 1), cB + hstep + kstep, voffB);
        PG8_WAIT_V(6); PG8_BAR;
    }
    for (;;) {
        const bool has_next = S.next(ui + 1, nxt);
        const char* nA = has_next ? (const char*)g.A + (size_t)nxt.pm * tstep : cA; const char* nB = has_next ? (const char*)g.Bt + (size_t)nxt.pn * tstep : cB;
        for (int t = 0; t < nt; t += 2) {
            const bool last = (t == nt - 2);
            const char* a1 = cA + (size_t)(t + 1) * kstep;
            const char* a2 = last ? nA : cA + (size_t)(t + 2) * kstep; const char* b2 = last ? nB : cB + (size_t)(t + 2) * kstep;
            const char* a3 = a2 + kstep; const char* b3 = b2 + kstep;
            if (last && has_next) S.a_ready(nxt);
            if constexpr (SP2) {
            PG8_LDB(B0, 0, 0); PG8_LDB(B1, 0, 1); PG8_SCHED; PG8_LDA(At, 0, 0); PG8_STAGE(PG8_SA(1, 1), a1 + hstep, voffA);
            PG8_WAIT_V(8); PG8_WAIT_L(0); PG8_BAR; PG8_MMA(0, 0, At, B0); PG8_MMA(0, 1, At, B1); PG8_BAR; PG8_SCHED;
            PG8_LDA(At, 0, 1); PG8_STAGE(PG8_SB(0, 0), b2, voffB); PG8_STAGE(PG8_SB(0, 1), b2 + hstep, voffB); PG8_STAGE(PG8_SA(0, 0), a2, voffA);
            PG8_WAIT_V(8); PG8_WAIT_L(0); PG8_BAR; PG8_MMA(1, 0, At, B0); PG8_MMA(1, 1, At, B1); PG8_BAR; PG8_SCHED;
            PG8_LDB(B0, 1, 0); PG8_LDB(B1, 1, 1); PG8_SCHED; PG8_LDA(At, 1, 0); PG8_STAGE(PG8_SA(0, 1), a2 + hstep, voffA);
            PG8_WAIT_V(8); PG8_WAIT_L(0); PG8_BAR; PG8_MMA(0, 0, At, B0); PG8_MMA(0, 1, At, B1); PG8_BAR; PG8_SCHED;
            PG8_LDA(At, 1, 1); PG8_STAGE(PG8_SB(1, 0), b3, voffB); PG8_STAGE(PG8_SB(1, 1), b3 + hstep, voffB); PG8_STAGE(PG8_SA(1, 0), a3, voffA);
            PG8_WAIT_V(8); PG8_WAIT_L(0); PG8_BAR; PG8_MMA(1, 0, At, B0); PG8_MMA(1, 1, At, B1); PG8_BAR; PG8_SCHED;
            } else {
            PG8_LDB(B0, 0, 0); PG8_SCHED; PG8_LDA(At, 0, 0); PG8_STAGE(PG8_SA(1, 1), a1 + hstep, voffA);
            PG8_WAIT_L(8); PG8_BAR; PG8_WAIT_L(0); PG8_MMA(0, 0, At, B0); PG8_BAR; PG8_SCHED;
            PG8_LDB(B1, 0, 1); PG8_STAGE(PG8_SB(0, 0), b2, voffB);
            PG8_BAR; PG8_WAIT_L(0); PG8_MMA(0, 1, At, B1); PG8_BAR;
            PG8_LDA(At, 0, 1); PG8_STAGE(PG8_SA(0, 0), a2, voffA);
            PG8_BAR; PG8_WAIT_L(0); PG8_MMA(1, 0, At, B0); PG8_BAR; PG8_SCHED;
            PG8_STAGE(PG8_SB(0, 1), b2 + hstep, voffB);
            PG8_WAIT_V(6); PG8_BAR; PG8_MMA(1, 1, At, B1); PG8_BAR;
            PG8_LDB(B0, 1, 0); PG8_SCHED; PG8_LDA(At, 1, 0); PG8_STAGE(PG8_SA(0, 1), a2 + hstep, voffA);
            PG8_WAIT_L(8); PG8_BAR; PG8_WAIT_L(0); PG8_MMA(0, 0, At, B0); PG8_BAR; PG8_SCHED;
            PG8_LDB(B1, 1, 1); PG8_STAGE(PG8_SB(1, 0), b3, voffB);
            PG8_BAR; PG8_WAIT_L(0); PG8_MMA(0, 1, At, B1); PG8_BAR;
            PG8_LDA(At, 1, 1); PG8_STAGE(PG8_SA(1, 0), a3, voffA);
            PG8_BAR; PG8_WAIT_L(0); PG8_MMA(1, 0, At, B0); PG8_BAR; PG8_SCHED;
            PG8_STAGE(PG8_SB(1, 1), b3 + hstep, voffB);
            PG8_WAIT_V(6); PG8_BAR; PG8_MMA(1, 1, At, B1); PG8_BAR;
            }
        }
        if constexpr (ALIGN_EPI) { if (wr == 0) PG8_BAR; }
        if constexpr (!Epi::AFTER_DRAIN) { E(acc, cur, wr, wc, fr, fq); S.done(cur); }
        if (!has_next) break;
#pragma unroll
        for (int a = 0; a < 2; ++a)
#pragma unroll
            for (int b = 0; b < 2; ++b)
#pragma unroll
                for (int m = 0; m < 4; ++m)
#pragma unroll
                    for (int n = 0; n < 2; ++n) acc[a][b][m][n] = (f32x4){0.f, 0.f, 0.f, 0.f};
        cur = nxt; cA = nA; cB = nB; ++ui;
        if constexpr (ALIGN_EPI) { if (wr == 1) PG8_BAR; }
    }
    PG8_WAIT_V(0);
    if constexpr (!ALIGN_EPI) { if (wr == 0) PG8_BAR; }
    PG8_BAR;
    if constexpr (Epi::AFTER_DRAIN) { E.fused(acc, cur, wr, wc, fr, fq, lds, wid, lane); S.done(cur); }
#undef PG8_SA
#undef PG8_SB
#undef PG8_STAGE
#undef PG8_LDA
#undef PG8_LDB
#undef PG8_MMA
#undef PG8_WAIT_V
#undef PG8_WAIT_L
#undef PG8_BAR
#undef PG8_SCHED
}
}

#define GAS __attribute__((address_space(1)))
#define LAS __attribute__((address_space(3)))
typedef unsigned short bf16;
typedef unsigned v4u __attribute__((ext_vector_type(4)));
typedef float f32x4 __attribute__((ext_vector_type(4)));
typedef short bf16x8 __attribute__((ext_vector_type(8)));
typedef GAS unsigned gu32;
typedef GAS unsigned long long gu64;
#define RLX_AGENT __ATOMIC_RELAXED, __HIP_MEMORY_SCOPE_AGENT
#define LDS_WAIT() asm volatile("s_waitcnt lgkmcnt(0)" ::: "memory")
#define VM_WAIT() asm volatile("s_waitcnt vmcnt(0)" ::: "memory")
__device__ __forceinline__ unsigned long long rt() { return __builtin_amdgcn_s_memrealtime(); }
__device__ __forceinline__ unsigned f2bf(float f) { unsigned u = __builtin_bit_cast(unsigned, f); return (u + 0x7fffu + ((u >> 16) & 1u)) >> 16; }
__device__ __forceinline__ unsigned pk2(float lo, float hi) { return f2bf(lo) | (f2bf(hi) << 16); }
#define XB_TMO      128
#define XB_XCNT(j)  (256  + 64 * (j))
#define XB_XSUB(j)  (1280 + 64 * (j))
#define XB_XGEN(j)  (2304 + 64 * (j))
#define XB_TOP      3328
#define XB_TOPGEN   3392
#define XCD_BAR_WORDS 3456
#define XB_SPIN_CAP (1u << 18)

__device__ __forceinline__ unsigned xb_ld(unsigned* p)              { return __hip_atomic_load(p, __ATOMIC_RELAXED, __HIP_MEMORY_SCOPE_AGENT); }
__device__ __forceinline__ unsigned xb_add(unsigned* p, unsigned v) { return __hip_atomic_fetch_add(p, v, __ATOMIC_RELAXED, __HIP_MEMORY_SCOPE_AGENT); }
__device__ __forceinline__ unsigned xb_xcc_id() { return (unsigned)__builtin_amdgcn_s_getreg((3 << 11) | 20) & 0xFu; }
#define XB_SPIN(cond, bar) do { unsigned _sp = 0; while (cond) { __builtin_amdgcn_s_sleep(1); \
    if ((++_sp & 255u) == 0u) { if (xb_ld(&(bar)[XB_TMO])) break; if (_sp > XB_SPIN_CAP) { atomicAdd(&(bar)[XB_TMO], 1u); break; } } } } while (0)

struct XcdBarrier {
    unsigned* bar; unsigned x;
    volatile LAS unsigned* st;
};

__device__ __forceinline__ XcdBarrier xcd_barrier_post(unsigned* bar, volatile LAS unsigned* st) {
    XcdBarrier b; b.bar = bar; b.x = xb_xcc_id(); b.st = st;
    if (threadIdx.x == 0) (void)xb_add(&bar[XB_XCNT(b.x)], 1u);
    return b;
}
__device__ __forceinline__ void xcd_barrier_complete(unsigned* bar, unsigned x, unsigned& nloc, unsigned& nx) {
    const unsigned G = gridDim.x * gridDim.y * gridDim.z;
    unsigned sum, cnt, mine, sp = 0u;
    for (;;) {
        sum = 0u; cnt = 0u; mine = 0u;
#pragma unroll
        for (unsigned j = 0; j < 16; ++j) { const unsigned c = xb_ld(&bar[XB_XCNT(j)]); sum += c; cnt += (c > 0u) ? 1u : 0u; mine = (j == x) ? c : mine; }
        if (sum == G) break;
        __builtin_amdgcn_s_sleep(1);
        if ((++sp & 255u) == 0u) { if (xb_ld(&bar[XB_TMO])) break; if (sp > XB_SPIN_CAP) { atomicAdd(&bar[XB_TMO], 1u); break; } }
    }
    nloc = mine > 0u ? mine : 1u; nx = cnt > 0u ? cnt : 1u;
}

__device__ __forceinline__ void xcd_barrier(const XcdBarrier& b) {
    asm volatile("s_waitcnt vmcnt(0)" ::: "memory");
    __syncthreads();
    if (threadIdx.x == 0) {
        unsigned* bar = b.bar;
        __builtin_amdgcn_s_waitcnt(0);
        unsigned nloc = b.st[0], nx = b.st[1];
        if (nloc == 0u) { xcd_barrier_complete(bar, b.x, nloc, nx); b.st[0] = nloc; b.st[1] = nx; }
        const unsigned old = xb_add(&bar[XB_XSUB(b.x)], 1u);
        const unsigned gen = old / nloc;
        if (old + 1u == (gen + 1u) * nloc) {
            __builtin_amdgcn_fence(__ATOMIC_RELEASE, "agent");
            asm volatile("s_waitcnt vmcnt(0)" ::: "memory");
            const unsigned og = xb_add(&bar[XB_TOP], 1u);
            const unsigned tg = og / nx;
            if (og + 1u == (tg + 1u) * nx) xb_add(&bar[XB_TOPGEN], 1u);
            else XB_SPIN(xb_ld(&bar[XB_TOPGEN]) == tg, bar);
            __builtin_amdgcn_fence(__ATOMIC_ACQUIRE, "agent");
            xb_add(&bar[XB_XGEN(b.x)], 1u);
            asm volatile("s_waitcnt vmcnt(0)" ::: "memory");
        } else {
            XB_SPIN(xb_ld(&bar[XB_XGEN(b.x)]) == gen, bar);
            __builtin_amdgcn_fence(__ATOMIC_ACQUIRE, "agent");
            asm volatile("s_waitcnt vmcnt(0)" ::: "memory");
        }
    }
    __syncthreads();
}

constexpr int NWAVES = 8;
#ifndef REP_M2
#define REP_M2 1
#endif
#ifndef REP_M13
#define REP_M13 1
#endif
#ifndef REP_P0
#define REP_P0 1
#endif
#ifndef REP_P2
#define REP_P2 1
#endif
#ifndef REP_P3
#define REP_P3 1
#endif
#ifndef REP_BAR
#define REP_BAR 1
#endif
#ifndef REP_SCAN
#define REP_SCAN 1
#endif
#ifndef REP_P1
#define REP_P1 1
#endif
using pg8::RMS_EPS;
constexpr int BATCH = 8, T = 2048, D = 1024, FF = 2816, M = BATCH * T, NP = 3072;
constexpr int C_Q = 0, C_KC = 512, C_VC = 640, C_KS = 768, C_VS = 896, C_KW = 1024, C_VW = 1152, C_GQ = 1280, C_GK = 1536, C_GV = 1792, C_GR = 2304, C_GN = 2816, C_GA = 2840;
constexpr int SRC_NIN = 2856;
constexpr size_t MiB = 1u << 20;
constexpr size_t WS_CTL = 0, CTL_ZERO_BYTES = 1 * MiB;
constexpr size_t WS_W1GU = 1 * MiB, WS_W1D = 12 * MiB, WS_WIN = 18 * MiB, WS_WOUT = 24 * MiB, WS_W2GU = 26 * MiB, WS_W2D = 37 * MiB;
constexpr size_t WS_WC1K = 43 * MiB, WS_WC1V = 43 * MiB + 512 * 1024;
constexpr size_t WS_WC2K = 44 * MiB, WS_WC2V = 44 * MiB + 16384, WS_CBIAS = 44 * MiB + 32768  , WS_KC = 44 * MiB + 65536, WS_VTC = 44 * MiB + 65536 + 262144;
constexpr size_t WS_SSQ0 = 45 * MiB, WS_SSQA = 46 * MiB, WS_SSQB = 47 * MiB, WS_DEC = 48 * MiB;
constexpr size_t WS_XB = 50 * MiB, WS_KVT = WS_XB;
constexpr size_t WS_R = 82 * MiB;
constexpr size_t WS_MIX = 178 * MiB, WS_VTS = 210 * MiB, WS_VTW = 214 * MiB, WS_ST = 218 * MiB, WS_END = 234 * MiB;
constexpr int CW_BAR = 4096;
constexpr int RING_OFF = 0, RING_BYTES = 131072, LDSCTL_OFF = RING_BYTES, MISC_OFF = LDSCTL_OFF + 320, LDS_BYTES = 147456;

typedef unsigned u32x2 __attribute__((ext_vector_type(2)));
typedef float f32x2_t __attribute__((ext_vector_type(2))); typedef __bf16 bf16x2_t __attribute__((ext_vector_type(2)));
__device__ __forceinline__ unsigned cvtpk(float lo, float hi) { f32x2_t v = {lo, hi}; bf16x2_t b = __builtin_convertvector(v, bf16x2_t); return __builtin_bit_cast(unsigned, b); }
__device__ __forceinline__ bf16 f2b(float x) { return (bf16)(cvtpk(x, 0.f) & 0xffffu); }
__device__ __forceinline__ float bf2f(bf16 h) { return __builtin_bit_cast(float, (unsigned)h << 16); }
__device__ __forceinline__ float blo(unsigned w) { return __builtin_bit_cast(float, w << 16); }
__device__ __forceinline__ float bhi(unsigned w) { return __builtin_bit_cast(float, w & 0xffff0000u); }
__device__ __forceinline__ float fexp(float x) { return __builtin_amdgcn_exp2f(x * 1.4426950408889634f); }
__device__ __forceinline__ bf16x8 pack8(f32x4 a, f32x4 b) { v4u w; w.x = cvtpk(a[0], a[1]); w.y = cvtpk(a[2], a[3]); w.z = cvtpk(b[0], b[1]); w.w = cvtpk(b[2], b[3]); return __builtin_bit_cast(bf16x8, w); }
__device__ __forceinline__ bf16x8 ld2x8(const bf16* p0, const bf16* p1) { const u32x2 a = *(const u32x2*)p0, b = *(const u32x2*)p1; v4u w; w.x = a.x; w.y = a.y; w.z = b.x; w.w = b.y; return __builtin_bit_cast(bf16x8, w); }
__device__ __forceinline__ bf16x8 ldb16(const void* ub, unsigned boff) { return *(const bf16x8*)((const char*)ub + boff); }
__device__ __forceinline__ bf16x8 ldb8x2(const void* ub, unsigned boff) { const u32x2 a = *(const u32x2*)((const char*)ub + boff), b = *(const u32x2*)((const char*)ub + boff + 32); v4u w; w.x = a.x; w.y = a.y; w.z = b.x; w.w = b.y; return __builtin_bit_cast(bf16x8, w); }
__device__ __forceinline__ float ldb_bf(const void* ub, unsigned boff) { return bf2f(*(const bf16*)((const char*)ub + boff)); }
#define OPAQUE(x) asm volatile("" : "+v"(x))
#define MFMA16(a, b, c) __builtin_amdgcn_mfma_f32_16x16x32_bf16((a), (b), (c), 0, 0, 0)
#define WAVE_LDS_FENCE() asm volatile("s_waitcnt lgkmcnt(0)" ::: "memory")

struct Frame {
    LAS unsigned char* lds;
    volatile LAS unsigned* MISC;
    gu32* ctl;
    int tid, lane, wave, vcu, G;
    const float* in[22];
    float* out;
    bf16 *W1GU, *W1D, *WIN, *WOUT, *W2GU, *W2D, *WC1K, *WC1V, *WC2K, *WC2V, *KC, *VTC, *XB, *H, *PROJ, *MIX, *VTS, *VTW, *ST;
    float *CBIAS, *SSQ0, *SSQA, *SSQB, *DEC, *KVT;
};

__device__ __forceinline__ float wave_sum(float v) {
#pragma unroll
    for (int o = 1; o < 64; o <<= 1) v += __shfl_xor(v, o);
    return v;
}

__device__ __forceinline__ int win_src_col(int n) { return n < 1280 ? n : (n < 2816 ? n + 24 : (n < 2840 ? n - 1536 : (n < 2856 ? n : -1))); }
__device__ __forceinline__ void p0_tr_item(const float* W, const float* W2, const float* gain, int K, int Nsrc, int mode, bf16* WT, LAS float* scr, int kb, int nb, int lane) {
    const int k0 = 64 * kb, n0 = 32 * nb, nd = n0 + (lane & 31);
    const float* src = W; int sc = nd;
    if (mode == 1) { const int tile = nd >> 8, c = nd & 255; if (c >= 128) { src = W2; sc = tile * 128 + c - 128; } else sc = tile * 128 + c; }
    else if (mode == 2) sc = win_src_col(nd);
#pragma unroll 8
    for (int i = 0; i < 32; ++i) { const int kk = 2 * i + (lane >> 5); float v = 0.f; if (sc >= 0) v = src[(size_t)(k0 + kk) * Nsrc + sc]; if (gain) v *= gain[k0 + kk]; scr[kk * 33 + (lane & 31)] = v; }
    LDS_WAIT(); asm volatile("" ::: "memory");
    const int c = lane & 7;
#pragma unroll
    for (int j = 0; j < 4; ++j) { const int n = (lane >> 3) + 8 * j; const LAS float* s = scr + (8 * c) * 33 + n;
        v4u o; o.x = pk2(s[0 * 33], s[1 * 33]); o.y = pk2(s[2 * 33], s[3 * 33]); o.z = pk2(s[4 * 33], s[5 * 33]); o.w = pk2(s[6 * 33], s[7 * 33]);
        *(GAS v4u*)(WT + (size_t)(n0 + n) * K + k0 + 8 * c) = o; }
    LDS_WAIT(); asm volatile("" ::: "memory");
}
__device__ __forceinline__ void p0_prologue(Frame& F) {
    LAS float* scr = (LAS float*)(F.lds + RING_OFF + F.wave * 16384);
    const int gw = F.vcu * NWAVES + F.wave, NGW = F.G * NWAVES;
    constexpr int I_GU = 16 * 176, I_DN = 44 * 32, I_IN = 16 * 96, I_OUT = 16 * 32, I_C1 = 32 * 4, I_C2 = 2 * 2;
    constexpr int NITEMS = 2 * I_GU + 2 * I_DN + I_IN + I_OUT + 2 * I_C1 + 2 * I_C2;
    for (int it = gw; it < NITEMS; it += NGW) {
        int r = it;
        if (r < I_GU) { p0_tr_item(F.in[2], F.in[3], F.in[1], 1024, FF, 1, F.W1GU, scr, r / 176, r % 176, F.lane); continue; } r -= I_GU;
        if (r < I_GU) { p0_tr_item(F.in[18], F.in[19], F.in[17], 1024, FF, 1, F.W2GU, scr, r / 176, r % 176, F.lane); continue; } r -= I_GU;
        if (r < I_DN) { p0_tr_item(F.in[4], nullptr, nullptr, FF, 1024, 0, F.W1D, scr, r / 32, r % 32, F.lane); continue; } r -= I_DN;
        if (r < I_DN) { p0_tr_item(F.in[20], nullptr, nullptr, FF, 1024, 0, F.W2D, scr, r / 32, r % 32, F.lane); continue; } r -= I_DN;
        if (r < I_IN) { p0_tr_item(F.in[6], nullptr, F.in[5], 1024, SRC_NIN, 2, F.WIN, scr, r / 96, r % 96, F.lane); continue; } r -= I_IN;
        if (r < I_OUT) { p0_tr_item(F.in[16], nullptr, nullptr, 1024, 1024, 0, F.WOUT, scr, r / 32, r % 32, F.lane); continue; } r -= I_OUT;
        if (r < I_C1) { p0_tr_item(F.in[8], nullptr, nullptr, 2048, 128, 0, F.WC1K, scr, r / 4, r % 4, F.lane); continue; } r -= I_C1;
        if (r < I_C1) { p0_tr_item(F.in[11], nullptr, nullptr, 2048, 128, 0, F.WC1V, scr, r / 4, r % 4, F.lane); continue; } r -= I_C1;
        if (r < I_C2) { p0_tr_item(F.in[9], nullptr, nullptr, 128, 64, 0, F.WC2K, scr, r / 2, r % 2, F.lane); continue; } r -= I_C2;
        p0_tr_item(F.in[12], nullptr, nullptr, 128, 64, 0, F.WC2V, scr, r / 2, r % 2, F.lane);
    }
    for (int m = gw; m < M; m += NGW) {
        const GAS f32x4* xr = (const GAS f32x4*)(F.in[0] + (size_t)m * D) + F.lane;
        f32x4 v[4]; float s = 0.f;
#pragma unroll
        for (int j = 0; j < 4; ++j) { v[j] = xr[64 * j]; s += (v[j].x * v[j].x + v[j].y * v[j].y) + (v[j].z * v[j].z + v[j].w * v[j].w); }
        s = wave_sum(s);
        if (F.lane == 0) F.SSQ0[m] = s;
        GAS unsigned long long* o8 = (GAS unsigned long long*)(F.XB + (size_t)m * D) + F.lane;
#pragma unroll
        for (int j = 0; j < 4; ++j) o8[64 * j] = (unsigned long long)cvtpk(v[j].x, v[j].y) | ((unsigned long long)cvtpk(v[j].z, v[j].w) << 32);
    }
    for (int it = gw; it < 64; it += NGW) {
        const int kv = it >> 5, ch = it & 31; const float* W = (kv ? F.in[11] : F.in[8]) + (size_t)ch * 64 * 128 + F.lane; const float* pe = (kv ? F.in[10] : F.in[7]) + ch * 64;
        float s0 = 0.f, s1 = 0.f;
#pragma unroll 16
        for (int k = 0; k < 64; ++k) { const float p = pe[k]; s0 += p * W[k * 128]; s1 += p * W[k * 128 + 64]; }
        F.CBIAS[(kv * 32 + ch) * 128 + F.lane] = s0; F.CBIAS[(kv * 32 + ch) * 128 + 64 + F.lane] = s1;
    }
}

__device__ __forceinline__ void m1_compress(Frame& F, int ci) {
    const int kv = ci >> 7, b = (ci >> 4) & 7, g = (ci >> 3) & 1, rg = ci & 7;
    const int lane = F.lane, q = lane & 15, gl = lane >> 4, w = F.wave;
    LAS float* red = (LAS float*)(F.lds + RING_OFF);
    LAS bf16* hidb = (LAS bf16*)(F.lds + RING_OFF + 65536);
    const bf16* W1 = kv ? F.WC1V : F.WC1K; const bf16* W2 = kv ? F.WC2V : F.WC2K;
    const int ccol = (kv ? C_VC : C_KC) + g * 64;
    f32x4 acc[8];
#pragma unroll
    for (int nt = 0; nt < 8; ++nt) acc[nt] = (f32x4){0.f, 0.f, 0.f, 0.f};
#pragma unroll
    for (int ks = 0; ks < 8; ++ks) {
        const int l = 4 * w + (ks >> 1), dbase = 32 * (ks & 1) + 8 * gl;
        int tok = 16 * (16 * rg + q) + l; tok = tok > T - 1 ? T - 1 : tok;
        const bf16x8 a = *(const bf16x8*)(F.PROJ + ((size_t)b * T + tok) * NP + ccol + dbase);
        const int kg = 64 * l + dbase;
#pragma unroll
        for (int nt = 0; nt < 8; ++nt) { const bf16x8 bw = *(const bf16x8*)(W1 + (size_t)(16 * nt + q) * 2048 + kg); acc[nt] = MFMA16(a, bw, acc[nt]); }
    }
#pragma unroll
    for (int nt = 0; nt < 8; ++nt)
#pragma unroll
        for (int reg = 0; reg < 4; ++reg) red[(w * 16 + 4 * gl + reg) * 128 + 16 * nt + q] = acc[nt][reg];
    __syncthreads();
    {
        const int idx = F.tid * 4, r = idx >> 7, n = idx & 127;
        f32x4 s = (f32x4){0.f, 0.f, 0.f, 0.f};
#pragma unroll 8
        for (int ch = 0; ch < 32; ++ch) s += *(const f32x4*)(F.CBIAS + (kv * 32 + ch) * 128 + n);
#pragma unroll
        for (int ww = 0; ww < 8; ++ww) s += *(const LAS f32x4*)(red + (ww * 16 + r) * 128 + n);
        float o[4];
#pragma unroll
        for (int i = 0; i < 4; ++i) { const float x = s[i]; const float u2 = 2.0f * 0.7978845608028654f * (x + 0.044715f * x * x * x);
            const float th = 1.0f - 2.0f * __builtin_amdgcn_rcpf(fexp(u2) + 1.0f); o[i] = 0.5f * x * (1.0f + th); }
        u32x2 pw; pw.x = cvtpk(o[0], o[1]); pw.y = cvtpk(o[2], o[3]);
        *(LAS u32x2*)(hidb + r * 136 + n) = pw;
    }
    __syncthreads();
    if (w < 4) {
        f32x4 a2 = (f32x4){0.f, 0.f, 0.f, 0.f};
#pragma unroll
        for (int ks = 0; ks < 4; ++ks) { const bf16x8 a = *(const LAS bf16x8*)(hidb + q * 136 + 32 * ks + 8 * gl);
            const bf16x8 bw = *(const bf16x8*)(W2 + (size_t)(16 * w + q) * 128 + 32 * ks + 8 * gl); a2 = MFMA16(a, bw, a2); }
        const int d = 16 * w + q;
#pragma unroll
        for (int reg = 0; reg < 4; ++reg) { const int i = 16 * rg + 4 * gl + reg; const bf16 val = (i <= 126) ? f2b(a2[reg]) : (bf16)0;
            if (kv == 0) F.KC[((size_t)(b * 2 + g) * 128 + i) * 64 + d] = val; else F.VTC[((size_t)(b * 2 + g) * 64 + d) * 128 + i] = val; }
    }
    __syncthreads();
}

__device__ __forceinline__ void gla_prep(Frame& F, int b, int h, int n, LAS float* bm, LAS float* seg) {
    const int tid = F.tid, d = tid & 63, sg = tid >> 6;
    const float* wa = F.in[13] + h * 64 + d;
    float w[16];
#pragma unroll
    for (int r = 0; r < 16; ++r) w[r] = wa[r * 256];
    const float ba = F.in[14][h * 64 + d];
    float c[8]; float run = 0.f;
#pragma unroll
    for (int i = 0; i < 8; ++i) {
        const size_t row = (size_t)b * T + 64 * n + 8 * sg + i;
        const bf16* gp = F.PROJ + row * NP + C_GA;
        const v4u g0 = *(const v4u*)gp, g1 = *(const v4u*)(gp + 8);
        float z = ba;
        z += blo(g0.x) * w[0] + bhi(g0.x) * w[1] + blo(g0.y) * w[2] + bhi(g0.y) * w[3] + blo(g0.z) * w[4] + bhi(g0.z) * w[5] + blo(g0.w) * w[6] + bhi(g0.w) * w[7];
        z += blo(g1.x) * w[8] + bhi(g1.x) * w[9] + blo(g1.y) * w[10] + bhi(g1.y) * w[11] + blo(g1.z) * w[12] + bhi(g1.z) * w[13] + blo(g1.w) * w[14] + bhi(g1.w) * w[15];
        const float ls = fminf(z, 0.f) - __logf(1.0f + __expf(-fabsf(z)));
        run += ls * (1.0f / 16.0f); c[i] = run;
    }
    seg[sg * 64 + d] = run; __syncthreads();
    float pre = 0.f;
#pragma unroll
    for (int s2 = 0; s2 < 7; ++s2) pre += (s2 < sg) ? seg[s2 * 64 + d] : 0.f;
#pragma unroll
    for (int i = 0; i < 8; ++i) bm[(8 * sg + i) * 65 + d] = pre + c[i];
    __syncthreads();
}
__device__ __forceinline__ void gla_load_vt(Frame& F, size_t row, int h, int j, int c8, LAS bf16* VTl) {
    const bf16* vp = F.PROJ + row * NP + C_GV + h * 128 + 16 * c8;
    const v4u v0 = *(const v4u*)vp, v1 = *(const v4u*)(vp + 8);
    LAS bf16* dst = VTl + (16 * c8) * 72 + j;
    dst[0 * 72] = (bf16)(v0.x & 0xffffu); dst[1 * 72] = (bf16)(v0.x >> 16); dst[2 * 72] = (bf16)(v0.y & 0xffffu); dst[3 * 72] = (bf16)(v0.y >> 16);
    dst[4 * 72] = (bf16)(v0.z & 0xffffu); dst[5 * 72] = (bf16)(v0.z >> 16); dst[6 * 72] = (bf16)(v0.w & 0xffffu); dst[7 * 72] = (bf16)(v0.w >> 16);
    dst[8 * 72] = (bf16)(v1.x & 0xffffu); dst[9 * 72] = (bf16)(v1.x >> 16); dst[10 * 72] = (bf16)(v1.y & 0xffffu); dst[11 * 72] = (bf16)(v1.y >> 16);
    dst[12 * 72] = (bf16)(v1.z & 0xffffu); dst[13 * 72] = (bf16)(v1.z >> 16); dst[14 * 72] = (bf16)(v1.w & 0xffffu); dst[15 * 72] = (bf16)(v1.w >> 16);
}
__device__ __forceinline__ void m1_gla_kv(Frame& F, int item) {
    const int n = item & 31, h = (item >> 5) & 3, b = item >> 7;
    const int lane = F.lane, q = lane & 15, gl = lane >> 4, w = F.wave, tid = F.tid;
    LAS float* bm = (LAS float*)(F.lds + RING_OFF); LAS float* seg = (LAS float*)(F.lds + RING_OFF + 16640);
    LAS bf16* KstT = (LAS bf16*)(F.lds + RING_OFF + 18688); LAS bf16* VTl = (LAS bf16*)(F.lds + RING_OFF + 27904);
    gla_prep(F, b, h, n, bm, seg);
    const int j = tid >> 3, c8 = tid & 7; const size_t row = (size_t)b * T + 64 * n + j;
    {
        const v4u kk = *(const v4u*)(F.PROJ + row * NP + C_GK + h * 64 + 8 * c8);
        float kf[8] = {blo(kk.x), bhi(kk.x), blo(kk.y), bhi(kk.y), blo(kk.z), bhi(kk.z), blo(kk.w), bhi(kk.w)};
#pragma unroll
        for (int i = 0; i < 8; ++i) { const int d = 8 * c8 + i; const float e = fexp(bm[63 * 65 + d] - bm[j * 65 + d]); KstT[d * 72 + j] = f2b(kf[i] * e); }
    }
    gla_load_vt(F, row, h, j, c8, VTl);
    __syncthreads();
#pragma unroll
    for (int dt = 0; dt < 4; ++dt) {
        f32x4 acc = (f32x4){0.f, 0.f, 0.f, 0.f};
#pragma unroll
        for (int ks = 0; ks < 2; ++ks) { const bf16x8 a = *(const LAS bf16x8*)(KstT + (16 * dt + q) * 72 + 32 * ks + 8 * gl);
            const bf16x8 bv = *(const LAS bf16x8*)(VTl + (16 * w + q) * 72 + 32 * ks + 8 * gl); acc = MFMA16(a, bv, acc); }
        *(f32x4*)(F.KVT + ((size_t)item * 128 + 16 * w + q) * 64 + 16 * dt + 4 * gl) = acc;
    }
    if (tid < 64) F.DEC[(size_t)item * 64 + tid] = fexp(bm[63 * 65 + tid]);
    __syncthreads();
}
__device__ __forceinline__ void m1_transpose(Frame& F, int ti) {
    const int which = ti >> 9, rem = ti & 511, b = rem >> 6, g = (rem >> 5) & 1, tt = rem & 31;
    const bf16* src = F.PROJ + ((size_t)b * T + 64 * tt + F.lane) * NP + (which ? C_VW : C_VS) + g * 64;
    v4u x[8];
#pragma unroll
    for (int i = 0; i < 8; ++i) x[i] = *(const v4u*)(src + 8 * i);
    bf16* dst = (which ? F.VTW : F.VTS) + ((size_t)(b * 2 + g) * 64) * T + 64 * tt + F.lane;
#pragma unroll
    for (int d = 0; d < 64; ++d) { const unsigned wv = x[d >> 3][(d >> 1) & 3]; dst[(size_t)d * T] = (bf16)((d & 1) ? (wv >> 16) : (wv & 0xffffu)); }
}
__device__ __forceinline__ void m2_scan(Frame& F, int si) {
    const int bh = si >> 5, part = si & 31, qd = part * 64 + F.lane, v = qd >> 4, dq = qd & 15;
    f32x4 S = (f32x4){0.f, 0.f, 0.f, 0.f};
#pragma unroll 8
    for (int n = 0; n < 32; ++n) {
        const size_t item = (size_t)bh * 32 + n;
        const f32x4 kvv = *(const f32x4*)(F.KVT + (item * 128 + v) * 64 + 4 * dq);
        const f32x4 dc = *(const f32x4*)(F.DEC + item * 64 + 4 * dq);
        u32x2 wv; wv.x = cvtpk(S[0], S[1]); wv.y = cvtpk(S[2], S[3]);
        *(u32x2*)(F.ST + (item * 128 + v) * 64 + 4 * dq) = wv;
        S = S * dc + kvv;
    }
}
__device__ __forceinline__ void m3_gla_out(Frame& F, int item) {
    const int n = item & 31, h = (item >> 5) & 3, b = item >> 7;
    const int lane = F.lane, q = lane & 15, gl = lane >> 4, w = F.wave, tid = F.tid;
    LAS float* bm = (LAS float*)(F.lds + RING_OFF); LAS float* seg = (LAS float*)(F.lds + RING_OFF + 16640);
    LAS bf16* Qin = (LAS bf16*)(F.lds + RING_OFF + 18688); LAS bf16* Kin = (LAS bf16*)(F.lds + RING_OFF + 27904);
    LAS bf16* VTl = (LAS bf16*)(F.lds + RING_OFF + 37120); LAS bf16* Am = (LAS bf16*)(F.lds + RING_OFF + 55552);
    LAS float* ssqw = (LAS float*)(F.lds + RING_OFF + 64768);
    gla_prep(F, b, h, n, bm, seg);
    const int j = tid >> 3, c8 = tid & 7; const size_t row = (size_t)b * T + 64 * n + j;
    {
        const v4u qq = *(const v4u*)(F.PROJ + row * NP + C_GQ + h * 64 + 8 * c8);
        const v4u kk = *(const v4u*)(F.PROJ + row * NP + C_GK + h * 64 + 8 * c8);
        float qf[8] = {blo(qq.x), bhi(qq.x), blo(qq.y), bhi(qq.y), blo(qq.z), bhi(qq.z), blo(qq.w), bhi(qq.w)};
        float kf[8] = {blo(kk.x), bhi(kk.x), blo(kk.y), bhi(kk.y), blo(kk.z), bhi(kk.z), blo(kk.w), bhi(kk.w)};
#pragma unroll
        for (int i = 0; i < 8; ++i) { const float bb = bm[j * 65 + 8 * c8 + i]; qf[i] = qf[i] * 0.125f * fexp(bb); kf[i] = kf[i] * fexp(-bb); }
        v4u pq, pk; pq.x = cvtpk(qf[0], qf[1]); pq.y = cvtpk(qf[2], qf[3]); pq.z = cvtpk(qf[4], qf[5]); pq.w = cvtpk(qf[6], qf[7]);
        pk.x = cvtpk(kf[0], kf[1]); pk.y = cvtpk(kf[2], kf[3]); pk.z = cvtpk(kf[4], kf[5]); pk.w = cvtpk(kf[6], kf[7]);
        *(LAS v4u*)(Qin + j * 72 + 8 * c8) = pq; *(LAS v4u*)(Kin + j * 72 + 8 * c8) = pk;
    }
    gla_load_vt(F, row, h, j, c8, VTl);
    __syncthreads();
    {
        const int it = w >> 1;
#pragma unroll
        for (int jj = 0; jj < 2; ++jj) { const int jt = 2 * (w & 1) + jj; f32x4 a = (f32x4){0.f, 0.f, 0.f, 0.f};
            if (jt <= it) {
#pragma unroll
                for (int ks = 0; ks < 2; ++ks) a = MFMA16(*(const LAS bf16x8*)(Qin + (16 * it + q) * 72 + 32 * ks + 8 * gl), *(const LAS bf16x8*)(Kin + (16 * jt + q) * 72 + 32 * ks + 8 * gl), a);
            }
#pragma unroll
            for (int reg = 0; reg < 4; ++reg) { const int i = 16 * it + 4 * gl + reg, jx = 16 * jt + q; Am[i * 72 + jx] = (i >= jx) ? f2b(a[reg]) : (bf16)0; } }
    }
    __syncthreads();
    f32x4 acc[4];
#pragma unroll
    for (int it = 0; it < 4; ++it) acc[it] = (f32x4){0.f, 0.f, 0.f, 0.f};
#pragma unroll
    for (int ks = 0; ks < 2; ++ks) {
        const bf16x8 bv = *(const LAS bf16x8*)(VTl + (16 * w + q) * 72 + 32 * ks + 8 * gl);
        const bf16x8 bs = *(const bf16x8*)(F.ST + ((size_t)item * 128 + 16 * w + q) * 64 + 32 * ks + 8 * gl);
#pragma unroll
        for (int it = 0; it < 4; ++it) { acc[it] = MFMA16(*(const LAS bf16x8*)(Am + (16 * it + q) * 72 + 32 * ks + 8 * gl), bv, acc[it]);
            acc[it] = MFMA16(*(const LAS bf16x8*)(Qin + (16 * it + q) * 72 + 32 * ks + 8 * gl), bs, acc[it]); }
    }
#pragma unroll
    for (int it = 0; it < 4; ++it)
#pragma unroll
        for (int reg = 0; reg < 4; ++reg) { float s = acc[it][reg] * acc[it][reg]; s += __shfl_xor(s, 1); s += __shfl_xor(s, 2); s += __shfl_xor(s, 4); s += __shfl_xor(s, 8);
            if (q == 0) ssqw[w * 64 + 16 * it + 4 * gl + reg] = s; }
    __syncthreads();
    const float gg = F.in[15][16 * w + q];
#pragma unroll
    for (int it = 0; it < 4; ++it)
#pragma unroll
        for (int reg = 0; reg < 4; ++reg) { const int i = 16 * it + 4 * gl + reg; float tot = 0.f;
#pragma unroll
            for (int w2 = 0; w2 < 8; ++w2) tot += ssqw[w2 * 64 + i];
            const float rs = __builtin_amdgcn_rsqf(tot * (1.0f / 128.0f) + RMS_EPS);
            const size_t r2 = (size_t)b * T + 64 * n + i;
            const float gr = bf2f(F.PROJ[r2 * NP + C_GR + h * 128 + 16 * w + q]);
            const float sl = gr * __builtin_amdgcn_rcpf(1.0f + fexp(-gr));
            F.MIX[r2 * 1024 + 512 + h * 128 + 16 * w + q] = f2b(acc[it][reg] * rs * gg * sl); }
    __syncthreads();
}

constexpr float NSA_C2 = 0.125f * 1.4426950408889634f, NSA_THR = 8.0f;
constexpr int NSA_STAGE_BYTES = 18432, NSA_VOFF = 9216, NSA_UM_OFF = 2 * NSA_STAGE_BYTES, NSA_KC_OFF = 40960, NSA_VC_OFF = NSA_KC_OFF + 18432;
__device__ __forceinline__ bf16x8 scale8(bf16x8 x, float c) { const v4u w = __builtin_bit_cast(v4u, x); v4u o;
    o.x = cvtpk(blo(w.x) * c, bhi(w.x) * c); o.y = cvtpk(blo(w.y) * c, bhi(w.y) * c); o.z = cvtpk(blo(w.z) * c, bhi(w.z) * c); o.w = cvtpk(blo(w.w) * c, bhi(w.w) * c); return __builtin_bit_cast(bf16x8, o); }
__device__ __forceinline__ float dot8(bf16x8 a, bf16x8 b) { const v4u x = __builtin_bit_cast(v4u, a), y = __builtin_bit_cast(v4u, b);
    return ((blo(x.x) * blo(y.x) + bhi(x.x) * bhi(y.x)) + (blo(x.y) * blo(y.y) + bhi(x.y) * bhi(y.y))) + ((blo(x.z) * blo(y.z) + bhi(x.z) * bhi(y.z)) + (blo(x.w) * blo(y.w) + bhi(x.w) * bhi(y.w))); }
struct NsaState { f32x4 O[2][4]; float m[2], l[2]; };
__device__ __forceinline__ void nsa_init(NsaState& st, const bf16x8 (&qf)[2][2], const bf16* Kself  , unsigned voK) {
    const bf16x8 k0 = ldb16(Kself, voK), k1 = ldb16(Kself + 32, voK);
#pragma unroll
    for (int r = 0; r < 2; ++r) { float s = dot8(qf[r][0], k0) + dot8(qf[r][1], k1); s += __shfl_xor(s, 16); s += __shfl_xor(s, 32); st.m[r] = s; st.l[r] = 0.f;
#pragma unroll
        for (int dt = 0; dt < 4; ++dt) st.O[r][dt] = (f32x4){0.f, 0.f, 0.f, 0.f}; }
}
__device__ __forceinline__ void nsa_tile(NsaState& st, const bf16x8 (&qf)[2][2], const float (&slope2)[2], const LAS bf16* Ks, const LAS bf16* Vs, int key0, int t, int q, int gl, bool selbit, int wlim, bool need_mask) {
#pragma unroll 1
    for (int half = 0; half < 2; ++half) {
        bf16x8 kf[2][2], vf[4];
#pragma unroll
        for (int kt = 0; kt < 2; ++kt)
#pragma unroll
            for (int ks = 0; ks < 2; ++ks) kf[kt][ks] = *(const LAS bf16x8*)(Ks + (32 * half + 16 * kt + q) * 72 + 32 * ks + 8 * gl);
#pragma unroll
        for (int dt = 0; dt < 4; ++dt) { const LAS bf16* vp = Vs + (16 * dt + q) * 72 + 32 * half + 4 * gl; const u32x2 a = *(const LAS u32x2*)vp, c = *(const LAS u32x2*)(vp + 16);
            v4u wv; wv.x = a.x; wv.y = a.y; wv.z = c.x; wv.w = c.y; vf[dt] = __builtin_bit_cast(bf16x8, wv); }
        const int kbase = key0 + 32 * half + 4 * gl;
        const float kb = (float)(kbase - t);
#pragma unroll
        for (int r = 0; r < 2; ++r) {
            const float c1 = slope2[r] * kb - st.m[r];
            f32x4 s0, s1;
#pragma unroll
            for (int reg = 0; reg < 4; ++reg) { s0[reg] = slope2[r] * (float)reg + c1; s1[reg] = slope2[r] * (float)(16 + reg) + c1; }
            s0 = MFMA16(kf[0][0], qf[r][0], s0); s0 = MFMA16(kf[0][1], qf[r][1], s0);
            s1 = MFMA16(kf[1][0], qf[r][0], s1); s1 = MFMA16(kf[1][1], qf[r][1], s1);
            if (need_mask) {
#pragma unroll
                for (int reg = 0; reg < 4; ++reg) { const int d0 = t - (kbase + reg), d1 = d0 - 16;
                    const bool ok0 = selbit && d0 >= 0 && d0 < wlim, ok1 = selbit && d1 >= 0 && d1 < wlim;
                    s0[reg] = ok0 ? s0[reg] : -INFINITY; s1[reg] = ok1 ? s1[reg] : -INFINITY; }
            }
            const float lmax = fmaxf(fmaxf(fmaxf(s0[0], s0[1]), fmaxf(s0[2], s0[3])), fmaxf(fmaxf(s1[0], s1[1]), fmaxf(s1[2], s1[3])));
            if (__ballot(lmax > NSA_THR) != 0ull) {
                float rm = fmaxf(lmax, __shfl_xor(lmax, 16)); rm = fmaxf(rm, __shfl_xor(rm, 32));
                const float dl = fmaxf(rm, 0.f), f = __builtin_amdgcn_exp2f(-dl);
                st.m[r] += dl; st.l[r] *= f;
#pragma unroll
                for (int reg = 0; reg < 4; ++reg) { s0[reg] -= dl; s1[reg] -= dl; }
#pragma unroll
                for (int dt = 0; dt < 4; ++dt) st.O[r][dt] *= f;
            }
            float ps = 0.f;
#pragma unroll
            for (int reg = 0; reg < 4; ++reg) { s0[reg] = __builtin_amdgcn_exp2f(s0[reg]); s1[reg] = __builtin_amdgcn_exp2f(s1[reg]); ps += s0[reg] + s1[reg]; }
            st.l[r] += ps;
            const bf16x8 pb = pack8(s0, s1);
#pragma unroll
            for (int dt = 0; dt < 4; ++dt) st.O[r][dt] = MFMA16(vf[dt], pb, st.O[r][dt]);
        }
    }
}
__device__ __forceinline__ void nsa_flush(NsaState& st, f32x4 (&tot)[2][4], const bf16* Pg  , int c, unsigned voG) {
#pragma unroll
    for (int r = 0; r < 2; ++r) { float l = st.l[r]; l += __shfl_xor(l, 16); l += __shfl_xor(l, 32);
        const float gate = __builtin_amdgcn_rcpf(1.0f + fexp(-ldb_bf(Pg + r * 3 + c, voG)));
        const float sc = gate * __builtin_amdgcn_rcpf(l);
#pragma unroll
        for (int dt = 0; dt < 4; ++dt) tot[r][dt] += st.O[r][dt] * sc; }
}
__device__ __forceinline__ void m2_nsa_unit(Frame& F, int b, int g, int cur) {
    int tid = F.tid; OPAQUE(tid);
    const int lane = tid & 63, q = lane & 15, gl = lane >> 4, w = F.wave;
    const int tgi = w & 3, pair = w >> 2;
    const int t0 = 64 * cur + 16 * tgi, t = t0 + q;
    const bf16* Pr = F.PROJ + ((size_t)b * T + t0) * NP;
    const bf16* Pq = Pr + C_Q + 4 * g * 64; const bf16* Pg = Pr + C_GN + (4 * g + 2 * pair) * 3;
    LAS unsigned char* L = F.lds + RING_OFF;
    LAS unsigned* um = (LAS unsigned*)(L + NSA_UM_OFF);
    const unsigned voQ = (unsigned)(q * NP + 8 * gl) * 2u, voG = (unsigned)(q * NP) * 2u;
    const float tf = (float)t;
    const int jw0 = (cur - 8) < 0 ? 0 : (cur - 8), nwin = cur + 1 - jw0;
    const bf16* Ksg = F.PROJ + (size_t)b * T * NP + C_KS + g * 64; const bf16* Kwg = F.PROJ + (size_t)b * T * NP + C_KW + g * 64;
    const bf16* VTs = F.VTS + (size_t)(b * 2 + g) * 64 * T; const bf16* VTw = F.VTW + (size_t)(b * 2 + g) * 64 * T;
    const int srow = tid >> 3, sch = tid & 7;
    const unsigned gK = (unsigned)(srow * NP + 8 * sch) * 2u, gV = (unsigned)(srow * T + 8 * sch) * 2u; const int lK = (srow * 72 + 8 * sch) * 2;
    unsigned remF = (cur <= 7) ? ((2u << cur) - 1u) : 0u; int fi = 0;
    v4u rk0, rv0, rk1, rv1, rk2, rv2;
#define NSA_FETCH(RK, RV) do { int j_; const bf16 *kp_, *vp_; if (fi < nwin) { j_ = jw0 + fi; kp_ = Kwg; vp_ = VTw; } else { j_ = __builtin_ctz(remF); remF &= remF - 1u; kp_ = Ksg; vp_ = VTs; } ++fi; \
        RK = *(const v4u*)((const char*)(kp_ + (size_t)j_ * 64 * NP) + gK); RV = *(const v4u*)((const char*)(vp_ + j_ * 64) + gV); } while (0)
#define NSA_STAGE(s_, RK, RV) do { LAS unsigned char* sb_ = L + (s_) * NSA_STAGE_BYTES; *(LAS v4u*)(sb_ + lK) = RK; *(LAS v4u*)(sb_ + NSA_VOFF + lK) = RV; } while (0)
    NSA_FETCH(rk0, rv0); NSA_FETCH(rk1, rv1);
    if (cur >= 1) NSA_FETCH(rk2, rv2);
    {
        const bf16* KCg = F.KC + (size_t)(b * 2 + g) * 128 * 64; const bf16* VCg = F.VTC + (size_t)(b * 2 + g) * 64 * 128;
#pragma unroll
        for (int i = 0; i < 2; ++i) { const int c = tid + 512 * i;
            *(LAS v4u*)(L + NSA_KC_OFF + ((c >> 3) * 72 + 8 * (c & 7)) * 2) = *(const v4u*)(KCg + 8 * c);
            *(LAS v4u*)(L + NSA_VC_OFF + ((c >> 4) * 136 + 8 * (c & 15)) * 2) = *(const v4u*)(VCg + 8 * c); }
    }
    __syncthreads();
    f32x4 tot[2][4];
    unsigned mask;
    {
        const LAS bf16* KCs = (const LAS bf16*)(L + NSA_KC_OFF); const LAS bf16* VCs = (const LAS bf16*)(L + NSA_VC_OFF);
        f32x4 psum[8];
#pragma unroll
        for (int nt = 0; nt < 8; ++nt) psum[nt] = (f32x4){0.f, 0.f, 0.f, 0.f};
#pragma unroll 1
        for (int r = 0; r < 4; ++r) {
            int glo = gl; OPAQUE(glo);
            const bf16x8 q0 = scale8(ldb16(Pq + r * 64, voQ), NSA_C2), q1 = scale8(ldb16(Pq + r * 64 + 32, voQ), NSA_C2);
            const float sl2 = __builtin_amdgcn_exp2f(-(float)(4 * g + r + 1)) * 1.4426950408889634f;
            f32x4 S[8]; const f32x4 z = (f32x4){0.f, 0.f, 0.f, 0.f};
#pragma unroll
            for (int nt = 0; nt < 8; ++nt) { const LAS bf16* kp = KCs + (16 * nt + q) * 72 + 8 * gl; S[nt] = MFMA16(*(const LAS bf16x8*)kp, q0, z); S[nt] = MFMA16(*(const LAS bf16x8*)(kp + 32), q1, S[nt]); }
            float mx = -1e30f;
#pragma unroll
            for (int nt = 0; nt < 8; ++nt)
#pragma unroll
                for (int reg = 0; reg < 4; ++reg) { const int n = 16 * nt + 4 * glo + reg; const bool valid = (16 * n + 31 <= t);
                    const float s = S[nt][reg] - sl2 * (tf - (16.0f * (float)n + 15.5f)); S[nt][reg] = valid ? s : -1e30f; mx = fmaxf(mx, S[nt][reg]); }
            mx = fmaxf(mx, __shfl_xor(mx, 16)); mx = fmaxf(mx, __shfl_xor(mx, 32));
            float sum = 0.f;
#pragma unroll
            for (int nt = 0; nt < 8; ++nt)
#pragma unroll
                for (int reg = 0; reg < 4; ++reg) { const float p = (S[nt][reg] > -1e29f) ? __builtin_amdgcn_exp2f(S[nt][reg] - mx) : 0.f; S[nt][reg] = p; sum += p; }
            sum += __shfl_xor(sum, 16); sum += __shfl_xor(sum, 32);
            const float inv = sum > 0.f ? 1.0f / sum : 0.f;
#pragma unroll
            for (int nt = 0; nt < 8; ++nt) { S[nt] = S[nt] * inv; psum[nt] += S[nt]; }
            if ((r >> 1) == pair) {
                f32x4 oc[4];
#pragma unroll
                for (int dt = 0; dt < 4; ++dt) oc[dt] = (f32x4){0.f, 0.f, 0.f, 0.f};
#pragma unroll
                for (int kp = 0; kp < 4; ++kp) { const bf16x8 pb = pack8(S[2 * kp], S[2 * kp + 1]);
#pragma unroll
                    for (int dt = 0; dt < 4; ++dt) { const LAS bf16* vp = VCs + (16 * dt + q) * 136 + 32 * kp + 4 * gl; const u32x2 a = *(const LAS u32x2*)vp, c = *(const LAS u32x2*)(vp + 16);
                        v4u wv; wv.x = a.x; wv.y = a.y; wv.z = c.x; wv.w = c.y; oc[dt] = MFMA16(__builtin_bit_cast(bf16x8, wv), pb, oc[dt]); } }
                const float gate = __builtin_amdgcn_rcpf(1.0f + fexp(-ldb_bf(Pg + (r & 1) * 3, voG)));
                if (r & 1) {
#pragma unroll
                    for (int dt = 0; dt < 4; ++dt) tot[1][dt] = oc[dt] * gate;
                } else {
#pragma unroll
                    for (int dt = 0; dt < 4; ++dt) tot[0][dt] = oc[dt] * gate;
                }
            }
        }
        if (cur <= 7) mask = (2u << cur) - 1u;
        else {
            float v[8]; float shp = 0.f;
#pragma unroll
            for (int nt = 0; nt < 8; ++nt) { const float sh = __shfl(psum[nt][3], (lane + 48) & 63);
                const float pterm = (gl > 0) ? sh : shp; shp = sh;
                v[nt] = pterm + ((psum[nt][0] + psum[nt][1]) + (psum[nt][2] + psum[nt][3])); }
            mask = 1u | (1u << cur) | (1u << (cur - 1));
            unsigned taken = 0u;
#pragma unroll
            for (int round = 0; round < 5; ++round) {
                float bv = -1.f; int bi = 99;
#pragma unroll
                for (int i = 0; i < 8; ++i) { const int s = 4 * i + gl; const bool ok = (s >= 1) && (s <= cur - 2) && (((taken >> i) & 1u) == 0u); if (ok && v[i] > bv) { bv = v[i]; bi = s; } }
#pragma unroll
                for (int off = 16; off <= 32; off <<= 1) { const float ov = __shfl_xor(bv, off); const int oi = __shfl_xor(bi, off); if (ov > bv || (ov == bv && oi < bi)) { bv = ov; bi = oi; } }
                if (bi < 32) { mask |= 1u << bi; if ((bi & 3) == gl) taken |= 1u << (bi >> 2); }
            }
        }
    }
    unsigned wm = 0u;
#pragma unroll
    for (int j = 0; j < 32; ++j) wm |= (__ballot((mask >> j) & 1u) != 0ull) ? (1u << j) : 0u;
    if (lane == 0) um[w] = wm;
    NSA_STAGE(0, rk0, rv0);
    __syncthreads();
    unsigned U = 0u;
#pragma unroll
    for (int i = 0; i < 8; ++i) U |= um[i];
    U = __builtin_amdgcn_readfirstlane(U);
    if (cur > 7) remF = U;
    const int nsel = __builtin_popcount(U), NT = nwin + nsel;
    bf16x8 qf[2][2]; float slope2[2];
#pragma unroll
    for (int r = 0; r < 2; ++r) { slope2[r] = __builtin_amdgcn_exp2f(-(float)(4 * g + 2 * pair + r + 1)) * 1.4426950408889634f;
#pragma unroll
        for (int ks = 0; ks < 2; ++ks) qf[r][ks] = scale8(ldb16(Pq + (2 * pair + r) * 64 + 32 * ks, voQ), NSA_C2); }
    NsaState st;
    const unsigned voK = (unsigned)(q * NP + 8 * gl) * 2u;
    nsa_init(st, qf, Pr + C_KW + g * 64, voK);
    unsigned remC = U;
    int i3 = 0;
    for (int i = 0; i < NT; ++i) {
        const bool st_next = (i + 1 < NT), fe_next = (i + 3 < NT);
        if (i3 == 0) { if (st_next) NSA_STAGE((i + 1) & 1, rk1, rv1); if (fe_next) NSA_FETCH(rk0, rv0); }
        else if (i3 == 1) { if (st_next) NSA_STAGE((i + 1) & 1, rk2, rv2); if (fe_next) NSA_FETCH(rk1, rv1); }
        else { if (st_next) NSA_STAGE((i + 1) & 1, rk0, rv0); if (fe_next) NSA_FETCH(rk2, rv2); }
        i3 = (i3 == 2) ? 0 : i3 + 1;
        const LAS bf16* Ks = (const LAS bf16*)(L + (i & 1) * NSA_STAGE_BYTES); const LAS bf16* Vs = Ks + NSA_VOFF / 2;
        int key0, wlim; bool selbit, need_mask, run;
        if (i < nwin) {
            const int j = jw0 + i; key0 = 64 * j; wlim = 512; selbit = true;
            run = (key0 + 63 >= t0 - 511) && (key0 <= t0 + 15); need_mask = !(key0 >= t0 + 15 - 511 && key0 + 63 <= t0);
        } else {
            if (i == nwin) { nsa_flush(st, tot, Pg, 2, voG); nsa_init(st, qf, Pr + C_KS + g * 64, voK); }
            const int j = __builtin_ctz(remC); remC &= remC - 1u;
            selbit = ((mask >> j) & 1u) != 0u; const unsigned long long bal = __ballot(selbit);
            key0 = 64 * j; wlim = 0x7fffffff; run = (bal != 0ull); need_mask = (bal != ~0ull) || (j == cur);
        }
        if (run) nsa_tile(st, qf, slope2, Ks, Vs, key0, t, q, gl, selbit, wlim, need_mask);
        __syncthreads();
    }
    nsa_flush(st, tot, Pg, 1, voG);
    bf16* Mo = F.MIX + ((size_t)b * T + t0) * 1024 + (4 * g + 2 * pair) * 64; const unsigned voM = (unsigned)(q * 1024 + 4 * gl) * 2u;
#pragma unroll
    for (int r = 0; r < 2; ++r)
#pragma unroll
        for (int dt = 0; dt < 4; ++dt) { const f32x4 o = tot[r][dt]; u32x2 wv; wv.x = cvtpk(o[0], o[1]); wv.y = cvtpk(o[2], o[3]); *(u32x2*)((char*)(Mo + r * 64 + 16 * dt) + voM) = wv; }
#undef NSA_FETCH
#undef NSA_STAGE
}

__device__ __forceinline__ void p8_final_norm(Frame& F) {
    const int gw = F.vcu * NWAVES + F.wave, NGW = F.G * NWAVES;
    const GAS f32x4* gp = (const GAS f32x4*)F.in[21] + F.lane;
    f32x4 gv[4];
#pragma unroll
    for (int j = 0; j < 4; ++j) gv[j] = gp[64 * j];
    for (int m = gw; m < M; m += NGW) {
        GAS f32x4* xr = (GAS f32x4*)(F.out + (size_t)m * D) + F.lane;
        f32x4 v[4]; float s = 0.f;
#pragma unroll
        for (int j = 0; j < 4; ++j) { v[j] = xr[64 * j]; s += (v[j].x * v[j].x + v[j].y * v[j].y) + (v[j].z * v[j].z + v[j].w * v[j].w); }
        const float rs = __builtin_amdgcn_rsqf(wave_sum(s) * (1.0f / 1024.0f) + RMS_EPS);
#pragma unroll
        for (int j = 0; j < 4; ++j) xr[64 * j] = v[j] * rs * gv[j];
    }
}

struct Args { const float* in[22]; float* out; unsigned char* ws; };
__global__ void __launch_bounds__(NWAVES * 64, 2) hybrid_fwd(Args args) {
    extern __shared__ __attribute__((aligned(16))) unsigned char lds[];
    Frame F;
    F.lds = (LAS unsigned char*)lds;
    F.MISC = (volatile LAS unsigned*)(F.lds + MISC_OFF);
    F.tid = threadIdx.x; F.lane = F.tid & 63; F.wave = __builtin_amdgcn_readfirstlane(F.tid >> 6);
    F.G = gridDim.x; { const int bx = blockIdx.x; F.vcu = (F.G % 8 == 0) ? (bx % 8) * (F.G / 8) + bx / 8 : bx; }
    unsigned char* ws = args.ws;
    F.ctl = (gu32*)(ws + WS_CTL);
#pragma unroll
    for (int i = 0; i < 22; ++i) F.in[i] = args.in[i];
    F.out = args.out;
    F.W1GU = (bf16*)(ws + WS_W1GU); F.W1D = (bf16*)(ws + WS_W1D); F.WIN = (bf16*)(ws + WS_WIN); F.WOUT = (bf16*)(ws + WS_WOUT); F.W2GU = (bf16*)(ws + WS_W2GU); F.W2D = (bf16*)(ws + WS_W2D);
    F.WC1K = (bf16*)(ws + WS_WC1K); F.WC1V = (bf16*)(ws + WS_WC1V); F.WC2K = (bf16*)(ws + WS_WC2K); F.WC2V = (bf16*)(ws + WS_WC2V);
    F.KC = (bf16*)(ws + WS_KC); F.VTC = (bf16*)(ws + WS_VTC); F.XB = (bf16*)(ws + WS_XB); F.H = (bf16*)(ws + WS_R); F.PROJ = (bf16*)(ws + WS_R);
    F.MIX = (bf16*)(ws + WS_MIX); F.VTS = (bf16*)(ws + WS_VTS); F.VTW = (bf16*)(ws + WS_VTW); F.ST = (bf16*)(ws + WS_ST);
    F.CBIAS = (float*)(ws + WS_CBIAS); F.SSQ0 = (float*)(ws + WS_SSQ0); F.SSQA = (float*)(ws + WS_SSQA); F.SSQB = (float*)(ws + WS_SSQB); F.DEC = (float*)(ws + WS_DEC); F.KVT = (float*)(ws + WS_KVT);
    for (int u = F.tid; u < (LDS_BYTES - LDSCTL_OFF) / 4; u += NWAVES * 64) ((LAS unsigned*)(F.lds + LDSCTL_OFF))[u] = 0u;
    __syncthreads();
    XcdBarrier bar = xcd_barrier_post((unsigned*)(F.ctl + CW_BAR), F.MISC + 8);
#define GRID_BAR() do { for (int rb_ = 0; rb_ < REP_BAR; ++rb_) xcd_barrier(bar); asm volatile("" : "+v"(F.tid)); F.lane = F.tid & 63; } while (0)
    const int gw = F.vcu * NWAVES + F.wave, NGW = F.G * NWAVES;

#ifndef NO_P0
    for (int rep = 0; rep < REP_P0; ++rep) p0_prologue(F);
#endif
    GRID_BAR();
#ifndef NO_GEMM
    { pg8::Gemm g{F.XB, F.W1GU, M, 2 * FF, D}; pg8::StaticOrder S; S.init(M, 2 * FF, F.G, (int)blockIdx.x);
      pg8::EpiSwiGLU<1> E{F.H, FF, F.SSQ0};
      for (int rep = 0; rep < REP_P1; ++rep) pg8::gemm_phase<pg8::EpiSwiGLU<1>, pg8::StaticOrder, true, true>(F.lds + RING_OFF, g, S, E); }
#endif
    GRID_BAR();
#ifndef NO_GEMM
    { pg8::Gemm g{F.H, F.W1D, M, D, FF}; pg8::StaticOrder S; S.init(M, D, F.G, (int)blockIdx.x);
      pg8::EpiResid<true> E{F.in[0], F.out, F.XB, F.SSQA, 0.5f};
      for (int rep = 0; rep < REP_P2; ++rep) pg8::gemm_phase<pg8::EpiResid<true>, pg8::StaticOrder, true, true>(F.lds + RING_OFF, g, S, E); }
#endif
    GRID_BAR();
#ifndef NO_GEMM
    { pg8::Gemm g{F.XB, F.WIN, M, NP, D}; pg8::StaticOrder S; S.init(M, NP, F.G, (int)blockIdx.x);
      pg8::EpiProj<16> E{F.PROJ, NP, F.SSQA};
      for (int rep = 0; rep < REP_P3; ++rep) pg8::gemm_phase<pg8::EpiProj<16>, pg8::StaticOrder, true, true>(F.lds + RING_OFF, g, S, E); }
#endif
    GRID_BAR();
#ifndef NO_M1
    for (int rep = 0; rep < REP_M13; ++rep) {
    for (int ci = F.vcu; ci < 256; ci += F.G) m1_compress(F, ci);
    for (int it = F.vcu; it < 1024; it += F.G) m1_gla_kv(F, it);
    for (int ti = gw; ti < 1024; ti += NGW) m1_transpose(F, ti);
    }
#endif
    GRID_BAR();
#ifndef NO_NSA
    for (int rep = 0; rep < REP_M2; ++rep)
    for (int wi = F.vcu; wi < 256; wi += F.G) { const int b = wi >> 5, g = (wi >> 4) & 1, x = wi & 15;
#pragma unroll 1
        for (int u = 0; u < 2; ++u) m2_nsa_unit(F, b, g, u ? x : 31 - x); }
#endif
#ifndef NO_SCAN
    for (int rep = 0; rep < REP_SCAN; ++rep)
    for (int k = gw; k < 2048; k += NGW) { const int wi = k >> 3; if ((wi & 15) < 8) m2_scan(F, (((wi >> 4) * 8 + (wi & 15)) * 8) + (k & 7)); }
#endif
    GRID_BAR();
#ifndef NO_GLA3
    for (int rep = 0; rep < REP_M13; ++rep)
    for (int it = F.vcu; it < 1024; it += F.G) m3_gla_out(F, it);
#endif
    GRID_BAR();
#ifndef NO_GEMM
    { pg8::Gemm g{F.MIX, F.WOUT, M, D, D}; pg8::StaticOrder S; S.init(M, D, F.G, (int)blockIdx.x);
      pg8::EpiResid<true> E{F.out, F.out, F.XB, F.SSQB, 1.0f};
      pg8::gemm_phase<pg8::EpiResid<true>, pg8::StaticOrder, true, true>(F.lds + RING_OFF, g, S, E); }
#endif
    GRID_BAR();
#ifndef NO_GEMM
    { pg8::Gemm g{F.XB, F.W2GU, M, 2 * FF, D}; pg8::StaticOrder S; S.init(M, 2 * FF, F.G, (int)blockIdx.x);
      pg8::EpiSwiGLU<16> E{F.H, FF, F.SSQB};
      pg8::gemm_phase<pg8::EpiSwiGLU<16>, pg8::StaticOrder, true, true>(F.lds + RING_OFF, g, S, E); }
#endif
    GRID_BAR();
#ifndef NO_GEMM
    { pg8::Gemm g{F.H, F.W2D, M, D, FF}; pg8::StaticOrder S; S.init(M, D, F.G, (int)blockIdx.x);
      pg8::EpiResid<false> E{F.out, F.out, nullptr, nullptr, 0.5f};
      pg8::gemm_phase<pg8::EpiResid<false>, pg8::StaticOrder, true, true>(F.lds + RING_OFF, g, S, E); }
#endif
    GRID_BAR();
#ifndef NO_P8
    p8_final_norm(F);
#endif
}

extern "C" void kernel_launch(void* const* d_in, const int* in_sizes, int n_in, void* d_out, int out_size, void* d_ws, size_t ws_size, hipStream_t stream) {
    static int grid = 0;
    if (grid == 0) {
        if (n_in != 22 || in_sizes[0] != M * D || out_size != M * D || ws_size < WS_END) { fprintf(stderr, "kernel_launch: unexpected shapes (n_in %d, in0 %d, out %d, ws %zu); nothing launched\n", n_in, n_in > 0 ? in_sizes[0] : -1, out_size, ws_size); grid = -1; return; }
        int dev = 0, cus = 0;
        if (hipGetDevice(&dev) != hipSuccess || hipDeviceGetAttribute(&cus, hipDeviceAttributeMultiprocessorCount, dev) != hipSuccess) { fprintf(stderr, "kernel_launch: device query failed\n"); grid = -1; return; }
        if (hipFuncSetAttribute((const void*)hybrid_fwd, hipFuncAttributeMaxDynamicSharedMemorySize, LDS_BYTES) != hipSuccess) { fprintf(stderr, "kernel_launch: hipFuncSetAttribute failed\n"); grid = -1; return; }
        (void)hipGetLastError();
        grid = cus;
    }
    if (grid < 0) return;
    if (hipMemsetAsync((char*)d_ws + WS_CTL, 0, CTL_ZERO_BYTES, stream) != hipSuccess) { fprintf(stderr, "kernel_launch: hipMemsetAsync failed\n"); return; }
    Args a{};
    for (int i = 0; i < 22; ++i) a.in[i] = (const float*)d_in[i];
    a.out = (float*)d_out; a.ws = (unsigned char*)d_ws;
    hipLaunchKernelGGL(hybrid_fwd, dim3(grid), dim3(NWAVES * 64), LDS_BYTES, stream, a);
}
```

```cpp
#include <hip/hip_runtime.h>
#include <cstdio>
#include <cstdint>
namespace pg8 {
#define PG8_LAS __attribute__((address_space(3)))
typedef unsigned short bf16_t;
typedef short bf16x8 __attribute__((ext_vector_type(8)));
typedef float f32x4 __attribute__((ext_vector_type(4)));
typedef unsigned u32x4 __attribute__((ext_vector_type(4)));
constexpr int BM = 256, BK = 64, HALF = 128, HTB = HALF * BK * 2  , STAGE_BYTES = 8 * HTB, NXCD = 8, WGM = 8;

__host__ __device__ __forceinline__ int lds_byte(int r, int c) { const int st = (r >> 4) * 2 + (c >> 5), rr = r & 15, cc = c & 31, ob = rr * 64 + cc * 2; return st * 1024 + (ob ^ (((ob >> 9) & 1) << 5)); }
__host__ __device__ __forceinline__ void stage_rc(int b, int& R, int& C) { const int st = b / 1024, sb = b % 1024, swz = sb ^ (((sb >> 9) & 1) << 5); R = (st >> 1) * 16 + swz / 64; C = (st & 1) * 32 + (swz % 64) / 2; }
__host__ __device__ __forceinline__ int perm32(int rho) { const int n = rho >> 4, i = rho & 15; return 8 * (i >> 2) + 4 * n + (i & 3); }

struct Unit { int pm, pn; };
struct Gemm { const bf16_t* A; const bf16_t* Bt; int M, N, K; };

struct StaticOrder {
    int nM, nN, nwg, G, c;
    __host__ __device__ void init(int M, int N, int G_, int c_) { nM = M / BM; nN = N / BM; nwg = nM * nN; G = G_; c = c_; }
    __host__ __device__ bool next(int i, Unit& u) const {
        const long L = (long)i * G + c; if (L >= nwg) return false;
        int wgid = (int)L; { const int q = nwg / NXCD, r = nwg % NXCD, xcd = wgid % NXCD, off = wgid / NXCD; wgid = (xcd < r ? xcd * (q + 1) : r * (q + 1) + (xcd - r) * q) + off; }
        const int nig = WGM * nN, gid = wgid / nig, fm = gid * WGM, gsz = (nM - fm) < WGM ? (nM - fm) : WGM;
        u.pm = fm + ((wgid % nig) % gsz); u.pn = (wgid % nig) / gsz; return true;
    }
    __device__ __forceinline__ void a_ready(const Unit&) const {}
    __device__ __forceinline__ void done(const Unit&) const {}
};
__device__ __forceinline__ unsigned cvt_pk_bf16(float lo, float hi) { unsigned r; asm volatile("v_cvt_pk_bf16_f32 %0, %1, %2" : "=v"(r) : "v"(lo), "v"(hi)); return r; }
typedef float f32x2 __attribute__((ext_vector_type(2)));
typedef unsigned u32x2 __attribute__((ext_vector_type(2)));
constexpr float RMS_EPS = 1e-6f;
template <int NPARTS> __device__ __forceinline__ float row_rstd(const float* ssq, int row) {
    float s;
    if (NPARTS == 1) s = ssq[row];
    else { const f32x4* p = (const f32x4*)(ssq + (size_t)row * 16); const f32x4 a = p[0], b = p[1], c = p[2], d = p[3]; const f32x4 t = (a + b) + (c + d); s = (t[0] + t[1]) + (t[2] + t[3]); }
    return __builtin_amdgcn_rsqf(s * (1.0f / 1024.0f) + RMS_EPS);
}
__device__ __forceinline__ float silu_f(float x) { return x * __builtin_amdgcn_rcpf(1.0f + __builtin_amdgcn_exp2f(-1.4426950408889634f * x)); }
template <int NPARTS> struct EpiSwiGLU {
    static constexpr bool PERM = true, AFTER_DRAIN = false;
    bf16_t* H; int ldh; const float* ssq;
    __device__ __forceinline__ void operator()(const f32x4 (&acc)[2][2][4][2], const Unit& u, int wr, int wc, int fr, int fq) const {
        const int row0 = u.pm * BM + wr * 64 + fr, col0 = u.pn * 128 + wc * 32 + 8 * fq;
#pragma unroll
        for (int ai = 0; ai < 2; ++ai)
#pragma unroll
            for (int m = 0; m < 4; ++m) { const int row = row0 + ai * HALF + m * 16; const float rs = row_rstd<NPARTS>(ssq, row);
                const f32x4 g0 = acc[ai][0][m][0] * rs, g1 = acc[ai][0][m][1] * rs, u0 = acc[ai][1][m][0] * rs, u1 = acc[ai][1][m][1] * rs;
                u32x4 w;
                w.x = cvt_pk_bf16(silu_f(g0[0]) * u0[0], silu_f(g0[1]) * u0[1]); w.y = cvt_pk_bf16(silu_f(g0[2]) * u0[2], silu_f(g0[3]) * u0[3]);
                w.z = cvt_pk_bf16(silu_f(g1[0]) * u1[0], silu_f(g1[1]) * u1[1]); w.w = cvt_pk_bf16(silu_f(g1[2]) * u1[2], silu_f(g1[3]) * u1[3]);
                *(u32x4*)(H + (size_t)row * ldh + col0) = w; if (m & 1) asm volatile("" ::: "memory"); }
    }
};
template <int NPARTS> struct EpiProj {
    static constexpr bool PERM = true, AFTER_DRAIN = false;
    bf16_t* O; int ldc; const float* ssq;
    __device__ __forceinline__ void operator()(const f32x4 (&acc)[2][2][4][2], const Unit& u, int wr, int wc, int fr, int fq) const {
        const int row0 = u.pm * BM + wr * 64 + fr, col0 = u.pn * BM + wc * 32 + 8 * fq;
#pragma unroll
        for (int ai = 0; ai < 2; ++ai)
#pragma unroll
            for (int m = 0; m < 4; ++m) { const int row = row0 + ai * HALF + m * 16; const float rs = row_rstd<NPARTS>(ssq, row);
#pragma unroll
                for (int bj = 0; bj < 2; ++bj) { const f32x4 v0 = acc[ai][bj][m][0] * rs, v1 = acc[ai][bj][m][1] * rs; u32x4 w;
                    w.x = cvt_pk_bf16(v0[0], v0[1]); w.y = cvt_pk_bf16(v0[2], v0[3]); w.z = cvt_pk_bf16(v1[0], v1[1]); w.w = cvt_pk_bf16(v1[2], v1[3]);
                    *(u32x4*)(O + (size_t)row * ldc + col0 + bj * HALF) = w; } if (m & 1) asm volatile("" ::: "memory"); }
    }
};
template <bool WB> struct EpiResid {
    static constexpr bool PERM = false, AFTER_DRAIN = false;
    const float* rin; float* out; bf16_t* xb; float* ssqp; float alpha;
    __device__ __forceinline__ void operator()(const f32x4 (&acc)[2][2][4][2], const Unit& u, int wr, int wc, int fr, int fq) const {
        const int row0 = u.pm * BM + wr * 64 + fr, col0 = u.pn * BM + wc * 32 + 4 * fq;
#pragma unroll
        for (int ai = 0; ai < 2; ++ai)
#pragma unroll
            for (int m = 0; m < 4; ++m) { const int row = row0 + ai * HALF + m * 16; float ss = 0.f;
#pragma unroll
                for (int bj = 0; bj < 2; ++bj)
#pragma unroll
                    for (int n = 0; n < 2; ++n) { const size_t off = (size_t)row * 1024 + col0 + bj * HALF + n * 16;
                        const f32x4 o = *(const f32x4*)(rin + off) + acc[ai][bj][m][n] * alpha; *(f32x4*)(out + off) = o;
                        if (WB) { u32x2 w; w.x = cvt_pk_bf16(o[0], o[1]); w.y = cvt_pk_bf16(o[2], o[3]); *(u32x2*)(xb + off) = w; ss += (o[0] * o[0] + o[1] * o[1]) + (o[2] * o[2] + o[3] * o[3]); } }
                if (WB) { ss += __shfl_xor(ss, 16); ss += __shfl_xor(ss, 32); if (fq == 0) ssqp[(size_t)row * 16 + u.pn * 4 + wc] = ss; } asm volatile("" ::: "memory"); }
    }
};
template <class Epi, class Sched, bool ALIGN_EPI = false, bool SP2 = false>
__device__ __forceinline__ void gemm_phase(PG8_LAS unsigned char* lds, const Gemm g, const Sched& S, const Epi& E) {
    int tid_ = threadIdx.x; asm volatile("" : "+v"(tid_)); const int tid = tid_, wid = __builtin_amdgcn_readfirstlane(tid >> 6), lane = tid & 63, wr = wid >> 2, wc = wid & 3, fr = lane & 15, fq = lane >> 4;
    const int K = g.K, nt = K / BK;
    unsigned voffA[2], voffB[2];
#pragma unroll
    for (int i = 0; i < 2; ++i) { int R, C; stage_rc(tid * 16 + i * 8192, R, C); const int Rb = Epi::PERM ? ((R & ~31) + perm32(R & 31)) : R;
        voffA[i] = (unsigned)(R * K + C) * 2u; voffB[i] = (unsigned)(Rb * K + C) * 2u; }
    const size_t kstep = (size_t)(BK * 2);
    const size_t hstep = (size_t)HALF * K * 2;
    const size_t tstep = 2 * hstep;
    const unsigned ldsw = (unsigned)wid * 1024u;
    const int aoff = lds_byte(wr * 64 + fr, fq * 8), boff = lds_byte(wc * 32 + fr, fq * 8);
#define PG8_SA(b, h) (((b) * 2 + (h)) * HTB)
#define PG8_SB(b, h) ((4 + (b) * 2 + (h)) * HTB)
#define PG8_STAGE(bufoff, gbase, voff) do { _Pragma("unroll") for (int _i = 0; _i < 2; ++_i) \
        __builtin_amdgcn_global_load_lds((const unsigned*)((const char*)(gbase) + (voff)[_i]), (PG8_LAS unsigned*)(lds + (bufoff) + ldsw + _i * 8192), 16, 0, 0); } while (0)
#define PG8_LDA(dst, b, h) do { _Pragma("unroll") for (int m = 0; m < 4; ++m) _Pragma("unroll") for (int k = 0; k < 2; ++k) dst[m][k] = *(const PG8_LAS bf16x8*)(lds + PG8_SA(b, h) + aoff + m * 2048 + k * 1024); } while (0)
#define PG8_LDB(dst, b, h) do { _Pragma("unroll") for (int n = 0; n < 2; ++n) _Pragma("unroll") for (int k = 0; k < 2; ++k) dst[n][k] = *(const PG8_LAS bf16x8*)(lds + PG8_SB(b, h) + boff + n * 2048 + k * 1024); } while (0)
#define PG8_MMA(ai, bj, At, Bt) do { __builtin_amdgcn_s_setprio(1); _Pragma("unroll") for (int m = 0; m < 4; ++m) _Pragma("unroll") for (int n = 0; n < 2; ++n) _Pragma("unroll") for (int k = 0; k < 2; ++k) \
        acc[ai][bj][m][n] = __builtin_amdgcn_mfma_f32_16x16x32_bf16(Bt[n][k], At[m][k], acc[ai][bj][m][n], 0, 0, 0); __builtin_amdgcn_s_setprio(0); } while (0)
#define PG8_WAIT_V(n) asm volatile("s_waitcnt vmcnt(" #n ")" ::: "memory")
#define PG8_WAIT_L(n) asm volatile("s_waitcnt lgkmcnt(" #n ")" ::: "memory")
#define PG8_BAR __builtin_amdgcn_s_barrier()
#define PG8_SCHED __builtin_amdgcn_sched_barrier(0)
    Unit cur, nxt; int ui = 0;
    if (!S.next(0, cur)) return;
    f32x4 acc[2][2][4][2];
#pragma unroll
    for (int a = 0; a < 2; ++a)
#pragma unroll
        for (int b = 0; b < 2; ++b)
#pragma unroll
            for (int m = 0; m < 4; ++m)
#pragma unroll
                for (int n = 0; n < 2; ++n) acc[a][b][m][n] = (f32x4){0.f, 0.f, 0.f, 0.f};
    bf16x8 At[4][2], B0[2][2], B1[2][2];
    const char* cA = (const char*)g.A + (size_t)cur.pm * tstep; const char* cB = (const char*)g.Bt + (size_t)cur.pn * tstep;
    S.a_ready(cur);
    if constexpr (SP2) {
        PG8_STAGE(PG8_SB(0, 0), cB, voffB); PG8_STAGE(PG8_SB(0, 1), cB + hstep, voffB); PG8_STAGE(PG8_SA(0, 0), cA, voffA); PG8_STAGE(PG8_SA(0, 1), cA + hstep, voffA);
        if (wr == 1) PG8_BAR;
        PG8_WAIT_V(2); PG8_BAR;
        PG8_STAGE(PG8_SB(1, 0), cB + kstep, voffB); PG8_STAGE(PG8_SA(1, 0), cA + kstep, voffA); PG8_STAGE(PG8_SB(1, 1), cB + hstep + kstep, voffB);
        PG8_WAIT_V(6); PG8_BAR;
    } else {
        PG8_STAGE(PG8_SB(0, 0), cB, voffB); PG8_STAGE(PG8_SA(0, 0), cA, voffA); PG8_STAGE(PG8_SB(0, 1), cB + hstep, voffB); PG8_STAGE(PG8_SA(0, 1), cA + hstep, voffA);
        if (wr == 1) PG8_BAR;
        PG8_WAIT_V(4); PG8_BAR;
        PG8_STAGE(PG8_SB(1, 0), cB + kstep, voffB); PG8_STAGE(PG8_SA(1, 0), cA + kstep, voffA); PG8_STAGE(PG8_SB(1, 1), cB + hstep + kstep, voffB);
        PG8_WAIT_V(6); PG8_BAR;
    }
    for (;;) {
        const bool has_next = S.next(ui + 1, nxt);
        const char* nA = has_next ? (const char*)g.A + (size_t)nxt.pm * tstep : cA; const char* nB = has_next ? (const char*)g.Bt + (size_t)nxt.pn * tstep : cB;
        for (int t = 0; t < nt; t += 2) {
            const bool last = (t == nt - 2);
            const char* a1 = cA + (size_t)(t + 1) * kstep;
            const char* a2 = last ? nA : cA + (size_t)(t + 2) * kstep; const char* b2 = last ? nB : cB + (size_t)(t + 2) * kstep;
            const char* a3 = a2 + kstep; const char* b3 = b2 + kstep;
            if (last && has_next) S.a_ready(nxt);
            if constexpr (SP2) {
            PG8_LDB(B0, 0, 0); PG8_LDB(B1, 0, 1); PG8_SCHED; PG8_LDA(At, 0, 0); PG8_STAGE(PG8_SA(1, 1), a1 + hstep, voffA);
            PG8_WAIT_V(8); PG8_WAIT_L(0); PG8_BAR; PG8_MMA(0, 0, At, B0); PG8_MMA(0, 1, At, B1); PG8_BAR; PG8_SCHED;
            PG8_LDA(At, 0, 1); PG8_STAGE(PG8_SB(0, 0), b2, voffB); PG8_STAGE(PG8_SB(0, 1), b2 + hstep, voffB); PG8_STAGE(PG8_SA(0, 0), a2, voffA);
            PG8_WAIT_V(8); PG8_WAIT_L(0); PG8_BAR; PG8_MMA(1, 0, At, B0); PG8_MMA(1, 1, At, B1); PG8_BAR; PG8_SCHED;
            PG8_LDB(B0, 1, 0); PG8_LDB(B1, 1, 1); PG8_SCHED; PG8_LDA(At, 1, 0); PG8_STAGE(PG8_SA(0, 1), a2 + hstep, voffA);
            PG8_WAIT_V(8); PG8_WAIT_L(0); PG8_BAR; PG8_MMA(0, 0, At, B0); PG8_MMA(0, 1, At, B1); PG8_BAR; PG8_SCHED;
            PG8_LDA(At, 1, 1); PG8_STAGE(PG8_SB(1, 0), b3, voffB); PG8_STAGE(PG8_SB(1, 1), b3 + hstep, voffB); PG8_STAGE(PG8_SA(1, 0), a3, voffA);
            PG8_WAIT_V(8); PG8_WAIT_L(0); PG8_BAR; PG8_MMA(1, 0, At, B0); PG8_MMA(1, 1, At, B1); PG8_BAR; PG8_SCHED;
            } else {
            PG8_LDB(B0, 0, 0); PG8_SCHED; PG8_LDA(At, 0, 0); PG8_STAGE(PG8_SA(1, 1), a1 + hstep, voffA);
            PG8_WAIT_L(8); PG8_BAR; PG8_WAIT_L(0); PG8_MMA(0, 0, At, B0); PG8_BAR; PG8_SCHED;
            PG8_LDB(B1, 0, 1); PG8_STAGE(PG8_SB(0, 0), b2, voffB);
            PG8_BAR; PG8_WAIT_L(0); PG8_MMA(0, 1, At, B1); PG8_BAR;
            PG8_LDA(At, 0, 1); PG8_STAGE(PG8_SA(0, 0), a2, voffA);
            PG8_BAR; PG8_WAIT_L(0); PG8_MMA(1, 0, At, B0); PG8_BAR; PG8_SCHED;
            PG8_STAGE(PG8_SB(0, 1), b2 + hstep, voffB);
            PG8_WAIT_V(6); PG8_BAR; PG8_MMA(1, 1, At, B1); PG8_BAR;
            PG8_LDB(B0, 1, 0); PG8_SCHED; PG8_LDA(At, 1, 0); PG8_STAGE(PG8_SA(0, 1), a2 + hstep, voffA);
            PG8_WAIT_L(8); PG8_BAR; PG8_WAIT_L(0); PG8_MMA(0, 0, At, B0); PG8_BAR; PG8_SCHED;
            PG8_LDB(B1, 1, 1); PG8_STAGE(PG8_SB(1, 0), b3, voffB);
            PG8_BAR; PG8_WAIT_L(0); PG8_MMA(0, 1, At, B1); PG8_BAR;
            PG8_LDA(At, 1, 1); PG8_STAGE(PG8_SA(1, 0), a3, voffA);
            PG8_BAR; PG8_WAIT_L(0); PG8_MMA(1, 0, At, B0); PG8_BAR; PG8_SCHED;
            PG8_STAGE(PG8_SB(1, 1), b3 + hstep, voffB);
            PG8_WAIT_V(6); PG8_BAR; PG8_MMA(1, 1, At, B1); PG8_BAR;
            }
        }
        if constexpr (ALIGN_EPI) { if (wr == 0) PG8_BAR; }
        if constexpr (!Epi::AFTER_DRAIN) { E(acc, cur, wr, wc, fr, fq); S.done(cur); }
        if (!has_next) break;
#pragma unroll
        for (int a = 0; a < 2; ++a)
#pragma unroll
            for (int b = 0; b < 2; ++b)
#pragma unroll
                for (int m = 0; m < 4; ++m)
#pragma unroll
                    for (int n = 0; n < 2; ++n) acc[a][b][m][n] = (f32x4){0.f, 0.f, 0.f, 0.f};
        cur = nxt; cA = nA; cB = nB; ++ui;
        if constexpr (ALIGN_EPI) { if (wr == 1) PG8_BAR; }
    }
    PG8_WAIT_V(0);
    if constexpr (!ALIGN_EPI) { if (wr == 0) PG8_BAR; }
    PG8_BAR;
    if constexpr (Epi::AFTER_DRAIN) { E.fused(acc, cur, wr, wc, fr, fq, lds, wid, lane); S.done(cur); }
#undef PG8_SA
#undef PG8_SB
#undef PG8_STAGE
#undef PG8_LDA
#undef PG8_LDB
#undef PG8_MMA
#undef PG8_WAIT_V
#undef PG8_WAIT_L
#undef PG8_BAR
#undef PG8_SCHED
}
}

#define GAS __attribute__((address_space(1)))
#define LAS __attribute__((address_space(3)))
typedef unsigned short bf16;
typedef unsigned v4u __attribute__((ext_vector_type(4)));
typedef float f32x4 __attribute__((ext_vector_type(4)));
typedef short bf16x8 __attribute__((ext_vector_type(8)));
typedef GAS unsigned gu32;
typedef GAS unsigned long long gu64;
#define RLX_AGENT __ATOMIC_RELAXED, __HIP_MEMORY_SCOPE_AGENT
#define LDS_WAIT() asm volatile("s_waitcnt lgkmcnt(0)" ::: "memory")
#define VM_WAIT() asm volatile("s_waitcnt vmcnt(0)" ::: "memory")
__device__ __forceinline__ unsigned long long rt() { return __builtin_amdgcn_s_memrealtime(); }
__device__ __forceinline__ unsigned f2bf(float f) { unsigned u = __builtin_bit_cast(unsigned, f); return (u + 0x7fffu + ((u >> 16) & 1u)) >> 16; }
__device__ __forceinline__ unsigned pk2(float lo, float hi) { return f2bf(lo) | (f2bf(hi) << 16); }
#define XB_TMO      128
#define XB_XCNT(j)  (256  + 64 * (j))
#define XB_XSUB(j)  (1280 + 64 * (j))
#define XB_XGEN(j)  (2304 + 64 * (j))
#define XB_TOP      3328
#define XB_TOPGEN   3392
#define XCD_BAR_WORDS 3456
#define XB_SPIN_CAP (1u << 18)

__device__ __forceinline__ unsigned xb_ld(unsigned* p)              { return __hip_atomic_load(p, __ATOMIC_RELAXED, __HIP_MEMORY_SCOPE_AGENT); }
__device__ __forceinline__ unsigned xb_add(unsigned* p, unsigned v) { return __hip_atomic_fetch_add(p, v, __ATOMIC_RELAXED, __HIP_MEMORY_SCOPE_AGENT); }
__device__ __forceinline__ unsigned xb_xcc_id() { return (unsigned)__builtin_amdgcn_s_getreg((3 << 11) | 20) & 0xFu; }
#define XB_SPIN(cond, bar) do { unsigned _sp = 0; while (cond) { __builtin_amdgcn_s_sleep(1); \
    if ((++_sp & 255u) == 0u) { if (xb_ld(&(bar)[XB_TMO])) break; if (_sp > XB_SPIN_CAP) { atomicAdd(&(bar)[XB_TMO], 1u); break; } } } } while (0)

struct XcdBarrier {
    unsigned* bar; unsigned x;
    volatile LAS unsigned* st;
};

__device__ __forceinline__ XcdBarrier xcd_barrier_post(unsigned* bar, volatile LAS unsigned* st) {
    XcdBarrier b; b.bar = bar; b.x = xb_xcc_id(); b.st = st;
    if (threadIdx.x == 0) (void)xb_add(&bar[XB_XCNT(b.x)], 1u);
    return b;
}
__device__ __forceinline__ void xcd_barrier_complete(unsigned* bar, unsigned x, unsigned& nloc, unsigned& nx) {
    const unsigned G = gridDim.x * gridDim.y * gridDim.z;
    unsigned sum, cnt, mine, sp = 0u;
    for (;;) {
        sum = 0u; cnt = 0u; mine = 0u;
#pragma unroll
        for (unsigned j = 0; j < 16; ++j) { const unsigned c = xb_ld(&bar[XB_XCNT(j)]); sum += c; cnt += (c > 0u) ? 1u : 0u; mine = (j == x) ? c : mine; }
        if (sum == G) break;
        __builtin_amdgcn_s_sleep(1);
        if ((++sp & 255u) == 0u) { if (xb_ld(&bar[XB_TMO])) break; if (sp > XB_SPIN_CAP) { atomicAdd(&bar[XB_TMO], 1u); break; } }
    }
    nloc = mine > 0u ? mine : 1u; nx = cnt > 0u ? cnt : 1u;
}

__device__ __forceinline__ void xcd_barrier(const XcdBarrier& b) {
    asm volatile("s_waitcnt vmcnt(0)" ::: "memory");
    __syncthreads();
    if (threadIdx.x == 0) {
        unsigned* bar = b.bar;
        __builtin_amdgcn_s_waitcnt(0);
        unsigned nloc = b.st[0], nx = b.st[1];
        if (nloc == 0u) { xcd_barrier_complete(bar, b.x, nloc, nx); b.st[0] = nloc; b.st[1] = nx; }
        const unsigned old = xb_add(&bar[XB_XSUB(b.x)], 1u);
        const unsigned gen = old / nloc;
        if (old + 1u == (gen + 1u) * nloc) {
            __builtin_amdgcn_fence(__ATOMIC_RELEASE, "agent");
            asm volatile("s_waitcnt vmcnt(0)" ::: "memory");
            const unsigned og = xb_add(&bar[XB_TOP], 1u);
            const unsigned tg = og / nx;
            if (og + 1u == (tg + 1u) * nx) xb_add(&bar[XB_TOPGEN], 1u);
            else XB_SPIN(xb_ld(&bar[XB_TOPGEN]) == tg, bar);
            __builtin_amdgcn_fence(__ATOMIC_ACQUIRE, "agent");
            xb_add(&bar[XB_XGEN(b.x)], 1u);
            asm volatile("s_waitcnt vmcnt(0)" ::: "memory");
        } else {
            XB_SPIN(xb_ld(&bar[XB_XGEN(b.x)]) == gen, bar);
            __builtin_amdgcn_fence(__ATOMIC_ACQUIRE, "agent");
            asm volatile("s_waitcnt vmcnt(0)" ::: "memory");
        }
    }
    __syncthreads();
}

constexpr int NWAVES = 8;
#ifndef REP_M2
#define REP_M2 1
#endif
#ifndef REP_M13
#define REP_M13 1
#endif
#ifndef REP_P0
#define REP_P0 1
#endif
#ifndef REP_P2
#define REP_P2 1
#endif
#ifndef REP_P3
#define REP_P3 1
#endif
#ifndef REP_BAR
#define REP_BAR 1
#endif
#ifndef REP_SCAN
#define REP_SCAN 1
#endif
#ifndef REP_P1
#define REP_P1 1
#endif
using pg8::RMS_EPS;
constexpr int BATCH = 8, T = 2048, D = 1024, FF = 2816, M = BATCH * T, NP = 3072;
constexpr int C_Q = 0, C_KC = 512, C_VC = 640, C_KS = 768, C_VS = 896, C_KW = 1024, C_VW = 1152, C_GQ = 1280, C_GK = 1536, C_GV = 1792, C_GR = 2304, C_GN = 2816, C_GA = 2840;
constexpr int SRC_NIN = 2856;
constexpr size_t MiB = 1u << 20;
constexpr size_t WS_CTL = 0, CTL_ZERO_BYTES = 1 * MiB;
constexpr size_t WS_W1GU = 1 * MiB, WS_W1D = 12 * MiB, WS_WIN = 18 * MiB, WS_WOUT = 24 * MiB, WS_W2GU = 26 * MiB, WS_W2D = 37 * MiB;
constexpr size_t WS_WC1K = 43 * MiB, WS_WC1V = 43 * MiB + 512 * 1024;
constexpr size_t WS_WC2K = 44 * MiB, WS_WC2V = 44 * MiB + 16384, WS_CBIAS = 44 * MiB + 32768  , WS_KC = 44 * MiB + 65536, WS_VTC = 44 * MiB + 65536 + 262144;
constexpr size_t WS_SSQ0 = 45 * MiB, WS_SSQA = 46 * MiB, WS_SSQB = 47 * MiB, WS_DEC = 48 * MiB;
constexpr size_t WS_XB = 50 * MiB, WS_KVT = WS_XB;
constexpr size_t WS_R = 82 * MiB;
constexpr size_t WS_MIX = 178 * MiB, WS_VTS = 210 * MiB, WS_VTW = 214 * MiB, WS_ST = 218 * MiB, WS_END = 234 * MiB;
constexpr int CW_BAR = 4096;
constexpr int RING_OFF = 0, RING_BYTES = 131072, LDSCTL_OFF = RING_BYTES, MISC_OFF = LDSCTL_OFF + 320, LDS_BYTES = 147456;

typedef unsigned u32x2 __attribute__((ext_vector_type(2)));
typedef float f32x2_t __attribute__((ext_vector_type(2))); typedef __bf16 bf16x2_t __attribute__((ext_vector_type(2)));
__device__ __forceinline__ unsigned cvtpk(float lo, float hi) { f32x2_t v = {lo, hi}; bf16x2_t b = __builtin_convertvector(v, bf16x2_t); return __builtin_bit_cast(unsigned, b); }
__device__ __forceinline__ bf16 f2b(float x) { return (bf16)(cvtpk(x, 0.f) & 0xffffu); }
__device__ __forceinline__ float bf2f(bf16 h) { return __builtin_bit_cast(float, (unsigned)h << 16); }
__device__ __forceinline__ float blo(unsigned w) { return __builtin_bit_cast(float, w << 16); }
__device__ __forceinline__ float bhi(unsigned w) { return __builtin_bit_cast(float, w & 0xffff0000u); }
__device__ __forceinline__ float fexp(float x) { return __builtin_amdgcn_exp2f(x * 1.4426950408889634f); }
__device__ __forceinline__ bf16x8 pack8(f32x4 a, f32x4 b) { v4u w; w.x = cvtpk(a[0], a[1]); w.y = cvtpk(a[2], a[3]); w.z = cvtpk(b[0], b[1]); w.w = cvtpk(b[2], b[3]); return __builtin_bit_cast(bf16x8, w); }
__device__ __forceinline__ bf16x8 ld2x8(const bf16* p0, const bf16* p1) { const u32x2 a = *(const u32x2*)p0, b = *(const u32x2*)p1; v4u w; w.x = a.x; w.y = a.y; w.z = b.x; w.w = b.y; return __builtin_bit_cast(bf16x8, w); }
__device__ __forceinline__ bf16x8 ldb16(const void* ub, unsigned boff) { return *(const bf16x8*)((const char*)ub + boff); }
__device__ __forceinline__ bf16x8 ldb8x2(const void* ub, unsigned boff) { const u32x2 a = *(const u32x2*)((const char*)ub + boff), b = *(const u32x2*)((const char*)ub + boff + 32); v4u w; w.x = a.x; w.y = a.y; w.z = b.x; w.w = b.y; return __builtin_bit_cast(bf16x8, w); }
__device__ __forceinline__ float ldb_bf(const void* ub, unsigned boff) { return bf2f(*(const bf16*)((const char*)ub + boff)); }
#define OPAQUE(x) asm volatile("" : "+v"(x))
#define MFMA16(a, b, c) __builtin_amdgcn_mfma_f32_16x16x32_bf16((a), (b), (c), 0, 0, 0)
#define WAVE_LDS_FENCE() asm volatile("s_waitcnt lgkmcnt(0)" ::: "memory")

struct Frame {
    LAS unsigned char* lds;
    volatile LAS unsigned* MISC;
    gu32* ctl;
    int tid, lane, wave, vcu, G;
    const float* in[22];
    float* out;
    bf16 *W1GU, *W1D, *WIN, *WOUT, *W2GU, *W2D, *WC1K, *WC1V, *WC2K, *WC2V, *KC, *VTC, *XB, *H, *PROJ, *MIX, *VTS, *VTW, *ST;
    float *CBIAS, *SSQ0, *SSQA, *SSQB, *DEC, *KVT;
};

__device__ __forceinline__ float wave_sum(float v) {
#pragma unroll
    for (int o = 1; o < 64; o <<= 1) v += __shfl_xor(v, o);
    return v;
}

__device__ __forceinline__ int win_src_col(int n) { return n < 1280 ? n : (n < 2816 ? n + 24 : (n < 2840 ? n - 1536 : (n < 2856 ? n : -1))); }
__device__ __forceinline__ void p0_tr_item(const float* W, const float* W2, const float* gain, int K, int Nsrc, int mode, bf16* WT, LAS float* scr, int kb, int nb, int lane) {
    const int k0 = 64 * kb, n0 = 32 * nb, nd = n0 + (lane & 31);
    const float* src = W; int sc = nd;
    if (mode == 1) { const int tile = nd >> 8, c = nd & 255; if (c >= 128) { src = W2; sc = tile * 128 + c - 128; } else sc = tile * 128 + c; }
    else if (mode == 2) sc = win_src_col(nd);
#pragma unroll 8
    for (int i = 0; i < 32; ++i) { const int kk = 2 * i + (lane >> 5); float v = 0.f; if (sc >= 0) v = src[(size_t)(k0 + kk) * Nsrc + sc]; if (gain) v *= gain[k0 + kk]; scr[kk * 33 + (lane & 31)] = v; }
    LDS_WAIT(); asm volatile("" ::: "memory");
    const int c = lane & 7;
#pragma unroll
    for (int j = 0; j < 4; ++j) { const int n = (lane >> 3) + 8 * j; const LAS float* s = scr + (8 * c) * 33 + n;
        v4u o; o.x = pk2(s[0 * 33], s[1 * 33]); o.y = pk2(s[2 * 33], s[3 * 33]); o.z = pk2(s[4 * 33], s[5 * 33]); o.w = pk2(s[6 * 33], s[7 * 33]);
        *(GAS v4u*)(WT + (size_t)(n0 + n) * K + k0 + 8 * c) = o; }
    LDS_WAIT(); asm volatile("" ::: "memory");
}
__device__ __forceinline__ void p0_prologue(Frame& F) {
    LAS float* scr = (LAS float*)(F.lds + RING_OFF + F.wave * 16384);
    const int gw = F.vcu * NWAVES + F.wave, NGW = F.G * NWAVES;
    constexpr int I_GU = 16 * 176, I_DN = 44 * 32, I_IN = 16 * 96, I_OUT = 16 * 32, I_C1 = 32 * 4, I_C2 = 2 * 2;
    constexpr int NITEMS = 2 * I_GU + 2 * I_DN + I_IN + I_OUT + 2 * I_C1 + 2 * I_C2;
    for (int it = gw; it < NITEMS; it += NGW) {
        int r = it;
        if (r < I_GU) { p0_tr_item(F.in[2], F.in[3], F.in[1], 1024, FF, 1, F.W1GU, scr, r / 176, r % 176, F.lane); continue; } r -= I_GU;
        if (r < I_GU) { p0_tr_item(F.in[18], F.in[19], F.in[17], 1024, FF, 1, F.W2GU, scr, r / 176, r % 176, F.lane); continue; } r -= I_GU;
        if (r < I_DN) { p0_tr_item(F.in[4], nullptr, nullptr, FF, 1024, 0, F.W1D, scr, r / 32, r % 32, F.lane); continue; } r -= I_DN;
        if (r < I_DN) { p0_tr_item(F.in[20], nullptr, nullptr, FF, 1024, 0, F.W2D, scr, r / 32, r % 32, F.lane); continue; } r -= I_DN;
        if (r < I_IN) { p0_tr_item(F.in[6], nullptr, F.in[5], 1024, SRC_NIN, 2, F.WIN, scr, r / 96, r % 96, F.lane); continue; } r -= I_IN;
        if (r < I_OUT) { p0_tr_item(F.in[16], nullptr, nullptr, 1024, 1024, 0, F.WOUT, scr, r / 32, r % 32, F.lane); continue; } r -= I_OUT;
        if (r < I_C1) { p0_tr_item(F.in[8], nullptr, nullptr, 2048, 128, 0, F.WC1K, scr, r / 4, r % 4, F.lane); continue; } r -= I_C1;
        if (r < I_C1) { p0_tr_item(F.in[11], nullptr, nullptr, 2048, 128, 0, F.WC1V, scr, r / 4, r % 4, F.lane); continue; } r -= I_C1;
        if (r < I_C2) { p0_tr_item(F.in[9], nullptr, nullptr, 128, 64, 0, F.WC2K, scr, r / 2, r % 2, F.lane); continue; } r -= I_C2;
        p0_tr_item(F.in[12], nullptr, nullptr, 128, 64, 0, F.WC2V, scr, r / 2, r % 2, F.lane);
    }
    for (int m = gw; m < M; m += NGW) {
        const GAS f32x4* xr = (const GAS f32x4*)(F.in[0] + (size_t)m * D) + F.lane;
        f32x4 v[4]; float s = 0.f;
#pragma unroll
        for (int j = 0; j < 4; ++j) { v[j] = xr[64 * j]; s += (v[j].x * v[j].x + v[j].y * v[j].y) + (v[j].z * v[j].z + v[j].w * v[j].w); }
        s = wave_sum(s);
        if (F.lane == 0) F.SSQ0[m] = s;
        GAS unsigned long long* o8 = (GAS unsigned long long*)(F.XB + (size_t)m * D) + F.lane;
#pragma unroll
        for (int j = 0; j < 4; ++j) o8[64 * j] = (unsigned long long)cvtpk(v[j].x, v[j].y) | ((unsigned long long)cvtpk(v[j].z, v[j].w) << 32);
    }
    for (int it = gw; it < 64; it += NGW) {
        const int kv = it >> 5, ch = it & 31; const float* W = (kv ? F.in[11] : F.in[8]) + (size_t)ch * 64 * 128 + F.lane; const float* pe = (kv ? F.in[10] : F.in[7]) + ch * 64;
        float s0 = 0.f, s1 = 0.f;
#pragma unroll 16
        for (int k = 0; k < 64; ++k) { const float p = pe[k]; s0 += p * W[k * 128]; s1 += p * W[k * 128 + 64]; }
        F.CBIAS[(kv * 32 + ch) * 128 + F.lane] = s0; F.CBIAS[(kv * 32 + ch) * 128 + 64 + F.lane] = s1;
    }
}

__device__ __forceinline__ void m1_compress(Frame& F, int ci) {
    const int kv = ci >> 7, b = (ci >> 4) & 7, g = (ci >> 3) & 1, rg = ci & 7;
    const int lane = F.lane, q = lane & 15, gl = lane >> 4, w = F.wave;
    LAS float* red = (LAS float*)(F.lds + RING_OFF);
    LAS bf16* hidb = (LAS bf16*)(F.lds + RING_OFF + 65536);
    const bf16* W1 = kv ? F.WC1V : F.WC1K; const bf16* W2 = kv ? F.WC2V : F.WC2K;
    const int ccol = (kv ? C_VC : C_KC) + g * 64;
    f32x4 acc[8];
#pragma unroll
    for (int nt = 0; nt < 8; ++nt) acc[nt] = (f32x4){0.f, 0.f, 0.f, 0.f};
#pragma unroll
    for (int ks = 0; ks < 8; ++ks) {
        const int l = 4 * w + (ks >> 1), dbase = 32 * (ks & 1) + 8 * gl;
        int tok = 16 * (16 * rg + q) + l; tok = tok > T - 1 ? T - 1 : tok;
        const bf16x8 a = *(const bf16x8*)(F.PROJ + ((size_t)b * T + tok) * NP + ccol + dbase);
        const int kg = 64 * l + dbase;
#pragma unroll
        for (int nt = 0; nt < 8; ++nt) { const bf16x8 bw = *(const bf16x8*)(W1 + (size_t)(16 * nt + q) * 2048 + kg); acc[nt] = MFMA16(a, bw, acc[nt]); }
    }
#pragma unroll
    for (int nt = 0; nt < 8; ++nt)
#pragma unroll
        for (int reg = 0; reg < 4; ++reg) red[(w * 16 + 4 * gl + reg) * 128 + 16 * nt + q] = acc[nt][reg];
    __syncthreads();
    {
        const int idx = F.tid * 4, r = idx >> 7, n = idx & 127;
        f32x4 s = (f32x4){0.f, 0.f, 0.f, 0.f};
#pragma unroll 8
        for (int ch = 0; ch < 32; ++ch) s += *(const f32x4*)(F.CBIAS + (kv * 32 + ch) * 128 + n);
#pragma unroll
        for (int ww = 0; ww < 8; ++ww) s += *(const LAS f32x4*)(red + (ww * 16 + r) * 128 + n);
        float o[4];
#pragma unroll
        for (int i = 0; i < 4; ++i) { const float x = s[i]; const float u2 = 2.0f * 0.7978845608028654f * (x + 0.044715f * x * x * x);
            const float th = 1.0f - 2.0f * __builtin_amdgcn_rcpf(fexp(u2) + 1.0f); o[i] = 0.5f * x * (1.0f + th); }
        u32x2 pw; pw.x = cvtpk(o[0], o[1]); pw.y = cvtpk(o[2], o[3]);
        *(LAS u32x2*)(hidb + r * 136 + n) = pw;
    }
    __syncthreads();
    if (w < 4) {
        f32x4 a2 = (f32x4){0.f, 0.f, 0.f, 0.f};
#pragma unroll
        for (int ks = 0; ks < 4; ++ks) { const bf16x8 a = *(const LAS bf16x8*)(hidb + q * 136 + 32 * ks + 8 * gl);
            const bf16x8 bw = *(const bf16x8*)(W2 + (size_t)(16 * w + q) * 128 + 32 * ks + 8 * gl); a2 = MFMA16(a, bw, a2); }
        const int d = 16 * w + q;
#pragma unroll
        for (int reg = 0; reg < 4; ++reg) { const int i = 16 * rg + 4 * gl + reg; const bf16 val = (i <= 126) ? f2b(a2[reg]) : (bf16)0;
            if (kv == 0) F.KC[((size_t)(b * 2 + g) * 128 + i) * 64 + d] = val; else F.VTC[((size_t)(b * 2 + g) * 64 + d) * 128 + i] = val; }
    }
    __syncthreads();
}

__device__ __forceinline__ void gla_prep(Frame& F, int b, int h, int n, LAS float* bm, LAS float* seg) {
    const int tid = F.tid, d = tid & 63, sg = tid >> 6;
    const float* wa = F.in[13] + h * 64 + d;
    float w[16];
#pragma unroll
    for (int r = 0; r < 16; ++r) w[r] = wa[r * 256];
    const float ba = F.in[14][h * 64 + d];
    float c[8]; float run = 0.f;
#pragma unroll
    for (int i = 0; i < 8; ++i) {
        const size_t row = (size_t)b * T + 64 * n + 8 * sg + i;
        const bf16* gp = F.PROJ + row * NP + C_GA;
        const v4u g0 = *(const v4u*)gp, g1 = *(const v4u*)(gp + 8);
        float z = ba;
        z += blo(g0.x) * w[0] + bhi(g0.x) * w[1] + blo(g0.y) * w[2] + bhi(g0.y) * w[3] + blo(g0.z) * w[4] + bhi(g0.z) * w[5] + blo(g0.w) * w[6] + bhi(g0.w) * w[7];
        z += blo(g1.x) * w[8] + bhi(g1.x) * w[9] + blo(g1.y) * w[10] + bhi(g1.y) * w[11] + blo(g1.z) * w[12] + bhi(g1.z) * w[13] + blo(g1.w) * w[14] + bhi(g1.w) * w[15];
        const float ls = fminf(z, 0.f) - __logf(1.0f + __expf(-fabsf(z)));
        run += ls * (1.0f / 16.0f); c[i] = run;
    }
    seg[sg * 64 + d] = run; __syncthreads();
    float pre = 0.f;
#pragma unroll
    for (int s2 = 0; s2 < 7; ++s2) pre += (s2 < sg) ? seg[s2 * 64 + d] : 0.f;
#pragma unroll
    for (int i = 0; i < 8; ++i) bm[(8 * sg + i) * 65 + d] = pre + c[i];
    __syncthreads();
}
__device__ __forceinline__ void gla_load_vt(Frame& F, size_t row, int h, int j, int c8, LAS bf16* VTl) {
    const bf16* vp = F.PROJ + row * NP + C_GV + h * 128 + 16 * c8;
    const v4u v0 = *(const v4u*)vp, v1 = *(const v4u*)(vp + 8);
    LAS bf16* dst = VTl + (16 * c8) * 72 + j;
    dst[0 * 72] = (bf16)(v0.x & 0xffffu); dst[1 * 72] = (bf16)(v0.x >> 16); dst[2 * 72] = (bf16)(v0.y & 0xffffu); dst[3 * 72] = (bf16)(v0.y >> 16);
    dst[4 * 72] = (bf16)(v0.z & 0xffffu); dst[5 * 72] = (bf16)(v0.z >> 16); dst[6 * 72] = (bf16)(v0.w & 0xffffu); dst[7 * 72] = (bf16)(v0.w >> 16);
    dst[8 * 72] = (bf16)(v1.x & 0xffffu); dst[9 * 72] = (bf16)(v1.x >> 16); dst[10 * 72] = (bf16)(v1.y & 0xffffu); dst[11 * 72] = (bf16)(v1.y >> 16);
    dst[12 * 72] = (bf16)(v1.z & 0xffffu); dst[13 * 72] = (bf16)(v1.z >> 16); dst[14 * 72] = (bf16)(v1.w & 0xffffu); dst[15 * 72] = (bf16)(v1.w >> 16);
}
__device__ __forceinline__ void m1_gla_kv(Frame& F, int item) {
    const int n = item & 31, h = (item >> 5) & 3, b = item >> 7;
    const int lane = F.lane, q = lane & 15, gl = lane >> 4, w = F.wave, tid = F.tid;
    LAS float* bm = (LAS float*)(F.lds + RING_OFF); LAS float* seg = (LAS float*)(F.lds + RING_OFF + 16640);
    LAS bf16* KstT = (LAS bf16*)(F.lds + RING_OFF + 18688); LAS bf16* VTl = (LAS bf16*)(F.lds + RING_OFF + 27904);
    gla_prep(F, b, h, n, bm, seg);
    const int j = tid >> 3, c8 = tid & 7; const size_t row = (size_t)b * T + 64 * n + j;
    {
        const v4u kk = *(const v4u*)(F.PROJ + row * NP + C_GK + h * 64 + 8 * c8);
        float kf[8] = {blo(kk.x), bhi(kk.x), blo(kk.y), bhi(kk.y), blo(kk.z), bhi(kk.z), blo(kk.w), bhi(kk.w)};
#pragma unroll
        for (int i = 0; i < 8; ++i) { const int d = 8 * c8 + i; const float e = fexp(bm[63 * 65 + d] - bm[j * 65 + d]); KstT[d * 72 + j] = f2b(kf[i] * e); }
    }
    gla_load_vt(F, row, h, j, c8, VTl);
    __syncthreads();
#pragma unroll
    for (int dt = 0; dt < 4; ++dt) {
        f32x4 acc = (f32x4){0.f, 0.f, 0.f, 0.f};
#pragma unroll
        for (int ks = 0; ks < 2; ++ks) { const bf16x8 a = *(const LAS bf16x8*)(KstT + (16 * dt + q) * 72 + 32 * ks + 8 * gl);
            const bf16x8 bv = *(const LAS bf16x8*)(VTl + (16 * w + q) * 72 + 32 * ks + 8 * gl); acc = MFMA16(a, bv, acc); }
        *(f32x4*)(F.KVT + ((size_t)item * 128 + 16 * w + q) * 64 + 16 * dt + 4 * gl) = acc;
    }
    if (tid < 64) F.DEC[(size_t)item * 64 + tid] = fexp(bm[63 * 65 + tid]);
    __syncthreads();
}
__device__ __forceinline__ void m1_transpose(Frame& F, int ti) {
    const int which = ti >> 9, rem = ti & 511, b = rem >> 6, g = (rem >> 5) & 1, tt = rem & 31;
    const bf16* src = F.PROJ + ((size_t)b * T + 64 * tt + F.lane) * NP + (which ? C_VW : C_VS) + g * 64;
    v4u x[8];
#pragma unroll
    for (int i = 0; i < 8; ++i) x[i] = *(const v4u*)(src + 8 * i);
    bf16* dst = (which ? F.VTW : F.VTS) + ((size_t)(b * 2 + g) * 64) * T + 64 * tt + F.lane;
#pragma unroll
    for (int d = 0; d < 64; ++d) { const unsigned wv = x[d >> 3][(d >> 1) & 3]; dst[(size_t)d * T] = (bf16)((d & 1) ? (wv >> 16) : (wv & 0xffffu)); }
}
__device__ __forceinline__ void m2_scan(Frame& F, int si) {
    const int bh = si >> 5, part = si & 31, qd = part * 64 + F.lane, v = qd >> 4, dq = qd & 15;
    f32x4 S = (f32x4){0.f, 0.f, 0.f, 0.f};
#pragma unroll 8
    for (int n = 0; n < 32; ++n) {
        const size_t item = (size_t)bh * 32 + n;
        const f32x4 kvv = *(const f32x4*)(F.KVT + (item * 128 + v) * 64 + 4 * dq);
        const f32x4 dc = *(const f32x4*)(F.DEC + item * 64 + 4 * dq);
        u32x2 wv; wv.x = cvtpk(S[0], S[1]); wv.y = cvtpk(S[2], S[3]);
        *(u32x2*)(F.ST + (item * 128 + v) * 64 + 4 * dq) = wv;
        S = S * dc + kvv;
    }
}
__device__ __forceinline__ void m3_gla_out(Frame& F, int item) {
    const int n = item & 31, h = (item >> 5) & 3, b = item >> 7;
    const int lane = F.lane, q = lane & 15, gl = lane >> 4, w = F.wave, tid = F.tid;
    LAS float* bm = (LAS float*)(F.lds + RING_OFF); LAS float* seg = (LAS float*)(F.lds + RING_OFF + 16640);
    LAS bf16* Qin = (LAS bf16*)(F.lds + RING_OFF + 18688); LAS bf16* Kin = (LAS bf16*)(F.lds + RING_OFF + 27904);
    LAS bf16* VTl = (LAS bf16*)(F.lds + RING_OFF + 37120); LAS bf16* Am = (LAS bf16*)(F.lds + RING_OFF + 55552);
    LAS float* ssqw = (LAS float*)(F.lds + RING_OFF + 64768);
    gla_prep(F, b, h, n, bm, seg);
    const int j = tid >> 3, c8 = tid & 7; const size_t row = (size_t)b * T + 64 * n + j;
    {
        const v4u qq = *(const v4u*)(F.PROJ + row * NP + C_GQ + h * 64 + 8 * c8);
        const v4u kk = *(const v4u*)(F.PROJ + row * NP + C_GK + h * 64 + 8 * c8);
        float qf[8] = {blo(qq.x), bhi(qq.x), blo(qq.y), bhi(qq.y), blo(qq.z), bhi(qq.z), blo(qq.w), bhi(qq.w)};
        float kf[8] = {blo(kk.x), bhi(kk.x), blo(kk.y), bhi(kk.y), blo(kk.z), bhi(kk.z), blo(kk.w), bhi(kk.w)};
#pragma unroll
        for (int i = 0; i < 8; ++i) { const float bb = bm[j * 65 + 8 * c8 + i]; qf[i] = qf[i] * 0.125f * fexp(bb); kf[i] = kf[i] * fexp(-bb); }
        v4u pq, pk; pq.x = cvtpk(qf[0], qf[1]); pq.y = cvtpk(qf[2], qf[3]); pq.z = cvtpk(qf[4], qf[5]); pq.w = cvtpk(qf[6], qf[7]);
        pk.x = cvtpk(kf[0], kf[1]); pk.y = cvtpk(kf[2], kf[3]); pk.z = cvtpk(kf[4], kf[5]); pk.w = cvtpk(kf[6], kf[7]);
        *(LAS v4u*)(Qin + j * 72 + 8 * c8) = pq; *(LAS v4u*)(Kin + j * 72 + 8 * c8) = pk;
    }
    gla_load_vt(F, row, h, j, c8, VTl);
    __syncthreads();
    {
        const int it = w >> 1;
#pragma unroll
        for (int jj = 0; jj < 2; ++jj) { const int jt = 2 * (w & 1) + jj; f32x4 a = (f32x4){0.f, 0.f, 0.f, 0.f};
            if (jt <= it) {
#pragma unroll
                for (int ks = 0; ks < 2; ++ks) a = MFMA16(*(const LAS bf16x8*)(Qin + (16 * it + q) * 72 + 32 * ks + 8 * gl), *(const LAS bf16x8*)(Kin + (16 * jt + q) * 72 + 32 * ks + 8 * gl), a);
            }
#pragma unroll
            for (int reg = 0; reg < 4; ++reg) { const int i = 16 * it + 4 * gl + reg, jx = 16 * jt + q; Am[i * 72 + jx] = (i >= jx) ? f2b(a[reg]) : (bf16)0; } }
    }
    __syncthreads();
    f32x4 acc[4];
#pragma unroll
    for (int it = 0; it < 4; ++it) acc[it] = (f32x4){0.f, 0.f, 0.f, 0.f};
#pragma unroll
    for (int ks = 0; ks < 2; ++ks) {
        const bf16x8 bv = *(const LAS bf16x8*)(VTl + (16 * w + q) * 72 + 32 * ks + 8 * gl);
        const bf16x8 bs = *(const bf16x8*)(F.ST + ((size_t)item * 128 + 16 * w + q) * 64 + 32 * ks + 8 * gl);
#pragma unroll
        for (int it = 0; it < 4; ++it) { acc[it] = MFMA16(*(const LAS bf16x8*)(Am + (16 * it + q) * 72 + 32 * ks + 8 * gl), bv, acc[it]);
            acc[it] = MFMA16(*(const LAS bf16x8*)(Qin + (16 * it + q) * 72 + 32 * ks + 8 * gl), bs, acc[it]); }
    }
#pragma unroll
    for (int it = 0; it < 4; ++it)
#pragma unroll
        for (int reg = 0; reg < 4; ++reg) { float s = acc[it][reg] * acc[it][reg]; s += __shfl_xor(s, 1); s += __shfl_xor(s, 2); s += __shfl_xor(s, 4); s += __shfl_xor(s, 8);
            if (q == 0) ssqw[w * 64 + 16 * it + 4 * gl + reg] = s; }
    __syncthreads();
    const float gg = F.in[15][16 * w + q];
#pragma unroll
    for (int it = 0; it < 4; ++it)
#pragma unroll
        for (int reg = 0; reg < 4; ++reg) { const int i = 16 * it + 4 * gl + reg; float tot = 0.f;
#pragma unroll
            for (int w2 = 0; w2 < 8; ++w2) tot += ssqw[w2 * 64 + i];
            const float rs = __builtin_amdgcn_rsqf(tot * (1.0f / 128.0f) + RMS_EPS);
            const size_t r2 = (size_t)b * T + 64 * n + i;
            const float gr = bf2f(F.PROJ[r2 * NP + C_GR + h * 128 + 16 * w + q]);
            const float sl = gr * __builtin_amdgcn_rcpf(1.0f + fexp(-gr));
            F.MIX[r2 * 1024 + 512 + h * 128 + 16 * w + q] = f2b(acc[it][reg] * rs * gg * sl); }
    __syncthreads();
}

constexpr float NSA_C2 = 0.125f * 1.4426950408889634f, NSA_THR = 8.0f;
constexpr int NSA_STAGE_BYTES = 16384, NSA_VOFF = 8192, NSA_NSTAGE = 4, NSA_KC_OFF = NSA_NSTAGE * NSA_STAGE_BYTES, NSA_VC_OFF = NSA_KC_OFF + 18432, NSA_UM_OFF = NSA_VC_OFF + 17408;
__device__ __forceinline__ bf16x8 scale8(bf16x8 x, float c) { const v4u w = __builtin_bit_cast(v4u, x); v4u o;
    o.x = cvtpk(blo(w.x) * c, bhi(w.x) * c); o.y = cvtpk(blo(w.y) * c, bhi(w.y) * c); o.z = cvtpk(blo(w.z) * c, bhi(w.z) * c); o.w = cvtpk(blo(w.w) * c, bhi(w.w) * c); return __builtin_bit_cast(bf16x8, o); }
__device__ __forceinline__ float dot8(bf16x8 a, bf16x8 b) { const v4u x = __builtin_bit_cast(v4u, a), y = __builtin_bit_cast(v4u, b);
    return ((blo(x.x) * blo(y.x) + bhi(x.x) * bhi(y.x)) + (blo(x.y) * blo(y.y) + bhi(x.y) * bhi(y.y))) + ((blo(x.z) * blo(y.z) + bhi(x.z) * bhi(y.z)) + (blo(x.w) * blo(y.w) + bhi(x.w) * bhi(y.w))); }
struct NsaState { f32x4 O[2][4]; float m[2], l[2]; };
__device__ __forceinline__ void nsa_init(NsaState& st, const bf16x8 (&qf)[2][2], const bf16* Kself  , unsigned voK) {
    const bf16x8 k0 = ldb16(Kself, voK), k1 = ldb16(Kself + 32, voK);
#pragma unroll
    for (int r = 0; r < 2; ++r) { float s = dot8(qf[r][0], k0) + dot8(qf[r][1], k1); s += __shfl_xor(s, 16); s += __shfl_xor(s, 32); st.m[r] = s; st.l[r] = 0.f;
#pragma unroll
        for (int dt = 0; dt < 4; ++dt) st.O[r][dt] = (f32x4){0.f, 0.f, 0.f, 0.f}; }
}
__device__ __forceinline__ void nsa_tile(NsaState& st, const bf16x8 (&qf)[2][2], const float (&slope2)[2], const LAS bf16* Ks, const LAS bf16* Vs, int key0, int t, int q, int gl, bool selbit, int wlim, bool need_mask) {
#pragma unroll 1
    for (int half = 0; half < 2; ++half) {
        bf16x8 kf[2][2], vf[4];
#pragma unroll
        for (int kt = 0; kt < 2; ++kt)
#pragma unroll
            for (int ks = 0; ks < 2; ++ks) kf[kt][ks] = *(const LAS bf16x8*)((const LAS unsigned char*)Ks + (32 * half + 16 * kt + q) * 128 + 16 * ((4 * ks + gl) ^ (q >> 1)));
#pragma unroll
        for (int dt = 0; dt < 4; ++dt) { const LAS unsigned char* vr = (const LAS unsigned char*)Vs + (16 * dt + q) * 128 + 8 * (gl & 1); const int c0 = 4 * half + (gl >> 1);
            const u32x2 a = *(const LAS u32x2*)(vr + 16 * (c0 ^ (q >> 1))), c = *(const LAS u32x2*)(vr + 16 * ((c0 + 2) ^ (q >> 1)));
            v4u wv; wv.x = a.x; wv.y = a.y; wv.z = c.x; wv.w = c.y; vf[dt] = __builtin_bit_cast(bf16x8, wv); }
        const int kbase = key0 + 32 * half + 4 * gl;
        const float kb = (float)(kbase - t);
#pragma unroll
        for (int r = 0; r < 2; ++r) {
            const float c1 = slope2[r] * kb - st.m[r];
            f32x4 s0, s1;
#pragma unroll
            for (int reg = 0; reg < 4; ++reg) { s0[reg] = slope2[r] * (float)reg + c1; s1[reg] = slope2[r] * (float)(16 + reg) + c1; }
            s0 = MFMA16(kf[0][0], qf[r][0], s0); s0 = MFMA16(kf[0][1], qf[r][1], s0);
            s1 = MFMA16(kf[1][0], qf[r][0], s1); s1 = MFMA16(kf[1][1], qf[r][1], s1);
            if (need_mask) {
#pragma unroll
                for (int reg = 0; reg < 4; ++reg) { const int d0 = t - (kbase + reg), d1 = d0 - 16;
                    const bool ok0 = selbit && d0 >= 0 && d0 < wlim, ok1 = selbit && d1 >= 0 && d1 < wlim;
                    s0[reg] = ok0 ? s0[reg] : -INFINITY; s1[reg] = ok1 ? s1[reg] : -INFINITY; }
            }
            const float lmax = fmaxf(fmaxf(fmaxf(s0[0], s0[1]), fmaxf(s0[2], s0[3])), fmaxf(fmaxf(s1[0], s1[1]), fmaxf(s1[2], s1[3])));
            if (__ballot(lmax > NSA_THR) != 0ull) {
                float rm = fmaxf(lmax, __shfl_xor(lmax, 16)); rm = fmaxf(rm, __shfl_xor(rm, 32));
                const float dl = fmaxf(rm, 0.f), f = __builtin_amdgcn_exp2f(-dl);
                st.m[r] += dl; st.l[r] *= f;
#pragma unroll
                for (int reg = 0; reg < 4; ++reg) { s0[reg] -= dl; s1[reg] -= dl; }
#pragma unroll
                for (int dt = 0; dt < 4; ++dt) st.O[r][dt] *= f;
            }
            float ps = 0.f;
#pragma unroll
            for (int reg = 0; reg < 4; ++reg) { s0[reg] = __builtin_amdgcn_exp2f(s0[reg]); s1[reg] = __builtin_amdgcn_exp2f(s1[reg]); ps += s0[reg] + s1[reg]; }
            st.l[r] += ps;
            const bf16x8 pb = pack8(s0, s1);
#pragma unroll
            for (int dt = 0; dt < 4; ++dt) st.O[r][dt] = MFMA16(vf[dt], pb, st.O[r][dt]);
        }
    }
}
__device__ __forceinline__ void nsa_flush(NsaState& st, f32x4 (&tot)[2][4], const bf16* Pg  , int c, unsigned voG) {
#pragma unroll
    for (int r = 0; r < 2; ++r) { float l = st.l[r]; l += __shfl_xor(l, 16); l += __shfl_xor(l, 32);
        const float gate = __builtin_amdgcn_rcpf(1.0f + fexp(-ldb_bf(Pg + r * 3 + c, voG)));
        const float sc = gate * __builtin_amdgcn_rcpf(l);
#pragma unroll
        for (int dt = 0; dt < 4; ++dt) tot[r][dt] += st.O[r][dt] * sc; }
}
__device__ __forceinline__ void m2_nsa_unit(Frame& F, int b, int g, int cur) {
    int tid = F.tid; OPAQUE(tid);
    const int lane = tid & 63, q = lane & 15, gl = lane >> 4, w = F.wave;
    const int tgi = w & 3, pair = w >> 2;
    const int t0 = 64 * cur + 16 * tgi, t = t0 + q;
    const bf16* Pr = F.PROJ + ((size_t)b * T + t0) * NP;
    const bf16* Pq = Pr + C_Q + 4 * g * 64; const bf16* Pg = Pr + C_GN + (4 * g + 2 * pair) * 3;
    LAS unsigned char* L = F.lds + RING_OFF;
    LAS unsigned* um = (LAS unsigned*)(L + NSA_UM_OFF);
    const unsigned voQ = (unsigned)(q * NP + 8 * gl) * 2u, voG = (unsigned)(q * NP) * 2u;
    const float tf = (float)t;
    const int jw0 = (cur - 8) < 0 ? 0 : (cur - 8), nwin = cur + 1 - jw0;
    const bf16* Ksg = F.PROJ + (size_t)b * T * NP + C_KS + g * 64; const bf16* Kwg = F.PROJ + (size_t)b * T * NP + C_KW + g * 64;
    const bf16* VTs = F.VTS + (size_t)(b * 2 + g) * 64 * T; const bf16* VTw = F.VTW + (size_t)(b * 2 + g) * 64 * T;
    const int srow = 8 * w + (lane >> 3), sc = (lane & 7) ^ ((srow >> 1) & 7);
    const unsigned gK = (unsigned)(srow * NP + 8 * sc) * 2u, gV = (unsigned)(srow * T + 8 * sc) * 2u;
    unsigned remF = (cur <= 7) ? ((2u << cur) - 1u) : 0u; int fi = 0;
#define NSA_ISSUE() do { int j_; const bf16 *kp_, *vp_; if (fi < nwin) { j_ = jw0 + fi; kp_ = Kwg; vp_ = VTw; } else { j_ = __builtin_ctz(remF); remF &= remF - 1u; kp_ = Ksg; vp_ = VTs; } \
        LAS unsigned char* sb_ = L + (fi & 3) * NSA_STAGE_BYTES + w * 1024; ++fi; \
        __builtin_amdgcn_global_load_lds((const unsigned*)((const char*)(kp_ + (size_t)j_ * 64 * NP) + gK), (LAS unsigned*)sb_, 16, 0, 0); \
        __builtin_amdgcn_global_load_lds((const unsigned*)((const char*)(vp_ + j_ * 64) + gV), (LAS unsigned*)(sb_ + NSA_VOFF), 16, 0, 0); } while (0)
#define NSA_WAITV(n) asm volatile("s_waitcnt vmcnt(" #n ")" ::: "memory")
#define NSA_BAR() do { asm volatile("s_waitcnt lgkmcnt(0)" ::: "memory"); __builtin_amdgcn_s_barrier(); asm volatile("" ::: "memory"); } while (0)
    NSA_ISSUE(); NSA_ISSUE();
    if (cur >= 1) NSA_ISSUE();
    {
        const bf16* KCg = F.KC + (size_t)(b * 2 + g) * 128 * 64; const bf16* VCg = F.VTC + (size_t)(b * 2 + g) * 64 * 128;
#pragma unroll
        for (int i = 0; i < 2; ++i) { const int c = tid + 512 * i;
            *(LAS v4u*)(L + NSA_KC_OFF + ((c >> 3) * 72 + 8 * (c & 7)) * 2) = *(const v4u*)(KCg + 8 * c);
            *(LAS v4u*)(L + NSA_VC_OFF + ((c >> 4) * 136 + 8 * (c & 15)) * 2) = *(const v4u*)(VCg + 8 * c); }
    }
    __syncthreads();
    f32x4 tot[2][4];
    unsigned mask;
    {
        const LAS bf16* KCs = (const LAS bf16*)(L + NSA_KC_OFF); const LAS bf16* VCs = (const LAS bf16*)(L + NSA_VC_OFF);
        f32x4 psum[8];
#pragma unroll
        for (int nt = 0; nt < 8; ++nt) psum[nt] = (f32x4){0.f, 0.f, 0.f, 0.f};
#pragma unroll 1
        for (int r = 0; r < 4; ++r) {
            int glo = gl; OPAQUE(glo);
            const bf16x8 q0 = scale8(ldb16(Pq + r * 64, voQ), NSA_C2), q1 = scale8(ldb16(Pq + r * 64 + 32, voQ), NSA_C2);
            const float sl2 = __builtin_amdgcn_exp2f(-(float)(4 * g + r + 1)) * 1.4426950408889634f;
            f32x4 S[8]; const f32x4 z = (f32x4){0.f, 0.f, 0.f, 0.f};
#pragma unroll
            for (int nt = 0; nt < 8; ++nt) { const LAS bf16* kp = KCs + (16 * nt + q) * 72 + 8 * gl; S[nt] = MFMA16(*(const LAS bf16x8*)kp, q0, z); S[nt] = MFMA16(*(const LAS bf16x8*)(kp + 32), q1, S[nt]); }
            float mx = -1e30f;
#pragma unroll
            for (int nt = 0; nt < 8; ++nt)
#pragma unroll
                for (int reg = 0; reg < 4; ++reg) { const int n = 16 * nt + 4 * glo + reg; const bool valid = (16 * n + 31 <= t);
                    const float s = S[nt][reg] - sl2 * (tf - (16.0f * (float)n + 15.5f)); S[nt][reg] = valid ? s : -1e30f; mx = fmaxf(mx, S[nt][reg]); }
            mx = fmaxf(mx, __shfl_xor(mx, 16)); mx = fmaxf(mx, __shfl_xor(mx, 32));
            float sum = 0.f;
#pragma unroll
            for (int nt = 0; nt < 8; ++nt)
#pragma unroll
                for (int reg = 0; reg < 4; ++reg) { const float p = (S[nt][reg] > -1e29f) ? __builtin_amdgcn_exp2f(S[nt][reg] - mx) : 0.f; S[nt][reg] = p; sum += p; }
            sum += __shfl_xor(sum, 16); sum += __shfl_xor(sum, 32);
            const float inv = sum > 0.f ? 1.0f / sum : 0.f;
#pragma unroll
            for (int nt = 0; nt < 8; ++nt) { S[nt] = S[nt] * inv; psum[nt] += S[nt]; }
            if ((r >> 1) == pair) {
                f32x4 oc[4];
#pragma unroll
                for (int dt = 0; dt < 4; ++dt) oc[dt] = (f32x4){0.f, 0.f, 0.f, 0.f};
#pragma unroll
                for (int kp = 0; kp < 4; ++kp) { const bf16x8 pb = pack8(S[2 * kp], S[2 * kp + 1]);
#pragma unroll
                    for (int dt = 0; dt < 4; ++dt) { const LAS bf16* vp = VCs + (16 * dt + q) * 136 + 32 * kp + 4 * gl; const u32x2 a = *(const LAS u32x2*)vp, c = *(const LAS u32x2*)(vp + 16);
                        v4u wv; wv.x = a.x; wv.y = a.y; wv.z = c.x; wv.w = c.y; oc[dt] = MFMA16(__builtin_bit_cast(bf16x8, wv), pb, oc[dt]); } }
                const float gate = __builtin_amdgcn_rcpf(1.0f + fexp(-ldb_bf(Pg + (r & 1) * 3, voG)));
                if (r & 1) {
#pragma unroll
                    for (int dt = 0; dt < 4; ++dt) tot[1][dt] = oc[dt] * gate;
                } else {
#pragma unroll
                    for (int dt = 0; dt < 4; ++dt) tot[0][dt] = oc[dt] * gate;
                }
            }
        }
        if (cur <= 7) mask = (2u << cur) - 1u;
        else {
            float v[8]; float shp = 0.f;
#pragma unroll
            for (int nt = 0; nt < 8; ++nt) { const float sh = __shfl(psum[nt][3], (lane + 48) & 63);
                const float pterm = (gl > 0) ? sh : shp; shp = sh;
                v[nt] = pterm + ((psum[nt][0] + psum[nt][1]) + (psum[nt][2] + psum[nt][3])); }
            mask = 1u | (1u << cur) | (1u << (cur - 1));
            unsigned taken = 0u;
#pragma unroll
            for (int round = 0; round < 5; ++round) {
                float bv = -1.f; int bi = 99;
#pragma unroll
                for (int i = 0; i < 8; ++i) { const int s = 4 * i + gl; const bool ok = (s >= 1) && (s <= cur - 2) && (((taken >> i) & 1u) == 0u); if (ok && v[i] > bv) { bv = v[i]; bi = s; } }
#pragma unroll
                for (int off = 16; off <= 32; off <<= 1) { const float ov = __shfl_xor(bv, off); const int oi = __shfl_xor(bi, off); if (ov > bv || (ov == bv && oi < bi)) { bv = ov; bi = oi; } }
                if (bi < 32) { mask |= 1u << bi; if ((bi & 3) == gl) taken |= 1u << (bi >> 2); }
            }
        }
    }
    unsigned wm = 0u;
#pragma unroll
    for (int j = 0; j < 32; ++j) wm |= (__ballot((mask >> j) & 1u) != 0ull) ? (1u << j) : 0u;
    if (lane == 0) um[w] = wm;
    __syncthreads();
    unsigned U = 0u;
#pragma unroll
    for (int i = 0; i < 8; ++i) U |= um[i];
    U = __builtin_amdgcn_readfirstlane(U);
    if (cur > 7) remF = U;
    const int nsel = __builtin_popcount(U), NT = nwin + nsel;
    bf16x8 qf[2][2]; float slope2[2];
#pragma unroll
    for (int r = 0; r < 2; ++r) { slope2[r] = __builtin_amdgcn_exp2f(-(float)(4 * g + 2 * pair + r + 1)) * 1.4426950408889634f;
#pragma unroll
        for (int ks = 0; ks < 2; ++ks) qf[r][ks] = scale8(ldb16(Pq + (2 * pair + r) * 64 + 32 * ks, voQ), NSA_C2); }
    NsaState st;
    const unsigned voK = (unsigned)(q * NP + 8 * gl) * 2u;
    nsa_init(st, qf, Pr + C_KW + g * 64, voK);
    unsigned remC = U;
    NSA_WAITV(0); NSA_BAR();
    for (int i = 0; i < NT; ++i) {
        if (i + 3 < NT) NSA_ISSUE();
        const LAS bf16* Ks = (const LAS bf16*)(L + (i & 3) * NSA_STAGE_BYTES); const LAS bf16* Vs = Ks + NSA_VOFF / 2;
        int key0, wlim; bool selbit, need_mask, run;
        if (i < nwin) {
            const int j = jw0 + i; key0 = 64 * j; wlim = 512; selbit = true;
            run = (key0 + 63 >= t0 - 511) && (key0 <= t0 + 15); need_mask = !(key0 >= t0 + 15 - 511 && key0 + 63 <= t0);
        } else {
            if (i == nwin) { nsa_flush(st, tot, Pg, 2, voG); nsa_init(st, qf, Pr + C_KS + g * 64, voK); }
            const int j = __builtin_ctz(remC); remC &= remC - 1u;
            selbit = ((mask >> j) & 1u) != 0u; const unsigned long long bal = __ballot(selbit);
            key0 = 64 * j; wlim = 0x7fffffff; run = (bal != 0ull); need_mask = (bal != ~0ull) || (j == cur);
        }
        if (run) nsa_tile(st, qf, slope2, Ks, Vs, key0, t, q, gl, selbit, wlim, need_mask);
        if (i + 3 < NT) NSA_WAITV(4); else if (i + 2 < NT) NSA_WAITV(2); else NSA_WAITV(0);
        NSA_BAR();
    }
    nsa_flush(st, tot, Pg, 1, voG);
    bf16* Mo = F.MIX + ((size_t)b * T + t0) * 1024 + (4 * g + 2 * pair) * 64; const unsigned voM = (unsigned)(q * 1024 + 4 * gl) * 2u;
#pragma unroll
    for (int r = 0; r < 2; ++r)
#pragma unroll
        for (int dt = 0; dt < 4; ++dt) { const f32x4 o = tot[r][dt]; u32x2 wv; wv.x = cvtpk(o[0], o[1]); wv.y = cvtpk(o[2], o[3]); *(u32x2*)((char*)(Mo + r * 64 + 16 * dt) + voM) = wv; }
#undef NSA_ISSUE
#undef NSA_WAITV
#undef NSA_BAR
}

__device__ __forceinline__ void p8_final_norm(Frame& F) {
    const int gw = F.vcu * NWAVES + F.wave, NGW = F.G * NWAVES;
    const GAS f32x4* gp = (const GAS f32x4*)F.in[21] + F.lane;
    f32x4 gv[4];
#pragma unroll
    for (int j = 0; j < 4; ++j) gv[j] = gp[64 * j];
    for (int m = gw; m < M; m += NGW) {
        GAS f32x4* xr = (GAS f32x4*)(F.out + (size_t)m * D) + F.lane;
        f32x4 v[4]; float s = 0.f;
#pragma unroll
        for (int j = 0; j < 4; ++j) { v[j] = xr[64 * j]; s += (v[j].x * v[j].x + v[j].y * v[j].y) + (v[j].z * v[j].z + v[j].w * v[j].w); }
        const float rs = __builtin_amdgcn_rsqf(wave_sum(s) * (1.0f / 1024.0f) + RMS_EPS);
#pragma unroll
        for (int j = 0; j < 4; ++j) xr[64 * j] = v[j] * rs * gv[j];
    }
}

struct Args { const float* in[22]; float* out; unsigned char* ws; };
__global__ void __launch_bounds__(NWAVES * 64, 2) hybrid_fwd(Args args) {
    extern __shared__ __attribute__((aligned(16))) unsigned char lds[];
    Frame F;
    F.lds = (LAS unsigned char*)lds;
    F.MISC = (volatile LAS unsigned*)(F.lds + MISC_OFF);
    F.tid = threadIdx.x; F.lane = F.tid & 63; F.wave = __builtin_amdgcn_readfirstlane(F.tid >> 6);
    F.G = gridDim.x; { const int bx = blockIdx.x; F.vcu = (F.G % 8 == 0) ? (bx % 8) * (F.G / 8) + bx / 8 : bx; }
    unsigned char* ws = args.ws;
    F.ctl = (gu32*)(ws + WS_CTL);
#pragma unroll
    for (int i = 0; i < 22; ++i) F.in[i] = args.in[i];
    F.out = args.out;
    F.W1GU = (bf16*)(ws + WS_W1GU); F.W1D = (bf16*)(ws + WS_W1D); F.WIN = (bf16*)(ws + WS_WIN); F.WOUT = (bf16*)(ws + WS_WOUT); F.W2GU = (bf16*)(ws + WS_W2GU); F.W2D = (bf16*)(ws + WS_W2D);
    F.WC1K = (bf16*)(ws + WS_WC1K); F.WC1V = (bf16*)(ws + WS_WC1V); F.WC2K = (bf16*)(ws + WS_WC2K); F.WC2V = (bf16*)(ws + WS_WC2V);
    F.KC = (bf16*)(ws + WS_KC); F.VTC = (bf16*)(ws + WS_VTC); F.XB = (bf16*)(ws + WS_XB); F.H = (bf16*)(ws + WS_R); F.PROJ = (bf16*)(ws + WS_R);
    F.MIX = (bf16*)(ws + WS_MIX); F.VTS = (bf16*)(ws + WS_VTS); F.VTW = (bf16*)(ws + WS_VTW); F.ST = (bf16*)(ws + WS_ST);
    F.CBIAS = (float*)(ws + WS_CBIAS); F.SSQ0 = (float*)(ws + WS_SSQ0); F.SSQA = (float*)(ws + WS_SSQA); F.SSQB = (float*)(ws + WS_SSQB); F.DEC = (float*)(ws + WS_DEC); F.KVT = (float*)(ws + WS_KVT);
    for (int u = F.tid; u < (LDS_BYTES - LDSCTL_OFF) / 4; u += NWAVES * 64) ((LAS unsigned*)(F.lds + LDSCTL_OFF))[u] = 0u;
    __syncthreads();
    XcdBarrier bar = xcd_barrier_post((unsigned*)(F.ctl + CW_BAR), F.MISC + 8);
#define GRID_BAR() do { for (int rb_ = 0; rb_ < REP_BAR; ++rb_) xcd_barrier(bar); asm volatile("" : "+v"(F.tid)); F.lane = F.tid & 63; } while (0)
    const int gw = F.vcu * NWAVES + F.wave, NGW = F.G * NWAVES;

#ifndef NO_P0
    for (int rep = 0; rep < REP_P0; ++rep) p0_prologue(F);
#endif
    GRID_BAR();
#ifndef NO_GEMM
    { pg8::Gemm g{F.XB, F.W1GU, M, 2 * FF, D}; pg8::StaticOrder S; S.init(M, 2 * FF, F.G, (int)blockIdx.x);
      pg8::EpiSwiGLU<1> E{F.H, FF, F.SSQ0};
      for (int rep = 0; rep < REP_P1; ++rep) pg8::gemm_phase<pg8::EpiSwiGLU<1>, pg8::StaticOrder, true, true>(F.lds + RING_OFF, g, S, E); }
#endif
    GRID_BAR();
#ifndef NO_GEMM
    { pg8::Gemm g{F.H, F.W1D, M, D, FF}; pg8::StaticOrder S; S.init(M, D, F.G, (int)blockIdx.x);
      pg8::EpiResid<true> E{F.in[0], F.out, F.XB, F.SSQA, 0.5f};
      for (int rep = 0; rep < REP_P2; ++rep) pg8::gemm_phase<pg8::EpiResid<true>, pg8::StaticOrder, true, true>(F.lds + RING_OFF, g, S, E); }
#endif
    GRID_BAR();
#ifndef NO_GEMM
    { pg8::Gemm g{F.XB, F.WIN, M, NP, D}; pg8::StaticOrder S; S.init(M, NP, F.G, (int)blockIdx.x);
      pg8::EpiProj<16> E{F.PROJ, NP, F.SSQA};
      for (int rep = 0; rep < REP_P3; ++rep) pg8::gemm_phase<pg8::EpiProj<16>, pg8::StaticOrder, true, true>(F.lds + RING_OFF, g, S, E); }
#endif
    GRID_BAR();
#ifndef NO_M1
    for (int rep = 0; rep < REP_M13; ++rep) {
    for (int ci = F.vcu; ci < 256; ci += F.G) m1_compress(F, ci);
    for (int it = F.vcu; it < 1024; it += F.G) m1_gla_kv(F, it);
    for (int ti = gw; ti < 1024; ti += NGW) m1_transpose(F, ti);
    }
#endif
    GRID_BAR();
#ifndef NO_NSA
    for (int rep = 0; rep < REP_M2; ++rep)
    for (int wi = F.vcu; wi < 256; wi += F.G) { const int b = wi >> 5, g = (wi >> 4) & 1, x = wi & 15;
#pragma unroll 1
        for (int u = 0; u < 2; ++u) m2_nsa_unit(F, b, g, u ? x : 31 - x); }
#endif
#ifndef NO_SCAN
    for (int rep = 0; rep < REP_SCAN; ++rep)
    for (int k = gw; k < 2048; k += NGW) { const int wi = k >> 3; if ((wi & 15) < 8) m2_scan(F, (((wi >> 4) * 8 + (wi & 15)) * 8) + (k & 7)); }
#endif
    GRID_BAR();
#ifndef NO_GLA3
    for (int rep = 0; rep < REP_M13; ++rep)
    for (int it = F.vcu; it < 1024; it += F.G) m3_gla_out(F, it);
#endif
    GRID_BAR();
#ifndef NO_GEMM
    { pg8::Gemm g{F.MIX, F.WOUT, M, D, D}; pg8::StaticOrder S; S.init(M, D, F.G, (int)blockIdx.x);
      pg8::EpiResid<true> E{F.out, F.out, F.XB, F.SSQB, 1.0f};
      pg8::gemm_phase<pg8::EpiResid<true>, pg8::StaticOrder, true, true>(F.lds + RING_OFF, g, S, E); }
#endif
    GRID_BAR();
#ifndef NO_GEMM
    { pg8::Gemm g{F.XB, F.W2GU, M, 2 * FF, D}; pg8::StaticOrder S; S.init(M, 2 * FF, F.G, (int)blockIdx.x);
      pg8::EpiSwiGLU<16> E{F.H, FF, F.SSQB};
      pg8::gemm_phase<pg8::EpiSwiGLU<16>, pg8::StaticOrder, true, true>(F.lds + RING_OFF, g, S, E); }
#endif
    GRID_BAR();
#ifndef NO_GEMM
    { pg8::Gemm g{F.H, F.W2D, M, D, FF}; pg8::StaticOrder S; S.init(M, D, F.G, (int)blockIdx.x);
      pg8::EpiResid<false> E{F.out, F.out, nullptr, nullptr, 0.5f};
      pg8::gemm_phase<pg8::EpiResid<false>, pg8::StaticOrder, true, true>(F.lds + RING_OFF, g, S, E); }
#endif
    GRID_BAR();
#ifndef NO_P8
    p8_final_norm(F);
#endif
}

extern "C" void kernel_launch(void* const* d_in, const int* in_sizes, int n_in, void* d_out, int out_size, void* d_ws, size_t ws_size, hipStream_t stream) {
    static int grid = 0;
    if (grid == 0) {
        if (n_in != 22 || in_sizes[0] != M * D || out_size != M * D || ws_size < WS_END) { fprintf(stderr, "kernel_launch: unexpected shapes (n_in %d, in0 %d, out %d, ws %zu); nothing launched\n", n_in, n_in > 0 ? in_sizes[0] : -1, out_size, ws_size); grid = -1; return; }
        int dev = 0, cus = 0;
        if (hipGetDevice(&dev) != hipSuccess || hipDeviceGetAttribute(&cus, hipDeviceAttributeMultiprocessorCount, dev) != hipSuccess) { fprintf(stderr, "kernel_launch: device query failed\n"); grid = -1; return; }
        if (hipFuncSetAttribute((const void*)hybrid_fwd, hipFuncAttributeMaxDynamicSharedMemorySize, LDS_BYTES) != hipSuccess) { fprintf(stderr, "kernel_launch: hipFuncSetAttribute failed\n"); grid = -1; return; }
        (void)hipGetLastError();
        grid = cus;
    }
    if (grid < 0) return;
    if (hipMemsetAsync((char*)d_ws + WS_CTL, 0, CTL_ZERO_BYTES, stream) != hipSuccess) { fprintf(stderr, "kernel_launch: hipMemsetAsync failed\n"); return; }
    Args a{};
    for (int i = 0; i < 22; ++i) a.in[i] = (const float*)d_in[i];
    a.out = (float*)d_out; a.ws = (unsigned char*)d_ws;
    hipLaunchKernelGGL(hybrid_fwd, dim3(grid), dim3(NWAVES * 64), LDS_BYTES, stream, a);
}
```

```cpp
#include <hip/hip_runtime.h>
#include <cstdio>
#include <cstdint>
namespace pg8 {
#define PG8_LAS __attribute__((address_space(3)))
typedef unsigned short bf16_t;
typedef short bf16x8 __attribute__((ext_vector_type(8)));
typedef float f32x4 __attribute__((ext_vector_type(4)));
typedef unsigned u32x4 __attribute__((ext_vector_type(4)));
constexpr int BM = 256, BK = 64, HALF = 128, HTB = HALF * BK * 2  , STAGE_BYTES = 8 * HTB, NXCD = 8, WGM = 8;

__host__ __device__ __forceinline__ int lds_byte(int r, int c) { const int st = (r >> 4) * 2 + (c >> 5), rr = r & 15, cc = c & 31, ob = rr * 64 + cc * 2; return st * 1024 + (ob ^ (((ob >> 9) & 1) << 5)); }
__host__ __device__ __forceinline__ void stage_rc(int b, int& R, int& C) { const int st = b / 1024, sb = b % 1024, swz = sb ^ (((sb >> 9) & 1) << 5); R = (st >> 1) * 16 + swz / 64; C = (st & 1) * 32 + (swz % 64) / 2; }
__host__ __device__ __forceinline__ int perm32(int rho) { const int n = rho >> 4, i = rho & 15; return 8 * (i >> 2) + 4 * n + (i & 3); }

struct Unit { int pm, pn; };
struct Gemm { const bf16_t* A; const bf16_t* Bt; int M, N, K; };

struct StaticOrder {
    int nM, nN, nwg, G, c;
    __host__ __device__ void init(int M, int N, int G_, int c_) { nM = M / BM; nN = N / BM; nwg = nM * nN; G = G_; c = c_; }
    __host__ __device__ bool next(int i, Unit& u) const {
        const long L = (long)i * G + c; if (L >= nwg) return false;
        int wgid = (int)L; { const int q = nwg / NXCD, r = nwg % NXCD, xcd = wgid % NXCD, off = wgid / NXCD; wgid = (xcd < r ? xcd * (q + 1) : r * (q + 1) + (xcd - r) * q) + off; }
        const int nig = WGM * nN, gid = wgid / nig, fm = gid * WGM, gsz = (nM - fm) < WGM ? (nM - fm) : WGM;
        u.pm = fm + ((wgid % nig) % gsz); u.pn = (wgid % nig) / gsz; return true;
    }
    __device__ __forceinline__ void a_ready(const Unit&) const {}
    __device__ __forceinline__ void done(const Unit&) const {}
};
__device__ __forceinline__ unsigned cvt_pk_bf16(float lo, float hi) { unsigned r; asm volatile("v_cvt_pk_bf16_f32 %0, %1, %2" : "=v"(r) : "v"(lo), "v"(hi)); return r; }
typedef float f32x2 __attribute__((ext_vector_type(2)));
typedef unsigned u32x2 __attribute__((ext_vector_type(2)));
constexpr float RMS_EPS = 1e-6f;
template <int NPARTS> __device__ __forceinline__ float row_rstd(const float* ssq, int row) {
    float s;
    if (NPARTS == 1) s = ssq[row];
    else { const f32x4* p = (const f32x4*)(ssq + (size_t)row * 16); const f32x4 a = p[0], b = p[1], c = p[2], d = p[3]; const f32x4 t = (a + b) + (c + d); s = (t[0] + t[1]) + (t[2] + t[3]); }
    return __builtin_amdgcn_rsqf(s * (1.0f / 1024.0f) + RMS_EPS);
}
__device__ __forceinline__ float silu_f(float x) { return x * __builtin_amdgcn_rcpf(1.0f + __builtin_amdgcn_exp2f(-1.4426950408889634f * x)); }
template <int NPARTS> struct EpiSwiGLU {
    static constexpr bool PERM = true, AFTER_DRAIN = false;
    bf16_t* H; int ldh; const float* ssq;
    __device__ __forceinline__ void operator()(const f32x4 (&acc)[2][2][4][2], const Unit& u, int wr, int wc, int fr, int fq) const {
        const int row0 = u.pm * BM + wr * 64 + fr, col0 = u.pn * 128 + wc * 32 + 8 * fq;
#pragma unroll
        for (int ai = 0; ai < 2; ++ai)
#pragma unroll
            for (int m = 0; m < 4; ++m) { const int row = row0 + ai * HALF + m * 16; const float rs = row_rstd<NPARTS>(ssq, row);
                const f32x4 g0 = acc[ai][0][m][0] * rs, g1 = acc[ai][0][m][1] * rs, u0 = acc[ai][1][m][0] * rs, u1 = acc[ai][1][m][1] * rs;
                u32x4 w;
                w.x = cvt_pk_bf16(silu_f(g0[0]) * u0[0], silu_f(g0[1]) * u0[1]); w.y = cvt_pk_bf16(silu_f(g0[2]) * u0[2], silu_f(g0[3]) * u0[3]);
                w.z = cvt_pk_bf16(silu_f(g1[0]) * u1[0], silu_f(g1[1]) * u1[1]); w.w = cvt_pk_bf16(silu_f(g1[2]) * u1[2], silu_f(g1[3]) * u1[3]);
                *(u32x4*)(H + (size_t)row * ldh + col0) = w; if (m & 1) asm volatile("" ::: "memory"); }
    }
};
template <int NPARTS> struct EpiProj {
    static constexpr bool PERM = true, AFTER_DRAIN = false;
    bf16_t* O; int ldc; const float* ssq;
    __device__ __forceinline__ void operator()(const f32x4 (&acc)[2][2][4][2], const Unit& u, int wr, int wc, int fr, int fq) const {
        const int row0 = u.pm * BM + wr * 64 + fr, col0 = u.pn * BM + wc * 32 + 8 * fq;
#pragma unroll
        for (int ai = 0; ai < 2; ++ai)
#pragma unroll
            for (int m = 0; m < 4; ++m) { const int row = row0 + ai * HALF + m * 16; const float rs = row_rstd<NPARTS>(ssq, row);
#pragma unroll
                for (int bj = 0; bj < 2; ++bj) { const f32x4 v0 = acc[ai][bj][m][0] * rs, v1 = acc[ai][bj][m][1] * rs; u32x4 w;
                    w.x = cvt_pk_bf16(v0[0], v0[1]); w.y = cvt_pk_bf16(v0[2], v0[3]); w.z = cvt_pk_bf16(v1[0], v1[1]); w.w = cvt_pk_bf16(v1[2], v1[3]);
                    *(u32x4*)(O + (size_t)row * ldc + col0 + bj * HALF) = w; } if (m & 1) asm volatile("" ::: "memory"); }
    }
};
template <bool WB> struct EpiResid {
    static constexpr bool PERM = false, AFTER_DRAIN = false;
    const float* rin; float* out; bf16_t* xb; float* ssqp; float alpha;
    __device__ __forceinline__ void operator()(const f32x4 (&acc)[2][2][4][2], const Unit& u, int wr, int wc, int fr, int fq) const {
        const int row0 = u.pm * BM + wr * 64 + fr, col0 = u.pn * BM + wc * 32 + 4 * fq;
#pragma unroll
        for (int ai = 0; ai < 2; ++ai)
#pragma unroll
            for (int m = 0; m < 4; ++m) { const int row = row0 + ai * HALF + m * 16; float ss = 0.f;
#pragma unroll
                for (int bj = 0; bj < 2; ++bj)
#pragma unroll
                    for (int n = 0; n < 2; ++n) { const size_t off = (size_t)row * 1024 + col0 + bj * HALF + n * 16;
                        const f32x4 o = *(const f32x4*)(rin + off) + acc[ai][bj][m][n] * alpha; *(f32x4*)(out + off) = o;
                        if (WB) { u32x2 w; w.x = cvt_pk_bf16(o[0], o[1]); w.y = cvt_pk_bf16(o[2], o[3]); *(u32x2*)(xb + off) = w; ss += (o[0] * o[0] + o[1] * o[1]) + (o[2] * o[2] + o[3] * o[3]); } }
                if (WB) { ss += __shfl_xor(ss, 16); ss += __shfl_xor(ss, 32); if (fq == 0) ssqp[(size_t)row * 16 + u.pn * 4 + wc] = ss; } asm volatile("" ::: "memory"); }
    }
};
template <class Epi, class Sched, bool ALIGN_EPI = false, bool SP2 = false>
__device__ __forceinline__ void gemm_phase(PG8_LAS unsigned char* lds, const Gemm g, const Sched& S, const Epi& E) {
    int tid_ = threadIdx.x; asm volatile("" : "+v"(tid_)); const int tid = tid_, wid = __builtin_amdgcn_readfirstlane(tid >> 6), lane = tid & 63, wr = wid >> 2, wc = wid & 3, fr = lane & 15, fq = lane >> 4;
    const int K = g.K, nt = K / BK;
    unsigned voffA[2], voffB[2];
#pragma unroll
    for (int i = 0; i < 2; ++i) { int R, C; stage_rc(tid * 16 + i * 8192, R, C); const int Rb = Epi::PERM ? ((R & ~31) + perm32(R & 31)) : R;
        voffA[i] = (unsigned)(R * K + C) * 2u; voffB[i] = (unsigned)(Rb * K + C) * 2u; }
    const size_t kstep = (size_t)(BK * 2);
    const size_t hstep = (size_t)HALF * K * 2;
    const size_t tstep = 2 * hstep;
    const unsigned ldsw = (unsigned)wid * 1024u;
    const int aoff = lds_byte(wr * 64 + fr, fq * 8), boff = lds_byte(wc * 32 + fr, fq * 8);
#define PG8_SA(b, h) (((b) * 2 + (h)) * HTB)
#define PG8_SB(b, h) ((4 + (b) * 2 + (h)) * HTB)
#define PG8_STAGE(bufoff, gbase, voff) do { _Pragma("unroll") for (int _i = 0; _i < 2; ++_i) \
        __builtin_amdgcn_global_load_lds((const unsigned*)((const char*)(gbase) + (voff)[_i]), (PG8_LAS unsigned*)(lds + (bufoff) + ldsw + _i * 8192), 16, 0, 0); } while (0)
#define PG8_LDA(dst, b, h) do { _Pragma("unroll") for (int m = 0; m < 4; ++m) _Pragma("unroll") for (int k = 0; k < 2; ++k) dst[m][k] = *(const PG8_LAS bf16x8*)(lds + PG8_SA(b, h) + aoff + m * 2048 + k * 1024); } while (0)
#define PG8_LDB(dst, b, h) do { _Pragma("unroll") for (int n = 0; n < 2; ++n) _Pragma("unroll") for (int k = 0; k < 2; ++k) dst[n][k] = *(const PG8_LAS bf16x8*)(lds + PG8_SB(b, h) + boff + n * 2048 + k * 1024); } while (0)
#define PG8_MMA(ai, bj, At, Bt) do { __builtin_amdgcn_s_setprio(1); _Pragma("unroll") for (int m = 0; m < 4; ++m) _Pragma("unroll") for (int n = 0; n < 2; ++n) _Pragma("unroll") for (int k = 0; k < 2; ++k) \
        acc[ai][bj][m][n] = __builtin_amdgcn_mfma_f32_16x16x32_bf16(Bt[n][k], At[m][k], acc[ai][bj][m][n], 0, 0, 0); __builtin_amdgcn_s_setprio(0); } while (0)
#define PG8_WAIT_V(n) asm volatile("s_waitcnt vmcnt(" #n ")" ::: "memory")
#define PG8_WAIT_L(n) asm volatile("s_waitcnt lgkmcnt(" #n ")" ::: "memory")
#define PG8_BAR __builtin_amdgcn_s_barrier()
#define PG8_SCHED __builtin_amdgcn_sched_barrier(0)
    Unit cur, nxt; int ui = 0;
    if (!S.next(0, cur)) return;
    f32x4 acc[2][2][4][2];
#pragma unroll
    for (int a = 0; a < 2; ++a)
#pragma unroll
        for (int b = 0; b < 2; ++b)
#pragma unroll
            for (int m = 0; m < 4; ++m)
#pragma unroll
                for (int n = 0; n < 2; ++n) acc[a][b][m][n] = (f32x4){0.f, 0.f, 0.f, 0.f};
    bf16x8 At[4][2], B0[2][2], B1[2][2];
    const char* cA = (const char*)g.A + (size_t)cur.pm * tstep; const char* cB = (const char*)g.Bt + (size_t)cur.pn * tstep;
    S.a_ready(cur);
    if constexpr (SP2) {
        PG8_STAGE(PG8_SB(0, 0), cB, voffB); PG8_STAGE(PG8_SB(0, 1), cB + hstep, voffB); PG8_STAGE(PG8_SA(0, 0), cA, voffA); PG8_STAGE(PG8_SA(0, 1), cA + hstep, voffA);
        if (wr == 1) PG8_BAR;
        PG8_WAIT_V(2); PG8_BAR;
        PG8_STAGE(PG8_SB(1, 0), cB + kstep, voffB); PG8_STAGE(PG8_SA(1, 0), cA + kstep, voffA); PG8_STAGE(PG8_SB(1, 1), cB + hstep + kstep, voffB);
        PG8_WAIT_V(6); PG8_BAR;
    } else {
        PG8_STAGE(PG8_SB(0, 0), cB, voffB); PG8_STAGE(PG8_SA(0, 0), cA, voffA); PG8_STAGE(PG8_SB(0, 1), cB + hstep, voffB); PG8_STAGE(PG8_SA(0, 1), cA + hstep, voffA);
        if (wr == 1) PG8_BAR;
        PG8_WAIT_V(4); PG8_BAR;
        PG8_STAGE(PG8_SB(1, 0), cB + kstep, voffB); PG8_STAGE(PG8_SA(1, 0), cA + kstep, voffA); PG8_STAGE(PG8_SB(1, 1), cB + hstep + kstep, voffB);
        PG8_WAIT_V(6); PG8_BAR;
    }
    for (;;) {
        const bool has_next = S.next(ui + 1, nxt);
        const char* nA = has_next ? (const char*)g.A + (size_t)nxt.pm * tstep : cA; const char* nB = has_next ? (const char*)g.Bt + (size_t)nxt.pn * tstep : cB;
        for (int t = 0; t < nt; t += 2) {
            const bool last = (t == nt - 2);
            const char* a1 = cA + (size_t)(t + 1) * kstep;
            const char* a2 = last ? nA : cA + (size_t)(t + 2) * kstep; const char* b2 = last ? nB : cB + (size_t)(t + 2) * kstep;
            const char* a3 = a2 + kstep; const char* b3 = b2 + kstep;
            if (last && has_next) S.a_ready(nxt);
            if constexpr (SP2) {
            PG8_LDB(B0, 0, 0); PG8_LDB(B1, 0, 1); PG8_SCHED; PG8_LDA(At, 0, 0); PG8_STAGE(PG8_SA(1, 1), a1 + hstep, voffA);
            PG8_WAIT_V(8); PG8_WAIT_L(0); PG8_BAR; PG8_MMA(0, 0, At, B0); PG8_MMA(0, 1, At, B1); PG8_BAR; PG8_SCHED;
            PG8_LDA(At, 0, 1); PG8_STAGE(PG8_SB(0, 0), b2, voffB); PG8_STAGE(PG8_SB(0, 1), b2 + hstep, voffB); PG8_STAGE(PG8_SA(0, 0), a2, voffA);
            PG8_WAIT_V(8); PG8_WAIT_L(0); PG8_BAR; PG8_MMA(1, 0, At, B0); PG8_MMA(1, 1, At, B1); PG8_BAR; PG8_SCHED;
            PG8_LDB(B0, 1, 0); PG8_LDB(B1, 1, 1); PG8_SCHED; PG8_LDA(At, 1, 0); PG8_STAGE(PG8_SA(0, 1), a2 + hstep, voffA);
            PG8_WAIT_V(8); PG8_WAIT_L(0); PG8_BAR; PG8_MMA(0, 0, At, B0); PG8_MMA(0, 1, At, B1); PG8_BAR; PG8_SCHED;
            PG8_LDA(At, 1, 1); PG8_STAGE(PG8_SB(1, 0), b3, voffB); PG8_STAGE(PG8_SB(1, 1), b3 + hstep, voffB); PG8_STAGE(PG8_SA(1, 0), a3, voffA);
            PG8_WAIT_V(8); PG8_WAIT_L(0); PG8_BAR; PG8_MMA(1, 0, At, B0); PG8_MMA(1, 1, At, B1); PG8_BAR; PG8_SCHED;
            } else {
            PG8_LDB(B0, 0, 0); PG8_SCHED; PG8_LDA(At, 0, 0); PG8_STAGE(PG8_SA(1, 1), a1 + hstep, voffA);
            PG8_WAIT_L(8); PG8_BAR; PG8_WAIT_L(0); PG8_MMA(0, 0, At, B0); PG8_BAR; PG8_SCHED;
            PG8_LDB(B1, 0, 1); PG8_STAGE(PG8_SB(0, 0), b2, voffB);
            PG8_BAR; PG8_WAIT_L(0); PG8_MMA(0, 1, At, B1); PG8_BAR;
            PG8_LDA(At, 0, 1); PG8_STAGE(PG8_SA(0, 0), a2, voffA);
            PG8_BAR; PG8_WAIT_L(0); PG8_MMA(1, 0, At, B0); PG8_BAR; PG8_SCHED;
            PG8_STAGE(PG8_SB(0, 1), b2 + hstep, voffB);
            PG8_WAIT_V(6); PG8_BAR; PG8_MMA(1, 1, At, B1); PG8_BAR;
            PG8_LDB(B0, 1, 0); PG8_SCHED; PG8_LDA(At, 1, 0); PG8_STAGE(PG8_SA(0, 1), a2 + hstep, voffA);
            PG8_WAIT_L(8); PG8_BAR; PG8_WAIT_L(0); PG8_MMA(0, 0, At, B0); PG8_BAR; PG8_SCHED;
            PG8_LDB(B1, 1, 1); PG8_STAGE(PG8_SB(1, 0), b3, voffB);
            PG8_BAR; PG8_WAIT_L(0); PG8_MMA(0, 1, At, B1); PG8_BAR;
            PG8_LDA(At, 1, 1); PG8_STAGE(PG8_SA(1, 0), a3, voffA);
            PG8_BAR; PG8_WAIT_L(0); PG8_MMA(1, 0, At, B0); PG8_BAR; PG8_SCHED;
            PG8_STAGE(PG8_SB(1, 1), b3 + hstep, voffB);
            PG8_WAIT_V(6); PG8_BAR; PG8_MMA(1, 1, At, B1); PG8_BAR;
            }
        }
        if constexpr (ALIGN_EPI) { if (wr == 0) PG8_BAR; }
        if constexpr (!Epi::AFTER_DRAIN) { E(acc, cur, wr, wc, fr, fq); S.done(cur); }
        if (!has_next) break;
#pragma unroll
        for (int a = 0; a < 2; ++a)
#pragma unroll
            for (int b = 0; b < 2; ++b)
#pragma unroll
                for (int m = 0; m < 4; ++m)
#pragma unroll
                    for (int n = 0; n < 2; ++n) acc[a][b][m][n] = (f32x4){0.f, 0.f, 0.f, 0.f};
        cur = nxt; cA = nA; cB = nB; ++ui;
        if constexpr (ALIGN_EPI) { if (wr == 1) PG8_BAR; }
    }
    PG8_WAIT_V(0);
    if constexpr (!ALIGN_EPI) { if (wr == 0) PG8_BAR; }
    PG8_BAR;
    if constexpr (Epi::AFTER_DRAIN) { E.fused(acc, cur, wr, wc, fr, fq, lds, wid, lane); S.done(cur); }
#undef PG8_SA
#undef PG8_SB
#undef PG8_STAGE
#undef PG8_LDA
#undef PG8_LDB
#undef PG8_MMA
#undef PG8_WAIT_V
#undef PG8_WAIT_L
#undef PG8_BAR
#undef PG8_SCHED
}
}

#define GAS __attribute__((address_space(1)))
#define LAS __attribute__((address_space(3)))
typedef unsigned short bf16;
typedef unsigned v4u __attribute__((ext_vector_type(4)));
typedef float f32x4 __attribute__((ext_vector_type(4)));
typedef short bf16x8 __attribute__((ext_vector_type(8)));
typedef GAS unsigned gu32;
typedef GAS unsigned long long gu64;
#define RLX_AGENT __ATOMIC_RELAXED, __HIP_MEMORY_SCOPE_AGENT
#define LDS_WAIT() asm volatile("s_waitcnt lgkmcnt(0)" ::: "memory")
#define VM_WAIT() asm volatile("s_waitcnt vmcnt(0)" ::: "memory")
__device__ __forceinline__ unsigned long long rt() { return __builtin_amdgcn_s_memrealtime(); }
__device__ __forceinline__ unsigned f2bf(float f) { unsigned u = __builtin_bit_cast(unsigned, f); return (u + 0x7fffu + ((u >> 16) & 1u)) >> 16; }
__device__ __forceinline__ unsigned pk2(float lo, float hi) { return f2bf(lo) | (f2bf(hi) << 16); }
#define XB_TMO      128
#define XB_XCNT(j)  (256  + 64 * (j))
#define XB_XSUB(j)  (1280 + 64 * (j))
#define XB_XGEN(j)  (2304 + 64 * (j))
#define XB_TOP      3328
#define XB_TOPGEN   3392
#define XCD_BAR_WORDS 3456
#define XB_SPIN_CAP (1u << 18)

__device__ __forceinline__ unsigned xb_ld(unsigned* p)              { return __hip_atomic_load(p, __ATOMIC_RELAXED, __HIP_MEMORY_SCOPE_AGENT); }
__device__ __forceinline__ unsigned xb_add(unsigned* p, unsigned v) { return __hip_atomic_fetch_add(p, v, __ATOMIC_RELAXED, __HIP_MEMORY_SCOPE_AGENT); }
__device__ __forceinline__ unsigned xb_xcc_id() { return (unsigned)__builtin_amdgcn_s_getreg((3 << 11) | 20) & 0xFu; }
#define XB_SPIN(cond, bar) do { unsigned _sp = 0; while (cond) { __builtin_amdgcn_s_sleep(1); \
    if ((++_sp & 255u) == 0u) { if (xb_ld(&(bar)[XB_TMO])) break; if (_sp > XB_SPIN_CAP) { atomicAdd(&(bar)[XB_TMO], 1u); break; } } } } while (0)

struct XcdBarrier {
    unsigned* bar; unsigned x;
    volatile LAS unsigned* st;
};

__device__ __forceinline__ XcdBarrier xcd_barrier_post(unsigned* bar, volatile LAS unsigned* st) {
    XcdBarrier b; b.bar = bar; b.x = xb_xcc_id(); b.st = st;
    if (threadIdx.x == 0) (void)xb_add(&bar[XB_XCNT(b.x)], 1u);
    return b;
}
__device__ __forceinline__ void xcd_barrier_complete(unsigned* bar, unsigned x, unsigned& nloc, unsigned& nx) {
    const unsigned G = gridDim.x * gridDim.y * gridDim.z;
    unsigned sum, cnt, mine, sp = 0u;
    for (;;) {
        sum = 0u; cnt = 0u; mine = 0u;
#pragma unroll
        for (unsigned j = 0; j < 16; ++j) { const unsigned c = xb_ld(&bar[XB_XCNT(j)]); sum += c; cnt += (c > 0u) ? 1u : 0u; mine = (j == x) ? c : mine; }
        if (sum == G) break;
        __builtin_amdgcn_s_sleep(1);
        if ((++sp & 255u) == 0u) { if (xb_ld(&bar[XB_TMO])) break; if (sp > XB_SPIN_CAP) { atomicAdd(&bar[XB_TMO], 1u); break; } }
    }
    nloc = mine > 0u ? mine : 1u; nx = cnt > 0u ? cnt : 1u;
}

__device__ __forceinline__ void xcd_barrier(const XcdBarrier& b) {
    asm volatile("s_waitcnt vmcnt(0)" ::: "memory");
    __syncthreads();
    if (threadIdx.x == 0) {
        unsigned* bar = b.bar;
        __builtin_amdgcn_s_waitcnt(0);
        unsigned nloc = b.st[0], nx = b.st[1];
        if (nloc == 0u) { xcd_barrier_complete(bar, b.x, nloc, nx); b.st[0] = nloc; b.st[1] = nx; }
        const unsigned old = xb_add(&bar[XB_XSUB(b.x)], 1u);
        const unsigned gen = old / nloc;
        if (old + 1u == (gen + 1u) * nloc) {
            __builtin_amdgcn_fence(__ATOMIC_RELEASE, "agent");
            asm volatile("s_waitcnt vmcnt(0)" ::: "memory");
            const unsigned og = xb_add(&bar[XB_TOP], 1u);
            const unsigned tg = og / nx;
            if (og + 1u == (tg + 1u) * nx) xb_add(&bar[XB_TOPGEN], 1u);
            else XB_SPIN(xb_ld(&bar[XB_TOPGEN]) == tg, bar);
            __builtin_amdgcn_fence(__ATOMIC_ACQUIRE, "agent");
            xb_add(&bar[XB_XGEN(b.x)], 1u);
            asm volatile("s_waitcnt vmcnt(0)" ::: "memory");
        } else {
            XB_SPIN(xb_ld(&bar[XB_XGEN(b.x)]) == gen, bar);
            __builtin_amdgcn_fence(__ATOMIC_ACQUIRE, "agent");
            asm volatile("s_waitcnt vmcnt(0)" ::: "memory");
        }
    }
    __syncthreads();
}

constexpr int NWAVES = 8;
#ifndef REP_M2
#define REP_M2 1
#endif
#ifndef REP_M13
#define REP_M13 1
#endif
#ifndef REP_P0
#define REP_P0 1
#endif
#ifndef REP_P2
#define REP_P2 1
#endif
#ifndef REP_P3
#define REP_P3 1
#endif
#ifndef REP_BAR
#define REP_BAR 1
#endif
#ifndef REP_SCAN
#define REP_SCAN 1
#endif
#ifndef REP_P1
#define REP_P1 1
#endif
using pg8::RMS_EPS;
constexpr int BATCH = 8, T = 2048, D = 1024, FF = 2816, M = BATCH * T, NP = 3072;
constexpr int C_Q = 0, C_KC = 512, C_VC = 640, C_KS = 768, C_VS = 896, C_KW = 1024, C_VW = 1152, C_GQ = 1280, C_GK = 1536, C_GV = 1792, C_GR = 2304, C_GN = 2816, C_GA = 2840;
constexpr int SRC_NIN = 2856;
constexpr size_t MiB = 1u << 20;
constexpr size_t WS_CTL = 0, CTL_ZERO_BYTES = 1 * MiB;
constexpr size_t WS_W1GU = 1 * MiB, WS_W1D = 12 * MiB, WS_WIN = 18 * MiB, WS_WOUT = 24 * MiB, WS_W2GU = 26 * MiB, WS_W2D = 37 * MiB;
constexpr size_t WS_WC1K = 43 * MiB, WS_WC1V = 43 * MiB + 512 * 1024;
constexpr size_t WS_WC2K = 44 * MiB, WS_WC2V = 44 * MiB + 16384, WS_CBIAS = 44 * MiB + 32768  , WS_KC = 44 * MiB + 65536, WS_VTC = 44 * MiB + 65536 + 262144;
constexpr size_t WS_SSQ0 = 45 * MiB, WS_SSQA = 46 * MiB, WS_SSQB = 47 * MiB, WS_DEC = 48 * MiB;
constexpr size_t WS_XB = 50 * MiB, WS_KVT = WS_XB;
constexpr size_t WS_R = 82 * MiB;
constexpr size_t WS_MIX = 178 * MiB, WS_VTS = 210 * MiB, WS_VTW = 214 * MiB, WS_ST = 218 * MiB, WS_END = 234 * MiB;
constexpr int CW_BAR = 4096;
constexpr int RING_OFF = 0, RING_BYTES = 131072, LDSCTL_OFF = RING_BYTES, MISC_OFF = LDSCTL_OFF + 320, LDS_BYTES = 147456;

typedef unsigned u32x2 __attribute__((ext_vector_type(2)));
typedef float f32x2_t __attribute__((ext_vector_type(2))); typedef __bf16 bf16x2_t __attribute__((ext_vector_type(2)));
__device__ __forceinline__ unsigned cvtpk(float lo, float hi) { f32x2_t v = {lo, hi}; bf16x2_t b = __builtin_convertvector(v, bf16x2_t); return __builtin_bit_cast(unsigned, b); }
__device__ __forceinline__ bf16 f2b(float x) { return (bf16)(cvtpk(x, 0.f) & 0xffffu); }
__device__ __forceinline__ float bf2f(bf16 h) { return __builtin_bit_cast(float, (unsigned)h << 16); }
__device__ __forceinline__ float blo(unsigned w) { return __builtin_bit_cast(float, w << 16); }
__device__ __forceinline__ float bhi(unsigned w) { return __builtin_bit_cast(float, w & 0xffff0000u); }
__device__ __forceinline__ float fexp(float x) { return __builtin_amdgcn_exp2f(x * 1.4426950408889634f); }
__device__ __forceinline__ bf16x8 pack8(f32x4 a, f32x4 b) { v4u w; w.x = cvtpk(a[0], a[1]); w.y = cvtpk(a[2], a[3]); w.z = cvtpk(b[0], b[1]); w.w = cvtpk(b[2], b[3]); return __builtin_bit_cast(bf16x8, w); }
__device__ __forceinline__ bf16x8 ld2x8(const bf16* p0, const bf16* p1) { const u32x2 a = *(const u32x2*)p0, b = *(const u32x2*)p1; v4u w; w.x = a.x; w.y = a.y; w.z = b.x; w.w = b.y; return __builtin_bit_cast(bf16x8, w); }
__device__ __forceinline__ bf16x8 ldb16(const void* ub, unsigned boff) { return *(const bf16x8*)((const char*)ub + boff); }
__device__ __forceinline__ bf16x8 ldb8x2(const void* ub, unsigned boff) { const u32x2 a = *(const u32x2*)((const char*)ub + boff), b = *(const u32x2*)((const char*)ub + boff + 32); v4u w; w.x = a.x; w.y = a.y; w.z = b.x; w.w = b.y; return __builtin_bit_cast(bf16x8, w); }
__device__ __forceinline__ float ldb_bf(const void* ub, unsigned boff) { return bf2f(*(const bf16*)((const char*)ub + boff)); }
#define OPAQUE(x) asm volatile("" : "+v"(x))
#define MFMA16(a, b, c) __builtin_amdgcn_mfma_f32_16x16x32_bf16((a), (b), (c), 0, 0, 0)
#define WAVE_LDS_FENCE() asm volatile("s_waitcnt lgkmcnt(0)" ::: "memory")

struct Frame {
    LAS unsigned char* lds;
    volatile LAS unsigned* MISC;
    gu32* ctl;
    int tid, lane, wave, vcu, G;
    const float* in[22];
    float* out;
    bf16 *W1GU, *W1D, *WIN, *WOUT, *W2GU, *W2D, *WC1K, *WC1V, *WC2K, *WC2V, *KC, *VTC, *XB, *H, *PROJ, *MIX, *VTS, *VTW, *ST;
    float *CBIAS, *SSQ0, *SSQA, *SSQB, *DEC, *KVT;
};

__device__ __forceinline__ float wave_sum(float v) {
#pragma unroll
    for (int o = 1; o < 64; o <<= 1) v += __shfl_xor(v, o);
    return v;
}

__device__ __forceinline__ int win_src_col(int n) { return n < 1280 ? n : (n < 2816 ? n + 24 : (n < 2840 ? n - 1536 : (n < 2856 ? n : -1))); }
__device__ __forceinline__ void p0_tr_item(const float* W, const float* W2, const float* gain, int K, int Nsrc, int mode, bf16* WT, LAS float* scr, int kb, int nb, int lane) {
    const int k0 = 64 * kb, n0 = 32 * nb, nd = n0 + (lane & 31);
    const float* src = W; int sc = nd;
    if (mode == 1) { const int tile = nd >> 8, c = nd & 255; if (c >= 128) { src = W2; sc = tile * 128 + c - 128; } else sc = tile * 128 + c; }
    else if (mode == 2) sc = win_src_col(nd);
#pragma unroll 8
    for (int i = 0; i < 32; ++i) { const int kk = 2 * i + (lane >> 5); float v = 0.f; if (sc >= 0) v = src[(size_t)(k0 + kk) * Nsrc + sc]; if (gain) v *= gain[k0 + kk]; scr[kk * 33 + (lane & 31)] = v; }
    LDS_WAIT(); asm volatile("" ::: "memory");
    const int c = lane & 7;
#pragma unroll
    for (int j = 0; j < 4; ++j) { const int n = (lane >> 3) + 8 * j; const LAS float* s = scr + (8 * c) * 33 + n;
        v4u o; o.x = pk2(s[0 * 33], s[1 * 33]); o.y = pk2(s[2 * 33], s[3 * 33]); o.z = pk2(s[4 * 33], s[5 * 33]); o.w = pk2(s[6 * 33], s[7 * 33]);
        *(GAS v4u*)(WT + (size_t)(n0 + n) * K + k0 + 8 * c) = o; }
    LDS_WAIT(); asm volatile("" ::: "memory");
}
__device__ __forceinline__ void p0_prologue(Frame& F) {
    LAS float* scr = (LAS float*)(F.lds + RING_OFF + F.wave * 16384);
    const int gw = F.vcu * NWAVES + F.wave, NGW = F.G * NWAVES;
    constexpr int I_GU = 16 * 176, I_DN = 44 * 32, I_IN = 16 * 96, I_OUT = 16 * 32, I_C1 = 32 * 4, I_C2 = 2 * 2;
    constexpr int NITEMS = 2 * I_GU + 2 * I_DN + I_IN + I_OUT + 2 * I_C1 + 2 * I_C2;
    for (int it = gw; it < NITEMS; it += NGW) {
        int r = it;
        if (r < I_GU) { p0_tr_item(F.in[2], F.in[3], F.in[1], 1024, FF, 1, F.W1GU, scr, r / 176, r % 176, F.lane); continue; } r -= I_GU;
        if (r < I_GU) { p0_tr_item(F.in[18], F.in[19], F.in[17], 1024, FF, 1, F.W2GU, scr, r / 176, r % 176, F.lane); continue; } r -= I_GU;
        if (r < I_DN) { p0_tr_item(F.in[4], nullptr, nullptr, FF, 1024, 0, F.W1D, scr, r / 32, r % 32, F.lane); continue; } r -= I_DN;
        if (r < I_DN) { p0_tr_item(F.in[20], nullptr, nullptr, FF, 1024, 0, F.W2D, scr, r / 32, r % 32, F.lane); continue; } r -= I_DN;
        if (r < I_IN) { p0_tr_item(F.in[6], nullptr, F.in[5], 1024, SRC_NIN, 2, F.WIN, scr, r / 96, r % 96, F.lane); continue; } r -= I_IN;
        if (r < I_OUT) { p0_tr_item(F.in[16], nullptr, nullptr, 1024, 1024, 0, F.WOUT, scr, r / 32, r % 32, F.lane); continue; } r -= I_OUT;
        if (r < I_C1) { p0_tr_item(F.in[8], nullptr, nullptr, 2048, 128, 0, F.WC1K, scr, r / 4, r % 4, F.lane); continue; } r -= I_C1;
        if (r < I_C1) { p0_tr_item(F.in[11], nullptr, nullptr, 2048, 128, 0, F.WC1V, scr, r / 4, r % 4, F.lane); continue; } r -= I_C1;
        if (r < I_C2) { p0_tr_item(F.in[9], nullptr, nullptr, 128, 64, 0, F.WC2K, scr, r / 2, r % 2, F.lane); continue; } r -= I_C2;
        p0_tr_item(F.in[12], nullptr, nullptr, 128, 64, 0, F.WC2V, scr, r / 2, r % 2, F.lane);
    }
    for (int m = gw; m < M; m += NGW) {
        const GAS f32x4* xr = (const GAS f32x4*)(F.in[0] + (size_t)m * D) + F.lane;
        f32x4 v[4]; float s = 0.f;
#pragma unroll
        for (int j = 0; j < 4; ++j) { v[j] = xr[64 * j]; s += (v[j].x * v[j].x + v[j].y * v[j].y) + (v[j].z * v[j].z + v[j].w * v[j].w); }
        s = wave_sum(s);
        if (F.lane == 0) F.SSQ0[m] = s;
        GAS unsigned long long* o8 = (GAS unsigned long long*)(F.XB + (size_t)m * D) + F.lane;
#pragma unroll
        for (int j = 0; j < 4; ++j) o8[64 * j] = (unsigned long long)cvtpk(v[j].x, v[j].y) | ((unsigned long long)cvtpk(v[j].z, v[j].w) << 32);
    }
    for (int it = gw; it < 64; it += NGW) {
        const int kv = it >> 5, ch = it & 31; const float* W = (kv ? F.in[11] : F.in[8]) + (size_t)ch * 64 * 128 + F.lane; const float* pe = (kv ? F.in[10] : F.in[7]) + ch * 64;
        float s0 = 0.f, s1 = 0.f;
#pragma unroll 16
        for (int k = 0; k < 64; ++k) { const float p = pe[k]; s0 += p * W[k * 128]; s1 += p * W[k * 128 + 64]; }
        F.CBIAS[(kv * 32 + ch) * 128 + F.lane] = s0; F.CBIAS[(kv * 32 + ch) * 128 + 64 + F.lane] = s1;
    }
}

__device__ __forceinline__ void m1_compress(Frame& F, int ci) {
    const int kv = ci >> 7, b = (ci >> 4) & 7, g = (ci >> 3) & 1, rg = ci & 7;
    const int lane = F.lane, q = lane & 15, gl = lane >> 4, w = F.wave;
    LAS float* red = (LAS float*)(F.lds + RING_OFF);
    LAS bf16* hidb = (LAS bf16*)(F.lds + RING_OFF + 65536);
    const bf16* W1 = kv ? F.WC1V : F.WC1K; const bf16* W2 = kv ? F.WC2V : F.WC2K;
    const int ccol = (kv ? C_VC : C_KC) + g * 64;
    f32x4 acc[8];
#pragma unroll
    for (int nt = 0; nt < 8; ++nt) acc[nt] = (f32x4){0.f, 0.f, 0.f, 0.f};
#pragma unroll
    for (int ks = 0; ks < 8; ++ks) {
        const int l = 4 * w + (ks >> 1), dbase = 32 * (ks & 1) + 8 * gl;
        int tok = 16 * (16 * rg + q) + l; tok = tok > T - 1 ? T - 1 : tok;
        const bf16x8 a = *(const bf16x8*)(F.PROJ + ((size_t)b * T + tok) * NP + ccol + dbase);
        const int kg = 64 * l + dbase;
#pragma unroll
        for (int nt = 0; nt < 8; ++nt) { const bf16x8 bw = *(const bf16x8*)(W1 + (size_t)(16 * nt + q) * 2048 + kg); acc[nt] = MFMA16(a, bw, acc[nt]); }
    }
#pragma unroll
    for (int nt = 0; nt < 8; ++nt)
#pragma unroll
        for (int reg = 0; reg < 4; ++reg) red[(w * 16 + 4 * gl + reg) * 128 + 16 * nt + q] = acc[nt][reg];
    __syncthreads();
    {
        const int idx = F.tid * 4, r = idx >> 7, n = idx & 127;
        f32x4 s = (f32x4){0.f, 0.f, 0.f, 0.f};
#pragma unroll 8
        for (int ch = 0; ch < 32; ++ch) s += *(const f32x4*)(F.CBIAS + (kv * 32 + ch) * 128 + n);
#pragma unroll
        for (int ww = 0; ww < 8; ++ww) s += *(const LAS f32x4*)(red + (ww * 16 + r) * 128 + n);
        float o[4];
#pragma unroll
        for (int i = 0; i < 4; ++i) { const float x = s[i]; const float u2 = 2.0f * 0.7978845608028654f * (x + 0.044715f * x * x * x);
            const float th = 1.0f - 2.0f * __builtin_amdgcn_rcpf(fexp(u2) + 1.0f); o[i] = 0.5f * x * (1.0f + th); }
        u32x2 pw; pw.x = cvtpk(o[0], o[1]); pw.y = cvtpk(o[2], o[3]);
        *(LAS u32x2*)(hidb + r * 136 + n) = pw;
    }
    __syncthreads();
    if (w < 4) {
        f32x4 a2 = (f32x4){0.f, 0.f, 0.f, 0.f};
#pragma unroll
        for (int ks = 0; ks < 4; ++ks) { const bf16x8 a = *(const LAS bf16x8*)(hidb + q * 136 + 32 * ks + 8 * gl);
            const bf16x8 bw = *(const bf16x8*)(W2 + (size_t)(16 * w + q) * 128 + 32 * ks + 8 * gl); a2 = MFMA16(a, bw, a2); }
        const int d = 16 * w + q;
#pragma unroll
        for (int reg = 0; reg < 4; ++reg) { const int i = 16 * rg + 4 * gl + reg; const bf16 val = (i <= 126) ? f2b(a2[reg]) : (bf16)0;
            if (kv == 0) F.KC[((size_t)(b * 2 + g) * 128 + i) * 64 + d] = val; else F.VTC[((size_t)(b * 2 + g) * 64 + d) * 128 + i] = val; }
    }
    __syncthreads();
}

__device__ __forceinline__ void gla_prep(Frame& F, int b, int h, int n, LAS float* bm, LAS float* seg) {
    const int tid = F.tid, d = tid & 63, sg = tid >> 6;
    const float* wa = F.in[13] + h * 64 + d;
    float w[16];
#pragma unroll
    for (int r = 0; r < 16; ++r) w[r] = wa[r * 256];
    const float ba = F.in[14][h * 64 + d];
    float c[8]; float run = 0.f;
#pragma unroll
    for (int i = 0; i < 8; ++i) {
        const size_t row = (size_t)b * T + 64 * n + 8 * sg + i;
        const bf16* gp = F.PROJ + row * NP + C_GA;
        const v4u g0 = *(const v4u*)gp, g1 = *(const v4u*)(gp + 8);
        float z = ba;
        z += blo(g0.x) * w[0] + bhi(g0.x) * w[1] + blo(g0.y) * w[2] + bhi(g0.y) * w[3] + blo(g0.z) * w[4] + bhi(g0.z) * w[5] + blo(g0.w) * w[6] + bhi(g0.w) * w[7];
        z += blo(g1.x) * w[8] + bhi(g1.x) * w[9] + blo(g1.y) * w[10] + bhi(g1.y) * w[11] + blo(g1.z) * w[12] + bhi(g1.z) * w[13] + blo(g1.w) * w[14] + bhi(g1.w) * w[15];
        const float ls = fminf(z, 0.f) - __logf(1.0f + __expf(-fabsf(z)));
        run += ls * (1.0f / 16.0f); c[i] = run;
    }
    seg[sg * 64 + d] = run; __syncthreads();
    float pre = 0.f;
#pragma unroll
    for (int s2 = 0; s2 < 7; ++s2) pre += (s2 < sg) ? seg[s2 * 64 + d] : 0.f;
#pragma unroll
    for (int i = 0; i < 8; ++i) bm[(8 * sg + i) * 65 + d] = pre + c[i];
    __syncthreads();
}
__device__ __forceinline__ void gla_load_vt(Frame& F, size_t row, int h, int j, int c8, LAS bf16* VTl) {
    const bf16* vp = F.PROJ + row * NP + C_GV + h * 128 + 16 * c8;
    const v4u v0 = *(const v4u*)vp, v1 = *(const v4u*)(vp + 8);
    LAS bf16* dst = VTl + (16 * c8) * 72 + j;
    dst[0 * 72] = (bf16)(v0.x & 0xffffu); dst[1 * 72] = (bf16)(v0.x >> 16); dst[2 * 72] = (bf16)(v0.y & 0xffffu); dst[3 * 72] = (bf16)(v0.y >> 16);
    dst[4 * 72] = (bf16)(v0.z & 0xffffu); dst[5 * 72] = (bf16)(v0.z >> 16); dst[6 * 72] = (bf16)(v0.w & 0xffffu); dst[7 * 72] = (bf16)(v0.w >> 16);
    dst[8 * 72] = (bf16)(v1.x & 0xffffu); dst[9 * 72] = (bf16)(v1.x >> 16); dst[10 * 72] = (bf16)(v1.y & 0xffffu); dst[11 * 72] = (bf16)(v1.y >> 16);
    dst[12 * 72] = (bf16)(v1.z & 0xffffu); dst[13 * 72] = (bf16)(v1.z >> 16); dst[14 * 72] = (bf16)(v1.w & 0xffffu); dst[15 * 72] = (bf16)(v1.w >> 16);
}
__device__ __forceinline__ void m1_gla_kv(Frame& F, int item) {
    const int n = item & 31, h = (item >> 5) & 3, b = item >> 7;
    const int lane = F.lane, q = lane & 15, gl = lane >> 4, w = F.wave, tid = F.tid;
    LAS float* bm = (LAS float*)(F.lds + RING_OFF); LAS float* seg = (LAS float*)(F.lds + RING_OFF + 16640);
    LAS bf16* KstT = (LAS bf16*)(F.lds + RING_OFF + 18688); LAS bf16* VTl = (LAS bf16*)(F.lds + RING_OFF + 27904);
    gla_prep(F, b, h, n, bm, seg);
    const int j = tid >> 3, c8 = tid & 7; const size_t row = (size_t)b * T + 64 * n + j;
    {
        const v4u kk = *(const v4u*)(F.PROJ + row * NP + C_GK + h * 64 + 8 * c8);
        float kf[8] = {blo(kk.x), bhi(kk.x), blo(kk.y), bhi(kk.y), blo(kk.z), bhi(kk.z), blo(kk.w), bhi(kk.w)};
#pragma unroll
        for (int i = 0; i < 8; ++i) { const int d = 8 * c8 + i; const float e = fexp(bm[63 * 65 + d] - bm[j * 65 + d]); KstT[d * 72 + j] = f2b(kf[i] * e); }
    }
    gla_load_vt(F, row, h, j, c8, VTl);
    __syncthreads();
#pragma unroll
    for (int dt = 0; dt < 4; ++dt) {
        f32x4 acc = (f32x4){0.f, 0.f, 0.f, 0.f};
#pragma unroll
        for (int ks = 0; ks < 2; ++ks) { const bf16x8 a = *(const LAS bf16x8*)(KstT + (16 * dt + q) * 72 + 32 * ks + 8 * gl);
            const bf16x8 bv = *(const LAS bf16x8*)(VTl + (16 * w + q) * 72 + 32 * ks + 8 * gl); acc = MFMA16(a, bv, acc); }
        *(f32x4*)(F.KVT + ((size_t)item * 128 + 16 * w + q) * 64 + 16 * dt + 4 * gl) = acc;
    }
    if (tid < 64) F.DEC[(size_t)item * 64 + tid] = fexp(bm[63 * 65 + tid]);
    __syncthreads();
}
__device__ __forceinline__ void m1_transpose(Frame& F, int ti) {
    const int which = ti >> 9, rem = ti & 511, b = rem >> 6, g = (rem >> 5) & 1, tt = rem & 31;
    const bf16* src = F.PROJ + ((size_t)b * T + 64 * tt + F.lane) * NP + (which ? C_VW : C_VS) + g * 64;
    v4u x[8];
#pragma unroll
    for (int i = 0; i < 8; ++i) x[i] = *(const v4u*)(src + 8 * i);
    bf16* dst = (which ? F.VTW : F.VTS) + ((size_t)(b * 2 + g) * 64) * T + 64 * tt + F.lane;
#pragma unroll
    for (int d = 0; d < 64; ++d) { const unsigned wv = x[d >> 3][(d >> 1) & 3]; dst[(size_t)d * T] = (bf16)((d & 1) ? (wv >> 16) : (wv & 0xffffu)); }
}
__device__ __forceinline__ void m2_scan(Frame& F, int si) {
    const int bh = si >> 5, part = si & 31, qd = part * 64 + F.lane, v = qd >> 4, dq = qd & 15;
    f32x4 S = (f32x4){0.f, 0.f, 0.f, 0.f};
#pragma unroll 8
    for (int n = 0; n < 32; ++n) {
        const size_t item = (size_t)bh * 32 + n;
        const f32x4 kvv = *(const f32x4*)(F.KVT + (item * 128 + v) * 64 + 4 * dq);
        const f32x4 dc = *(const f32x4*)(F.DEC + item * 64 + 4 * dq);
        u32x2 wv; wv.x = cvtpk(S[0], S[1]); wv.y = cvtpk(S[2], S[3]);
        *(u32x2*)(F.ST + (item * 128 + v) * 64 + 4 * dq) = wv;
        S = S * dc + kvv;
    }
}
__device__ __forceinline__ void m3_gla_out(Frame& F, int item) {
    const int n = item & 31, h = (item >> 5) & 3, b = item >> 7;
    const int lane = F.lane, q = lane & 15, gl = lane >> 4, w = F.wave, tid = F.tid;
    LAS float* bm = (LAS float*)(F.lds + RING_OFF); LAS float* seg = (LAS float*)(F.lds + RING_OFF + 16640);
    LAS bf16* Qin = (LAS bf16*)(F.lds + RING_OFF + 18688); LAS bf16* Kin = (LAS bf16*)(F.lds + RING_OFF + 27904);
    LAS bf16* VTl = (LAS bf16*)(F.lds + RING_OFF + 37120); LAS bf16* Am = (LAS bf16*)(F.lds + RING_OFF + 55552);
    LAS float* ssqw = (LAS float*)(F.lds + RING_OFF + 64768);
    gla_prep(F, b, h, n, bm, seg);
    const int j = tid >> 3, c8 = tid & 7; const size_t row = (size_t)b * T + 64 * n + j;
    {
        const v4u qq = *(const v4u*)(F.PROJ + row * NP + C_GQ + h * 64 + 8 * c8);
        const v4u kk = *(const v4u*)(F.PROJ + row * NP + C_GK + h * 64 + 8 * c8);
        float qf[8] = {blo(qq.x), bhi(qq.x), blo(qq.y), bhi(qq.y), blo(qq.z), bhi(qq.z), blo(qq.w), bhi(qq.w)};
        float kf[8] = {blo(kk.x), bhi(kk.x), blo(kk.y), bhi(kk.y), blo(kk.z), bhi(kk.z), blo(kk.w), bhi(kk.w)};
#pragma unroll
        for (int i = 0; i < 8; ++i) { const float bb = bm[j * 65 + 8 * c8 + i]; qf[i] = qf[i] * 0.125f * fexp(bb); kf[i] = kf[i] * fexp(-bb); }
        v4u pq, pk; pq.x = cvtpk(qf[0], qf[1]); pq.y = cvtpk(qf[2], qf[3]); pq.z = cvtpk(qf[4], qf[5]); pq.w = cvtpk(qf[6], qf[7]);
        pk.x = cvtpk(kf[0], kf[1]); pk.y = cvtpk(kf[2], kf[3]); pk.z = cvtpk(kf[4], kf[5]); pk.w = cvtpk(kf[6], kf[7]);
        *(LAS v4u*)(Qin + j * 72 + 8 * c8) = pq; *(LAS v4u*)(Kin + j * 72 + 8 * c8) = pk;
    }
    gla_load_vt(F, row, h, j, c8, VTl);
    __syncthreads();
    {
        const int it = w >> 1;
#pragma unroll
        for (int jj = 0; jj < 2; ++jj) { const int jt = 2 * (w & 1) + jj; f32x4 a = (f32x4){0.f, 0.f, 0.f, 0.f};
            if (jt <= it) {
#pragma unroll
                for (int ks = 0; ks < 2; ++ks) a = MFMA16(*(const LAS bf16x8*)(Qin + (16 * it + q) * 72 + 32 * ks + 8 * gl), *(const LAS bf16x8*)(Kin + (16 * jt + q) * 72 + 32 * ks + 8 * gl), a);
            }
#pragma unroll
            for (int reg = 0; reg < 4; ++reg) { const int i = 16 * it + 4 * gl + reg, jx = 16 * jt + q; Am[i * 72 + jx] = (i >= jx) ? f2b(a[reg]) : (bf16)0; } }
    }
    __syncthreads();
    f32x4 acc[4];
#pragma unroll
    for (int it = 0; it < 4; ++it) acc[it] = (f32x4){0.f, 0.f, 0.f, 0.f};
#pragma unroll
    for (int ks = 0; ks < 2; ++ks) {
        const bf16x8 bv = *(const LAS bf16x8*)(VTl + (16 * w + q) * 72 + 32 * ks + 8 * gl);
        const bf16x8 bs = *(const bf16x8*)(F.ST + ((size_t)item * 128 + 16 * w + q) * 64 + 32 * ks + 8 * gl);
#pragma unroll
        for (int it = 0; it < 4; ++it) { acc[it] = MFMA16(*(const LAS bf16x8*)(Am + (16 * it + q) * 72 + 32 * ks + 8 * gl), bv, acc[it]);
            acc[it] = MFMA16(*(const LAS bf16x8*)(Qin + (16 * it + q) * 72 + 32 * ks + 8 * gl), bs, acc[it]); }
    }
#pragma unroll
    for (int it = 0; it < 4; ++it)
#pragma unroll
        for (int reg = 0; reg < 4; ++reg) { float s = acc[it][reg] * acc[it][reg]; s += __shfl_xor(s, 1); s += __shfl_xor(s, 2); s += __shfl_xor(s, 4); s += __shfl_xor(s, 8);
            if (q == 0) ssqw[w * 64 + 16 * it + 4 * gl + reg] = s; }
    __syncthreads();
    const float gg = F.in[15][16 * w + q];
#pragma unroll
    for (int it = 0; it < 4; ++it)
#pragma unroll
        for (int reg = 0; reg < 4; ++reg) { const int i = 16 * it + 4 * gl + reg; float tot = 0.f;
#pragma unroll
            for (int w2 = 0; w2 < 8; ++w2) tot += ssqw[w2 * 64 + i];
            const float rs = __builtin_amdgcn_rsqf(tot * (1.0f / 128.0f) + RMS_EPS);
            const size_t r2 = (size_t)b * T + 64 * n + i;
            const float gr = bf2f(F.PROJ[r2 * NP + C_GR + h * 128 + 16 * w + q]);
            const float sl = gr * __builtin_amdgcn_rcpf(1.0f + fexp(-gr));
            F.MIX[r2 * 1024 + 512 + h * 128 + 16 * w + q] = f2b(acc[it][reg] * rs * gg * sl); }
    __syncthreads();
}

constexpr float NSA_C2 = 0.125f * 1.4426950408889634f, NSA_THR = 8.0f;
constexpr int NSA_STAGE_BYTES = 16384, NSA_VOFF = 8192, NSA_NSTAGE = 4, NSA_KC_OFF = NSA_NSTAGE * NSA_STAGE_BYTES, NSA_VC_OFF = NSA_KC_OFF + 18432, NSA_UM_OFF = NSA_VC_OFF + 17408;
__device__ __forceinline__ bf16x8 scale8(bf16x8 x, float c) { const v4u w = __builtin_bit_cast(v4u, x); v4u o;
    o.x = cvtpk(blo(w.x) * c, bhi(w.x) * c); o.y = cvtpk(blo(w.y) * c, bhi(w.y) * c); o.z = cvtpk(blo(w.z) * c, bhi(w.z) * c); o.w = cvtpk(blo(w.w) * c, bhi(w.w) * c); return __builtin_bit_cast(bf16x8, o); }
__device__ __forceinline__ float dot8(bf16x8 a, bf16x8 b) { const v4u x = __builtin_bit_cast(v4u, a), y = __builtin_bit_cast(v4u, b);
    return ((blo(x.x) * blo(y.x) + bhi(x.x) * bhi(y.x)) + (blo(x.y) * blo(y.y) + bhi(x.y) * bhi(y.y))) + ((blo(x.z) * blo(y.z) + bhi(x.z) * bhi(y.z)) + (blo(x.w) * blo(y.w) + bhi(x.w) * bhi(y.w))); }
__device__ __forceinline__ float max3f(float a, float b, float c) { float r; asm("v_max3_f32 %0, %1, %2, %3" : "=v"(r) : "v"(a), "v"(b), "v"(c)); return r; }
struct NsaState { f32x4 O[2][4]; float m[2], l[2]; };
__device__ __forceinline__ void nsa_init(NsaState& st, const bf16x8 (&qf)[2][2], const bf16* Kself  , unsigned voK) {
    const bf16x8 k0 = ldb16(Kself, voK), k1 = ldb16(Kself + 32, voK);
#pragma unroll
    for (int r = 0; r < 2; ++r) { float s = dot8(qf[r][0], k0) + dot8(qf[r][1], k1); s += __shfl_xor(s, 16); s += __shfl_xor(s, 32); st.m[r] = s; st.l[r] = 0.f;
#pragma unroll
        for (int dt = 0; dt < 4; ++dt) st.O[r][dt] = (f32x4){0.f, 0.f, 0.f, 0.f}; }
}
__device__ __forceinline__ void nsa_tile(NsaState& st, const bf16x8 (&qf)[2][2], const float (&slope2)[2], const LAS bf16* Ks, const LAS bf16* Vs, int key0, int t, int q, int gl, bool selbit, int wlim, bool need_mask) {
#pragma unroll 1
    for (int half = 0; half < 2; ++half) {
        bf16x8 kf[2][2], vf[4];
#pragma unroll
        for (int kt = 0; kt < 2; ++kt)
#pragma unroll
            for (int ks = 0; ks < 2; ++ks) kf[kt][ks] = *(const LAS bf16x8*)((const LAS unsigned char*)Ks + (32 * half + 16 * kt + q) * 128 + 16 * ((4 * ks + gl) ^ (q >> 1)));
#pragma unroll
        for (int dt = 0; dt < 4; ++dt) { const LAS unsigned char* vr = (const LAS unsigned char*)Vs + (16 * dt + q) * 128 + 8 * (gl & 1); const int c0 = 4 * half + (gl >> 1);
            const u32x2 a = *(const LAS u32x2*)(vr + 16 * (c0 ^ (q >> 1))), c = *(const LAS u32x2*)(vr + 16 * ((c0 + 2) ^ (q >> 1)));
            v4u wv; wv.x = a.x; wv.y = a.y; wv.z = c.x; wv.w = c.y; vf[dt] = __builtin_bit_cast(bf16x8, wv); }
        const int kbase = key0 + 32 * half + 4 * gl;
        const float kb = (float)(kbase - t);
#pragma unroll
        for (int r = 0; r < 2; ++r) {
            const float c1 = selbit ? (slope2[r] * kb - st.m[r]) : -INFINITY;
            f32x4 s0, s1;
#pragma unroll
            for (int reg = 0; reg < 4; ++reg) { s0[reg] = slope2[r] * (float)reg + c1; s1[reg] = slope2[r] * (float)(16 + reg) + c1; }
            s0 = MFMA16(kf[0][0], qf[r][0], s0); s0 = MFMA16(kf[0][1], qf[r][1], s0);
            s1 = MFMA16(kf[1][0], qf[r][0], s1); s1 = MFMA16(kf[1][1], qf[r][1], s1);
            if (need_mask) {
#pragma unroll
                for (int reg = 0; reg < 4; ++reg) { const int d0 = t - (kbase + reg), d1 = d0 - 16;
                    s0[reg] = (d0 >= 0 && d0 < wlim) ? s0[reg] : -INFINITY; s1[reg] = (d1 >= 0 && d1 < wlim) ? s1[reg] : -INFINITY; }
            }
            const float lmax = max3f(max3f(s0[0], s0[1], s0[2]), max3f(s0[3], s1[0], s1[1]), max3f(s1[2], s1[3], s1[3]));
            if (__ballot(lmax > NSA_THR) != 0ull) {
                float rm = fmaxf(lmax, __shfl_xor(lmax, 16)); rm = fmaxf(rm, __shfl_xor(rm, 32));
                const float dl = fmaxf(rm, 0.f), f = __builtin_amdgcn_exp2f(-dl);
                st.m[r] += dl; st.l[r] *= f;
#pragma unroll
                for (int reg = 0; reg < 4; ++reg) { s0[reg] -= dl; s1[reg] -= dl; }
#pragma unroll
                for (int dt = 0; dt < 4; ++dt) st.O[r][dt] *= f;
            }
            float ps = 0.f;
#pragma unroll
            for (int reg = 0; reg < 4; ++reg) { s0[reg] = __builtin_amdgcn_exp2f(s0[reg]); s1[reg] = __builtin_amdgcn_exp2f(s1[reg]); ps += s0[reg] + s1[reg]; }
            st.l[r] += ps;
            const bf16x8 pb = pack8(s0, s1);
#pragma unroll
            for (int dt = 0; dt < 4; ++dt) st.O[r][dt] = MFMA16(vf[dt], pb, st.O[r][dt]);
        }
    }
}
__device__ __forceinline__ void nsa_flush(NsaState& st, f32x4 (&tot)[2][4], const bf16* Pg  , int c, unsigned voG) {
#pragma unroll
    for (int r = 0; r < 2; ++r) { float l = st.l[r]; l += __shfl_xor(l, 16); l += __shfl_xor(l, 32);
        const float gate = __builtin_amdgcn_rcpf(1.0f + fexp(-ldb_bf(Pg + r * 3 + c, voG)));
        const float sc = gate * __builtin_amdgcn_rcpf(l);
#pragma unroll
        for (int dt = 0; dt < 4; ++dt) tot[r][dt] += st.O[r][dt] * sc; }
}
__device__ __forceinline__ void m2_nsa_unit(Frame& F, int b, int g, int cur) {
    int tid = F.tid; OPAQUE(tid);
    const int lane = tid & 63, q = lane & 15, gl = lane >> 4, w = F.wave;
    const int tgi = w & 3, pair = w >> 2;
    const int t0 = 64 * cur + 16 * tgi, t = t0 + q;
    const bf16* Pr = F.PROJ + ((size_t)b * T + t0) * NP;
    const bf16* Pq = Pr + C_Q + 4 * g * 64; const bf16* Pg = Pr + C_GN + (4 * g + 2 * pair) * 3;
    LAS unsigned char* L = F.lds + RING_OFF;
    LAS unsigned* um = (LAS unsigned*)(L + NSA_UM_OFF);
    const unsigned voQ = (unsigned)(q * NP + 8 * gl) * 2u, voG = (unsigned)(q * NP) * 2u;
    const float tf = (float)t;
    const int jw0 = (cur - 8) < 0 ? 0 : (cur - 8), nwin = cur + 1 - jw0;
    const bf16* Ksg = F.PROJ + (size_t)b * T * NP + C_KS + g * 64; const bf16* Kwg = F.PROJ + (size_t)b * T * NP + C_KW + g * 64;
    const bf16* VTs = F.VTS + (size_t)(b * 2 + g) * 64 * T; const bf16* VTw = F.VTW + (size_t)(b * 2 + g) * 64 * T;
    const int srow = 8 * w + (lane >> 3), sc = (lane & 7) ^ ((srow >> 1) & 7);
    const unsigned gK = (unsigned)(srow * NP + 8 * sc) * 2u, gV = (unsigned)(srow * T + 8 * sc) * 2u;
    unsigned remF = (cur <= 7) ? ((2u << cur) - 1u) : 0u; int fi = 0;
#define NSA_ISSUE() do { int j_; const bf16 *kp_, *vp_; if (fi < nwin) { j_ = jw0 + fi; kp_ = Kwg; vp_ = VTw; } else { j_ = __builtin_ctz(remF); remF &= remF - 1u; kp_ = Ksg; vp_ = VTs; } \
        LAS unsigned char* sb_ = L + (fi & 3) * NSA_STAGE_BYTES + w * 1024; ++fi; \
        __builtin_amdgcn_global_load_lds((const unsigned*)((const char*)(kp_ + (size_t)j_ * 64 * NP) + gK), (LAS unsigned*)sb_, 16, 0, 0); \
        __builtin_amdgcn_global_load_lds((const unsigned*)((const char*)(vp_ + j_ * 64) + gV), (LAS unsigned*)(sb_ + NSA_VOFF), 16, 0, 0); } while (0)
#define NSA_WAITV(n) asm volatile("s_waitcnt vmcnt(" #n ")" ::: "memory")
#define NSA_BAR() do { asm volatile("s_waitcnt lgkmcnt(0)" ::: "memory"); __builtin_amdgcn_s_barrier(); asm volatile("" ::: "memory"); } while (0)
    NSA_ISSUE(); NSA_ISSUE();
    if (cur >= 1) NSA_ISSUE();
    {
        const bf16* KCg = F.KC + (size_t)(b * 2 + g) * 128 * 64; const bf16* VCg = F.VTC + (size_t)(b * 2 + g) * 64 * 128;
#pragma unroll
        for (int i = 0; i < 2; ++i) { const int c = tid + 512 * i;
            *(LAS v4u*)(L + NSA_KC_OFF + ((c >> 3) * 72 + 8 * (c & 7)) * 2) = *(const v4u*)(KCg + 8 * c);
            *(LAS v4u*)(L + NSA_VC_OFF + ((c >> 4) * 136 + 8 * (c & 15)) * 2) = *(const v4u*)(VCg + 8 * c); }
    }
    __syncthreads();
    f32x4 tot[2][4];
    unsigned mask;
    {
        const LAS bf16* KCs = (const LAS bf16*)(L + NSA_KC_OFF); const LAS bf16* VCs = (const LAS bf16*)(L + NSA_VC_OFF);
        f32x4 psum[8];
#pragma unroll
        for (int nt = 0; nt < 8; ++nt) psum[nt] = (f32x4){0.f, 0.f, 0.f, 0.f};
#pragma unroll 1
        for (int r = 0; r < 4; ++r) {
            int glo = gl; OPAQUE(glo);
            const bf16x8 q0 = scale8(ldb16(Pq + r * 64, voQ), NSA_C2), q1 = scale8(ldb16(Pq + r * 64 + 32, voQ), NSA_C2);
            const float sl2 = __builtin_amdgcn_exp2f(-(float)(4 * g + r + 1)) * 1.4426950408889634f;
            f32x4 S[8]; const f32x4 z = (f32x4){0.f, 0.f, 0.f, 0.f};
#pragma unroll
            for (int nt = 0; nt < 8; ++nt) { const LAS bf16* kp = KCs + (16 * nt + q) * 72 + 8 * gl; S[nt] = MFMA16(*(const LAS bf16x8*)kp, q0, z); S[nt] = MFMA16(*(const LAS bf16x8*)(kp + 32), q1, S[nt]); }
            float mx = -1e30f;
#pragma unroll
            for (int nt = 0; nt < 8; ++nt)
#pragma unroll
                for (int reg = 0; reg < 4; ++reg) { const int n = 16 * nt + 4 * glo + reg; const bool valid = (16 * n + 31 <= t);
                    const float s = S[nt][reg] - sl2 * (tf - (16.0f * (float)n + 15.5f)); S[nt][reg] = valid ? s : -1e30f; mx = fmaxf(mx, S[nt][reg]); }
            mx = fmaxf(mx, __shfl_xor(mx, 16)); mx = fmaxf(mx, __shfl_xor(mx, 32));
            float sum = 0.f;
#pragma unroll
            for (int nt = 0; nt < 8; ++nt)
#pragma unroll
                for (int reg = 0; reg < 4; ++reg) { const float p = (S[nt][reg] > -1e29f) ? __builtin_amdgcn_exp2f(S[nt][reg] - mx) : 0.f; S[nt][reg] = p; sum += p; }
            sum += __shfl_xor(sum, 16); sum += __shfl_xor(sum, 32);
            const float inv = sum > 0.f ? 1.0f / sum : 0.f;
#pragma unroll
            for (int nt = 0; nt < 8; ++nt) { S[nt] = S[nt] * inv; psum[nt] += S[nt]; }
            if ((r >> 1) == pair) {
                f32x4 oc[4];
#pragma unroll
                for (int dt = 0; dt < 4; ++dt) oc[dt] = (f32x4){0.f, 0.f, 0.f, 0.f};
#pragma unroll
                for (int kp = 0; kp < 4; ++kp) { const bf16x8 pb = pack8(S[2 * kp], S[2 * kp + 1]);
#pragma unroll
                    for (int dt = 0; dt < 4; ++dt) { const LAS bf16* vp = VCs + (16 * dt + q) * 136 + 32 * kp + 4 * gl; const u32x2 a = *(const LAS u32x2*)vp, c = *(const LAS u32x2*)(vp + 16);
                        v4u wv; wv.x = a.x; wv.y = a.y; wv.z = c.x; wv.w = c.y; oc[dt] = MFMA16(__builtin_bit_cast(bf16x8, wv), pb, oc[dt]); } }
                const float gate = __builtin_amdgcn_rcpf(1.0f + fexp(-ldb_bf(Pg + (r & 1) * 3, voG)));
                if (r & 1) {
#pragma unroll
                    for (int dt = 0; dt < 4; ++dt) tot[1][dt] = oc[dt] * gate;
                } else {
#pragma unroll
                    for (int dt = 0; dt < 4; ++dt) tot[0][dt] = oc[dt] * gate;
                }
            }
        }
        if (cur <= 7) mask = (2u << cur) - 1u;
        else {
            float v[8]; float shp = 0.f;
#pragma unroll
            for (int nt = 0; nt < 8; ++nt) { const float sh = __shfl(psum[nt][3], (lane + 48) & 63);
                const float pterm = (gl > 0) ? sh : shp; shp = sh;
                v[nt] = pterm + ((psum[nt][0] + psum[nt][1]) + (psum[nt][2] + psum[nt][3])); }
            mask = 1u | (1u << cur) | (1u << (cur - 1));
            unsigned taken = 0u;
#pragma unroll
            for (int round = 0; round < 5; ++round) {
                float bv = -1.f; int bi = 99;
#pragma unroll
                for (int i = 0; i < 8; ++i) { const int s = 4 * i + gl; const bool ok = (s >= 1) && (s <= cur - 2) && (((taken >> i) & 1u) == 0u); if (ok && v[i] > bv) { bv = v[i]; bi = s; } }
#pragma unroll
                for (int off = 16; off <= 32; off <<= 1) { const float ov = __shfl_xor(bv, off); const int oi = __shfl_xor(bi, off); if (ov > bv || (ov == bv && oi < bi)) { bv = ov; bi = oi; } }
                if (bi < 32) { mask |= 1u << bi; if ((bi & 3) == gl) taken |= 1u << (bi >> 2); }
            }
        }
    }
    unsigned wm = 0u;
#pragma unroll
    for (int j = 0; j < 32; ++j) wm |= (__ballot((mask >> j) & 1u) != 0ull) ? (1u << j) : 0u;
    if (lane == 0) um[w] = wm;
    __syncthreads();
    unsigned U = 0u;
#pragma unroll
    for (int i = 0; i < 8; ++i) U |= um[i];
    U = __builtin_amdgcn_readfirstlane(U);
    if (cur > 7) remF = U;
    const int nsel = __builtin_popcount(U), NT = nwin + nsel;
    bf16x8 qf[2][2]; float slope2[2];
#pragma unroll
    for (int r = 0; r < 2; ++r) { slope2[r] = __builtin_amdgcn_exp2f(-(float)(4 * g + 2 * pair + r + 1)) * 1.4426950408889634f;
#pragma unroll
        for (int ks = 0; ks < 2; ++ks) qf[r][ks] = scale8(ldb16(Pq + (2 * pair + r) * 64 + 32 * ks, voQ), NSA_C2); }
    NsaState st;
    const unsigned voK = (unsigned)(q * NP + 8 * gl) * 2u;
    nsa_init(st, qf, Pr + C_KW + g * 64, voK);
    unsigned remC = U;
    NSA_WAITV(0); NSA_BAR();
    for (int i = 0; i < NT; ++i) {
        if (i + 3 < NT) NSA_ISSUE();
        const LAS bf16* Ks = (const LAS bf16*)(L + (i & 3) * NSA_STAGE_BYTES); const LAS bf16* Vs = Ks + NSA_VOFF / 2;
        int key0, wlim; bool selbit, need_mask, run;
        if (i < nwin) {
            const int j = jw0 + i; key0 = 64 * j; wlim = 512; selbit = true;
            run = (key0 + 63 >= t0 - 511) && (key0 <= t0 + 15); need_mask = !(key0 >= t0 + 15 - 511 && key0 + 63 <= t0);
        } else {
            if (i == nwin) { nsa_flush(st, tot, Pg, 2, voG); nsa_init(st, qf, Pr + C_KS + g * 64, voK); }
            const int j = __builtin_ctz(remC); remC &= remC - 1u;
            selbit = ((mask >> j) & 1u) != 0u; const unsigned long long bal = __ballot(selbit);
            key0 = 64 * j; wlim = 0x7fffffff; run = (bal != 0ull); need_mask = (j == cur);
        }
#ifdef PROBE_TILE2
        if (run) { NsaState st2 = st; nsa_tile(st2, qf, slope2, Ks, Vs, key0, t, q, gl, selbit, wlim, need_mask);
#pragma unroll
            for (int r_ = 0; r_ < 2; ++r_) { asm volatile("" :: "v"(st2.m[r_]), "v"(st2.l[r_]));
#pragma unroll
                for (int d_ = 0; d_ < 4; ++d_) asm volatile("" :: "v"(st2.O[r_][d_])); } }
#endif
        if (run) nsa_tile(st, qf, slope2, Ks, Vs, key0, t, q, gl, selbit, wlim, need_mask);
        if (i + 3 < NT) NSA_WAITV(4); else if (i + 2 < NT) NSA_WAITV(2); else NSA_WAITV(0);
        NSA_BAR();
    }
    nsa_flush(st, tot, Pg, 1, voG);
    bf16* Mo = F.MIX + ((size_t)b * T + t0) * 1024 + (4 * g + 2 * pair) * 64; const unsigned voM = (unsigned)(q * 1024 + 4 * gl) * 2u;
#pragma unroll
    for (int r = 0; r < 2; ++r)
#pragma unroll
        for (int dt = 0; dt < 4; ++dt) { const f32x4 o = tot[r][dt]; u32x2 wv; wv.x = cvtpk(o[0], o[1]); wv.y = cvtpk(o[2], o[3]); *(u32x2*)((char*)(Mo + r * 64 + 16 * dt) + voM) = wv; }
#undef NSA_ISSUE
#undef NSA_WAITV
#undef NSA_BAR
}

__device__ __forceinline__ void p8_final_norm(Frame& F) {
    const int gw = F.vcu * NWAVES + F.wave, NGW = F.G * NWAVES;
    const GAS f32x4* gp = (const GAS f32x4*)F.in[21] + F.lane;
    f32x4 gv[4];
#pragma unroll
    for (int j = 0; j < 4; ++j) gv[j] = gp[64 * j];
    for (int m = gw; m < M; m += NGW) {
        GAS f32x4* xr = (GAS f32x4*)(F.out + (size_t)m * D) + F.lane;
        f32x4 v[4]; float s = 0.f;
#pragma unroll
        for (int j = 0; j < 4; ++j) { v[j] = xr[64 * j]; s += (v[j].x * v[j].x + v[j].y * v[j].y) + (v[j].z * v[j].z + v[j].w * v[j].w); }
        const float rs = __builtin_amdgcn_rsqf(wave_sum(s) * (1.0f / 1024.0f) + RMS_EPS);
#pragma unroll
        for (int j = 0; j < 4; ++j) xr[64 * j] = v[j] * rs * gv[j];
    }
}

struct Args { const float* in[22]; float* out; unsigned char* ws; };
__global__ void __launch_bounds__(NWAVES * 64, 2) hybrid_fwd(Args args) {
    extern __shared__ __attribute__((aligned(16))) unsigned char lds[];
    Frame F;
    F.lds = (LAS unsigned char*)lds;
    F.MISC = (volatile LAS unsigned*)(F.lds + MISC_OFF);
    F.tid = threadIdx.x; F.lane = F.tid & 63; F.wave = __builtin_amdgcn_readfirstlane(F.tid >> 6);
    F.G = gridDim.x; { const int bx = blockIdx.x; F.vcu = (F.G % 8 == 0) ? (bx % 8) * (F.G / 8) + bx / 8 : bx; }
    unsigned char* ws = args.ws;
    F.ctl = (gu32*)(ws + WS_CTL);
#pragma unroll
    for (int i = 0; i < 22; ++i) F.in[i] = args.in[i];
    F.out = args.out;
    F.W1GU = (bf16*)(ws + WS_W1GU); F.W1D = (bf16*)(ws + WS_W1D); F.WIN = (bf16*)(ws + WS_WIN); F.WOUT = (bf16*)(ws + WS_WOUT); F.W2GU = (bf16*)(ws + WS_W2GU); F.W2D = (bf16*)(ws + WS_W2D);
    F.WC1K = (bf16*)(ws + WS_WC1K); F.WC1V = (bf16*)(ws + WS_WC1V); F.WC2K = (bf16*)(ws + WS_WC2K); F.WC2V = (bf16*)(ws + WS_WC2V);
    F.KC = (bf16*)(ws + WS_KC); F.VTC = (bf16*)(ws + WS_VTC); F.XB = (bf16*)(ws + WS_XB); F.H = (bf16*)(ws + WS_R); F.PROJ = (bf16*)(ws + WS_R);
    F.MIX = (bf16*)(ws + WS_MIX); F.VTS = (bf16*)(ws + WS_VTS); F.VTW = (bf16*)(ws + WS_VTW); F.ST = (bf16*)(ws + WS_ST);
    F.CBIAS = (float*)(ws + WS_CBIAS); F.SSQ0 = (float*)(ws + WS_SSQ0); F.SSQA = (float*)(ws + WS_SSQA); F.SSQB = (float*)(ws + WS_SSQB); F.DEC = (float*)(ws + WS_DEC); F.KVT = (float*)(ws + WS_KVT);
    for (int u = F.tid; u < (LDS_BYTES - LDSCTL_OFF) / 4; u += NWAVES * 64) ((LAS unsigned*)(F.lds + LDSCTL_OFF))[u] = 0u;
    __syncthreads();
    XcdBarrier bar = xcd_barrier_post((unsigned*)(F.ctl + CW_BAR), F.MISC + 8);
#define GRID_BAR() do { for (int rb_ = 0; rb_ < REP_BAR; ++rb_) xcd_barrier(bar); asm volatile("" : "+v"(F.tid)); F.lane = F.tid & 63; } while (0)
    const int gw = F.vcu * NWAVES + F.wave, NGW = F.G * NWAVES;

#ifndef NO_P0
    for (int rep = 0; rep < REP_P0; ++rep) p0_prologue(F);
#endif
    GRID_BAR();
#ifndef NO_GEMM
    { pg8::Gemm g{F.XB, F.W1GU, M, 2 * FF, D}; pg8::StaticOrder S; S.init(M, 2 * FF, F.G, (int)blockIdx.x);
      pg8::EpiSwiGLU<1> E{F.H, FF, F.SSQ0};
      for (int rep = 0; rep < REP_P1; ++rep) pg8::gemm_phase<pg8::EpiSwiGLU<1>, pg8::StaticOrder, true, true>(F.lds + RING_OFF, g, S, E); }
#endif
    GRID_BAR();
#ifndef NO_GEMM
    { pg8::Gemm g{F.H, F.W1D, M, D, FF}; pg8::StaticOrder S; S.init(M, D, F.G, (int)blockIdx.x);
      pg8::EpiResid<true> E{F.in[0], F.out, F.XB, F.SSQA, 0.5f};
      for (int rep = 0; rep < REP_P2; ++rep) pg8::gemm_phase<pg8::EpiResid<true>, pg8::StaticOrder, true, true>(F.lds + RING_OFF, g, S, E); }
#endif
    GRID_BAR();
#ifndef NO_GEMM
    { pg8::Gemm g{F.XB, F.WIN, M, NP, D}; pg8::StaticOrder S; S.init(M, NP, F.G, (int)blockIdx.x);
      pg8::EpiProj<16> E{F.PROJ, NP, F.SSQA};
      for (int rep = 0; rep < REP_P3; ++rep) pg8::gemm_phase<pg8::EpiProj<16>, pg8::StaticOrder, true, true>(F.lds + RING_OFF, g, S, E); }
#endif
    GRID_BAR();
#ifndef NO_M1
    for (int rep = 0; rep < REP_M13; ++rep) {
    for (int ci = F.vcu; ci < 256; ci += F.G) m1_compress(F, ci);
    for (int it = F.vcu; it < 1024; it += F.G) m1_gla_kv(F, it);
    for (int ti = gw; ti < 1024; ti += NGW) m1_transpose(F, ti);
    }
#endif
    GRID_BAR();
#ifndef NO_NSA
    for (int rep = 0; rep < REP_M2; ++rep)
    for (int wi = F.vcu; wi < 256; wi += F.G) { const int b = wi >> 5, g = (wi >> 4) & 1, x = wi & 15;
#pragma unroll 1
        for (int u = 0; u < 2; ++u) m2_nsa_unit(F, b, g, u ? x : 31 - x); }
#endif
#ifndef NO_SCAN
    for (int rep = 0; rep < REP_SCAN; ++rep)
    for (int k = gw; k < 2048; k += NGW) { const int wi = k >> 3; if ((wi & 15) < 8) m2_scan(F, (((wi >> 4) * 8 + (wi & 15)) * 8) + (k & 7)); }
#endif
    GRID_BAR();
#ifndef NO_GLA3
    for (int rep = 0; rep < REP_M13; ++rep)
    for (int it = F.vcu; it < 1024; it += F.G) m3_gla_out(F, it);
#endif
    GRID_BAR();
#ifndef NO_GEMM
    { pg8::Gemm g{F.MIX, F.WOUT, M, D, D}; pg8::StaticOrder S; S.init(M, D, F.G, (int)blockIdx.x);
      pg8::EpiResid<true> E{F.out, F.out, F.XB, F.SSQB, 1.0f};
      pg8::gemm_phase<pg8::EpiResid<true>, pg8::StaticOrder, true, true>(F.lds + RING_OFF, g, S, E); }
#endif
    GRID_BAR();
#ifndef NO_GEMM
    { pg8::Gemm g{F.XB, F.W2GU, M, 2 * FF, D}; pg8::StaticOrder S; S.init(M, 2 * FF, F.G, (int)blockIdx.x);
      pg8::EpiSwiGLU<16> E{F.H, FF, F.SSQB};
      pg8::gemm_phase<pg8::EpiSwiGLU<16>, pg8::StaticOrder, true, true>(F.lds + RING_OFF, g, S, E); }
#endif
    GRID_BAR();
#ifndef NO_GEMM
    { pg8::Gemm g{F.H, F.W2D, M, D, FF}; pg8::StaticOrder S; S.init(M, D, F.G, (int)blockIdx.x);
      pg8::EpiResid<false> E{F.out, F.out, nullptr, nullptr, 0.5f};
      pg8::gemm_phase<pg8::EpiResid<false>, pg8::StaticOrder, true, true>(F.lds + RING_OFF, g, S, E); }
#endif
    GRID_BAR();
#ifndef NO_P8
    p8_final_norm(F);
#endif
}

extern "C" void kernel_launch(void* const* d_in, const int* in_sizes, int n_in, void* d_out, int out_size, void* d_ws, size_t ws_size, hipStream_t stream) {
    static int grid = 0;
    if (grid == 0) {
        if (n_in != 22 || in_sizes[0] != M * D || out_size != M * D || ws_size < WS_END) { fprintf(stderr, "kernel_launch: unexpected shapes (n_in %d, in0 %d, out %d, ws %zu); nothing launched\n", n_in, n_in > 0 ? in_sizes[0] : -1, out_size, ws_size); grid = -1; return; }
        int dev = 0, cus = 0;
        if (hipGetDevice(&dev) != hipSuccess || hipDeviceGetAttribute(&cus, hipDeviceAttributeMultiprocessorCount, dev) != hipSuccess) { fprintf(stderr, "kernel_launch: device query failed\n"); grid = -1; return; }
        if (hipFuncSetAttribute((const void*)hybrid_fwd, hipFuncAttributeMaxDynamicSharedMemorySize, LDS_BYTES) != hipSuccess) { fprintf(stderr, "kernel_launch: hipFuncSetAttribute failed\n"); grid = -1; return; }
        (void)hipGetLastError();
        grid = cus;
    }
    if (grid < 0) return;
    if (hipMemsetAsync((char*)d_ws + WS_CTL, 0, CTL_ZERO_BYTES, stream) != hipSuccess) { fprintf(stderr, "kernel_launch: hipMemsetAsync failed\n"); return; }
    Args a{};
    for (int i = 0; i < 22; ++i) a.in[i] = (const float*)d_in[i];
    a.out = (float*)d_out; a.ws = (unsigned char*)d_ws;
    hipLaunchKernelGGL(hybrid_fwd, dim3(grid), dim3(NWAVES * 64), LDS_BYTES, stream, a);
}
```

```cpp
#include <hip/hip_runtime.h>
#include <cstdio>
#include <cstdint>
namespace pg8 {
#define PG8_LAS __attribute__((address_space(3)))
typedef unsigned short bf16_t;
typedef short bf16x8 __attribute__((ext_vector_type(8)));
typedef float f32x4 __attribute__((ext_vector_type(4)));
typedef unsigned u32x4 __attribute__((ext_vector_type(4)));
constexpr int BM = 256, BK = 64, HALF = 128, HTB = HALF * BK * 2  , STAGE_BYTES = 8 * HTB, NXCD = 8, WGM = 8;

__host__ __device__ __forceinline__ int lds_byte(int r, int c) { const int st = (r >> 4) * 2 + (c >> 5), rr = r & 15, cc = c & 31, ob = rr * 64 + cc * 2; return st * 1024 + (ob ^ (((ob >> 9) & 1) << 5)); }
__host__ __device__ __forceinline__ void stage_rc(int b, int& R, int& C) { const int st = b / 1024, sb = b % 1024, swz = sb ^ (((sb >> 9) & 1) << 5); R = (st >> 1) * 16 + swz / 64; C = (st & 1) * 32 + (swz % 64) / 2; }
__host__ __device__ __forceinline__ int perm32(int rho) { const int n = rho >> 4, i = rho & 15; return 8 * (i >> 2) + 4 * n + (i & 3); }

struct Unit { int pm, pn; };
struct Gemm { const bf16_t* A; const bf16_t* Bt; int M, N, K; };

struct StaticOrder {
    int nM, nN, nwg, G, c;
    __host__ __device__ void init(int M, int N, int G_, int c_) { nM = M / BM; nN = N / BM; nwg = nM * nN; G = G_; c = c_; }
    __host__ __device__ bool next(int i, Unit& u) const {
        const long L = (long)i * G + c; if (L >= nwg) return false;
        int wgid = (int)L; { const int q = nwg / NXCD, r = nwg % NXCD, xcd = wgid % NXCD, off = wgid / NXCD; wgid = (xcd < r ? xcd * (q + 1) : r * (q + 1) + (xcd - r) * q) + off; }
        const int nig = WGM * nN, gid = wgid / nig, fm = gid * WGM, gsz = (nM - fm) < WGM ? (nM - fm) : WGM;
        u.pm = fm + ((wgid % nig) % gsz); u.pn = (wgid % nig) / gsz; return true;
    }
    __device__ __forceinline__ void a_ready(const Unit&) const {}
    __device__ __forceinline__ void done(const Unit&) const {}
};
__device__ __forceinline__ unsigned cvt_pk_bf16(float lo, float hi) { unsigned r; asm volatile("v_cvt_pk_bf16_f32 %0, %1, %2" : "=v"(r) : "v"(lo), "v"(hi)); return r; }
typedef float f32x2 __attribute__((ext_vector_type(2)));
typedef unsigned u32x2 __attribute__((ext_vector_type(2)));
constexpr float RMS_EPS = 1e-6f;
template <int NPARTS> __device__ __forceinline__ float row_rstd(const float* ssq, int row) {
    float s;
    if (NPARTS == 1) s = ssq[row];
    else { const f32x4* p = (const f32x4*)(ssq + (size_t)row * 16); const f32x4 a = p[0], b = p[1], c = p[2], d = p[3]; const f32x4 t = (a + b) + (c + d); s = (t[0] + t[1]) + (t[2] + t[3]); }
    return __builtin_amdgcn_rsqf(s * (1.0f / 1024.0f) + RMS_EPS);
}
__device__ __forceinline__ float silu_f(float x) { return x * __builtin_amdgcn_rcpf(1.0f + __builtin_amdgcn_exp2f(-1.4426950408889634f * x)); }
template <int NPARTS> struct EpiSwiGLU {
    static constexpr bool PERM = true, AFTER_DRAIN = false;
    bf16_t* H; int ldh; const float* ssq;
    __device__ __forceinline__ void operator()(const f32x4 (&acc)[2][2][4][2], const Unit& u, int wr, int wc, int fr, int fq) const {
        const int row0 = u.pm * BM + wr * 64 + fr, col0 = u.pn * 128 + wc * 32 + 8 * fq;
#pragma unroll
        for (int ai = 0; ai < 2; ++ai)
#pragma unroll
            for (int m = 0; m < 4; ++m) { const int row = row0 + ai * HALF + m * 16; const float rs = row_rstd<NPARTS>(ssq, row);
                const f32x4 g0 = acc[ai][0][m][0] * rs, g1 = acc[ai][0][m][1] * rs, u0 = acc[ai][1][m][0] * rs, u1 = acc[ai][1][m][1] * rs;
                u32x4 w;
                w.x = cvt_pk_bf16(silu_f(g0[0]) * u0[0], silu_f(g0[1]) * u0[1]); w.y = cvt_pk_bf16(silu_f(g0[2]) * u0[2], silu_f(g0[3]) * u0[3]);
                w.z = cvt_pk_bf16(silu_f(g1[0]) * u1[0], silu_f(g1[1]) * u1[1]); w.w = cvt_pk_bf16(silu_f(g1[2]) * u1[2], silu_f(g1[3]) * u1[3]);
                *(u32x4*)(H + (size_t)row * ldh + col0) = w; if (m & 1) asm volatile("" ::: "memory"); }
    }
};
template <int NPARTS> struct EpiProj {
    static constexpr bool PERM = true, AFTER_DRAIN = false;
    bf16_t* O; int ldc; const float* ssq;
    __device__ __forceinline__ void operator()(const f32x4 (&acc)[2][2][4][2], const Unit& u, int wr, int wc, int fr, int fq) const {
        const int row0 = u.pm * BM + wr * 64 + fr, col0 = u.pn * BM + wc * 32 + 8 * fq;
#pragma unroll
        for (int ai = 0; ai < 2; ++ai)
#pragma unroll
            for (int m = 0; m < 4; ++m) { const int row = row0 + ai * HALF + m * 16; const float rs = row_rstd<NPARTS>(ssq, row);
#pragma unroll
                for (int bj = 0; bj < 2; ++bj) { const f32x4 v0 = acc[ai][bj][m][0] * rs, v1 = acc[ai][bj][m][1] * rs; u32x4 w;
                    w.x = cvt_pk_bf16(v0[0], v0[1]); w.y = cvt_pk_bf16(v0[2], v0[3]); w.z = cvt_pk_bf16(v1[0], v1[1]); w.w = cvt_pk_bf16(v1[2], v1[3]);
                    *(u32x4*)(O + (size_t)row * ldc + col0 + bj * HALF) = w; } if (m & 1) asm volatile("" ::: "memory"); }
    }
};
template <bool WB> struct EpiResid {
    static constexpr bool PERM = false, AFTER_DRAIN = false;
    const float* rin; float* out; bf16_t* xb; float* ssqp; float alpha;
    __device__ __forceinline__ void operator()(const f32x4 (&acc)[2][2][4][2], const Unit& u, int wr, int wc, int fr, int fq) const {
        const int row0 = u.pm * BM + wr * 64 + fr, col0 = u.pn * BM + wc * 32 + 4 * fq;
#pragma unroll
        for (int ai = 0; ai < 2; ++ai)
#pragma unroll
            for (int m = 0; m < 4; ++m) { const int row = row0 + ai * HALF + m * 16; float ss = 0.f;
#pragma unroll
                for (int bj = 0; bj < 2; ++bj)
#pragma unroll
                    for (int n = 0; n < 2; ++n) { const size_t off = (size_t)row * 1024 + col0 + bj * HALF + n * 16;
                        const f32x4 o = *(const f32x4*)(rin + off) + acc[ai][bj][m][n] * alpha; *(f32x4*)(out + off) = o;
                        if (WB) { u32x2 w; w.x = cvt_pk_bf16(o[0], o[1]); w.y = cvt_pk_bf16(o[2], o[3]); *(u32x2*)(xb + off) = w; ss += (o[0] * o[0] + o[1] * o[1]) + (o[2] * o[2] + o[3] * o[3]); } }
                if (WB) { ss += __shfl_xor(ss, 16); ss += __shfl_xor(ss, 32); if (fq == 0) ssqp[(size_t)row * 16 + u.pn * 4 + wc] = ss; } asm volatile("" ::: "memory"); }
    }
};
template <class Epi, class Sched, bool ALIGN_EPI = false, bool SP2 = false>
__device__ __forceinline__ void gemm_phase(PG8_LAS unsigned char* lds, const Gemm g, const Sched& S, const Epi& E) {
    int tid_ = threadIdx.x; asm volatile("" : "+v"(tid_)); const int tid = tid_, wid = __builtin_amdgcn_readfirstlane(tid >> 6), lane = tid & 63, wr = wid >> 2, wc = wid & 3, fr = lane & 15, fq = lane >> 4;
    const int K = g.K, nt = K / BK;
    unsigned voffA[2], voffB[2];
#pragma unroll
    for (int i = 0; i < 2; ++i) { int R, C; stage_rc(tid * 16 + i * 8192, R, C); const int Rb = Epi::PERM ? ((R & ~31) + perm32(R & 31)) : R;
        voffA[i] = (unsigned)(R * K + C) * 2u; voffB[i] = (unsigned)(Rb * K + C) * 2u; }
    const size_t kstep = (size_t)(BK * 2);
    const size_t hstep = (size_t)HALF * K * 2;
    const size_t tstep = 2 * hstep;
    const unsigned ldsw = (unsigned)wid * 1024u;
    const int aoff = lds_byte(wr * 64 + fr, fq * 8), boff = lds_byte(wc * 32 + fr, fq * 8);
#define PG8_SA(b, h) (((b) * 2 + (h)) * HTB)
#define PG8_SB(b, h) ((4 + (b) * 2 + (h)) * HTB)
#define PG8_STAGE(bufoff, gbase, voff) do { _Pragma("unroll") for (int _i = 0; _i < 2; ++_i) \
        __builtin_amdgcn_global_load_lds((const unsigned*)((const char*)(gbase) + (voff)[_i]), (PG8_LAS unsigned*)(lds + (bufoff) + ldsw + _i * 8192), 16, 0, 0); } while (0)
#define PG8_LDA(dst, b, h) do { _Pragma("unroll") for (int m = 0; m < 4; ++m) _Pragma("unroll") for (int k = 0; k < 2; ++k) dst[m][k] = *(const PG8_LAS bf16x8*)(lds + PG8_SA(b, h) + aoff + m * 2048 + k * 1024); } while (0)
#define PG8_LDB(dst, b, h) do { _Pragma("unroll") for (int n = 0; n < 2; ++n) _Pragma("unroll") for (int k = 0; k < 2; ++k) dst[n][k] = *(const PG8_LAS bf16x8*)(lds + PG8_SB(b, h) + boff + n * 2048 + k * 1024); } while (0)
#define PG8_MMA(ai, bj, At, Bt) do { __builtin_amdgcn_s_setprio(1); _Pragma("unroll") for (int m = 0; m < 4; ++m) _Pragma("unroll") for (int n = 0; n < 2; ++n) _Pragma("unroll") for (int k = 0; k < 2; ++k) \
        acc[ai][bj][m][n] = __builtin_amdgcn_mfma_f32_16x16x32_bf16(Bt[n][k], At[m][k], acc[ai][bj][m][n], 0, 0, 0); __builtin_amdgcn_s_setprio(0); } while (0)
#define PG8_WAIT_V(n) asm volatile("s_waitcnt vmcnt(" #n ")" ::: "memory")
#define PG8_WAIT_L(n) asm volatile("s_waitcnt lgkmcnt(" #n ")" ::: "memory")
#define PG8_BAR __builtin_amdgcn_s_barrier()
#define PG8_SCHED __builtin_amdgcn_sched_barrier(0)
    Unit cur, nxt; int ui = 0;
    if (!S.next(0, cur)) return;
    f32x4 acc[2][2][4][2];
#pragma unroll
    for (int a = 0; a < 2; ++a)
#pragma unroll
        for (int b = 0; b < 2; ++b)
#pragma unroll
            for (int m = 0; m < 4; ++m)
#pragma unroll
                for (int n = 0; n < 2; ++n) acc[a][b][m][n] = (f32x4){0.f, 0.f, 0.f, 0.f};
    bf16x8 At[4][2], B0[2][2], B1[2][2];
    const char* cA = (const char*)g.A + (size_t)cur.pm * tstep; const char* cB = (const char*)g.Bt + (size_t)cur.pn * tstep;
    S.a_ready(cur);
    if constexpr (SP2) {
        PG8_STAGE(PG8_SB(0, 0), cB, voffB); PG8_STAGE(PG8_SB(0, 1), cB + hstep, voffB); PG8_STAGE(PG8_SA(0, 0), cA, voffA); PG8_STAGE(PG8_SA(0, 1), cA + hstep, voffA);
        if (wr == 1) PG8_BAR;
        PG8_WAIT_V(2); PG8_BAR;
        PG8_STAGE(PG8_SB(1, 0), cB + kstep, voffB); PG8_STAGE(PG8_SA(1, 0), cA + kstep, voffA); PG8_STAGE(PG8_SB(1, 1), cB + hstep + kstep, voffB);
        PG8_WAIT_V(6); PG8_BAR;
    } else {
        PG8_STAGE(PG8_SB(0, 0), cB, voffB); PG8_STAGE(PG8_SA(0, 0), cA, voffA); PG8_STAGE(PG8_SB(0, 1), cB + hstep, voffB); PG8_STAGE(PG8_SA(0, 1), cA + hstep, voffA);
        if (wr == 1) PG8_BAR;
        PG8_WAIT_V(4); PG8_BAR;
        PG8_STAGE(PG8_SB(1, 0), cB + kstep, voffB); PG8_STAGE(PG8_SA(1, 0), cA + kstep, voffA); PG8_STAGE(PG8_SB(1, 1), cB + hstep + kstep, voffB);
        PG8_WAIT_V(6); PG8_BAR;
    }
    for (;;) {
        const bool has_next = S.next(ui + 1, nxt);
        const char* nA = has_next ? (const char*)g.A + (size_t)nxt.pm * tstep : cA; const char* nB = has_next ? (const char*)g.Bt + (size_t)nxt.pn * tstep : cB;
        for (int t = 0; t < nt; t += 2) {
            const bool last = (t == nt - 2);
            const char* a1 = cA + (size_t)(t + 1) * kstep;
            const char* a2 = last ? nA : cA + (size_t)(t + 2) * kstep; const char* b2 = last ? nB : cB + (size_t)(t + 2) * kstep;
            const char* a3 = a2 + kstep; const char* b3 = b2 + kstep;
            if (last && has_next) S.a_ready(nxt);
            if constexpr (SP2) {
            PG8_LDB(B0, 0, 0); PG8_LDB(B1, 0, 1); PG8_SCHED; PG8_LDA(At, 0, 0); PG8_STAGE(PG8_SA(1, 1), a1 + hstep, voffA);
            PG8_WAIT_V(8); PG8_WAIT_L(0); PG8_BAR; PG8_MMA(0, 0, At, B0); PG8_MMA(0, 1, At, B1); PG8_BAR; PG8_SCHED;
            PG8_LDA(At, 0, 1); PG8_STAGE(PG8_SB(0, 0), b2, voffB); PG8_STAGE(PG8_SB(0, 1), b2 + hstep, voffB); PG8_STAGE(PG8_SA(0, 0), a2, voffA);
            PG8_WAIT_V(8); PG8_WAIT_L(0); PG8_BAR; PG8_MMA(1, 0, At, B0); PG8_MMA(1, 1, At, B1); PG8_BAR; PG8_SCHED;
            PG8_LDB(B0, 1, 0); PG8_LDB(B1, 1, 1); PG8_SCHED; PG8_LDA(At, 1, 0); PG8_STAGE(PG8_SA(0, 1), a2 + hstep, voffA);
            PG8_WAIT_V(8); PG8_WAIT_L(0); PG8_BAR; PG8_MMA(0, 0, At, B0); PG8_MMA(0, 1, At, B1); PG8_BAR; PG8_SCHED;
            PG8_LDA(At, 1, 1); PG8_STAGE(PG8_SB(1, 0), b3, voffB); PG8_STAGE(PG8_SB(1, 1), b3 + hstep, voffB); PG8_STAGE(PG8_SA(1, 0), a3, voffA);
            PG8_WAIT_V(8); PG8_WAIT_L(0); PG8_BAR; PG8_MMA(1, 0, At, B0); PG8_MMA(1, 1, At, B1); PG8_BAR; PG8_SCHED;
            } else {
            PG8_LDB(B0, 0, 0); PG8_SCHED; PG8_LDA(At, 0, 0); PG8_STAGE(PG8_SA(1, 1), a1 + hstep, voffA);
            PG8_WAIT_L(8); PG8_BAR; PG8_WAIT_L(0); PG8_MMA(0, 0, At, B0); PG8_BAR; PG8_SCHED;
            PG8_LDB(B1, 0, 1); PG8_STAGE(PG8_SB(0, 0), b2, voffB);
            PG8_BAR; PG8_WAIT_L(0); PG8_MMA(0, 1, At, B1); PG8_BAR;
            PG8_LDA(At, 0, 1); PG8_STAGE(PG8_SA(0, 0), a2, voffA);
            PG8_BAR; PG8_WAIT_L(0); PG8_MMA(1, 0, At, B0); PG8_BAR; PG8_SCHED;
            PG8_STAGE(PG8_SB(0, 1), b2 + hstep, voffB);
            PG8_WAIT_V(6); PG8_BAR; PG8_MMA(1, 1, At, B1); PG8_BAR;
            PG8_LDB(B0, 1, 0); PG8_SCHED; PG8_LDA(At, 1, 0); PG8_STAGE(PG8_SA(0, 1), a2 + hstep, voffA);
            PG8_WAIT_L(8); PG8_BAR; PG8_WAIT_L(0); PG8_MMA(0, 0, At, B0); PG8_BAR; PG8_SCHED;
            PG8_LDB(B1, 1, 1); PG8_STAGE(PG8_SB(1, 0), b3, voffB);
            PG8_BAR; PG8_WAIT_L(0); PG8_MMA(0, 1, At, B1); PG8_BAR;
            PG8_LDA(At, 1, 1); PG8_STAGE(PG8_SA(1, 0), a3, voffA);
            PG8_BAR; PG8_WAIT_L(0); PG8_MMA(1, 0, At, B0); PG8_BAR; PG8_SCHED;
            PG8_STAGE(PG8_SB(1, 1), b3 + hstep, voffB);
            PG8_WAIT_V(6); PG8_BAR; PG8_MMA(1, 1, At, B1); PG8_BAR;
            }
        }
        if constexpr (ALIGN_EPI) { if (wr == 0) PG8_BAR; }
        if constexpr (!Epi::AFTER_DRAIN) { E(acc, cur, wr, wc, fr, fq); S.done(cur); }
        if (!has_next) break;
#pragma unroll
        for (int a = 0; a < 2; ++a)
#pragma unroll
            for (int b = 0; b < 2; ++b)
#pragma unroll
                for (int m = 0; m < 4; ++m)
#pragma unroll
                    for (int n = 0; n < 2; ++n) acc[a][b][m][n] = (f32x4){0.f, 0.f, 0.f, 0.f};
        cur = nxt; cA = nA; cB = nB; ++ui;
        if constexpr (ALIGN_EPI) { if (wr == 1) PG8_BAR; }
    }
    PG8_WAIT_V(0);
    if constexpr (!ALIGN_EPI) { if (wr == 0) PG8_BAR; }
    PG8_BAR;
    if constexpr (Epi::AFTER_DRAIN) { E.fused(acc, cur, wr, wc, fr, fq, lds, wid, lane); S.done(cur); }
#undef PG8_SA
#undef PG8_SB
#undef PG8_STAGE
#undef PG8_LDA
#undef PG8_LDB
#undef PG8_MMA
#undef PG8_WAIT_V
#undef PG8_WAIT_L
#undef PG8_BAR
#undef PG8_SCHED
}
}

#define GAS __attribute__((address_space(1)))
#define LAS __attribute__((address_space(3)))
typedef unsigned short bf16;
typedef unsigned v4u __attribute__((ext_vector_type(4)));
typedef float f32x4 __attribute__((ext_vector_type(4)));
typedef short bf16x8 __attribute__((ext_vector_type(8)));
typedef GAS unsigned gu32;
typedef GAS unsigned long long gu64;
#define RLX_AGENT __ATOMIC_RELAXED, __HIP_MEMORY_SCOPE_AGENT
#define LDS_WAIT() asm volatile("s_waitcnt lgkmcnt(0)" ::: "memory")
#define VM_WAIT() asm volatile("s_waitcnt vmcnt(0)" ::: "memory")
__device__ __forceinline__ unsigned long long rt() { return __builtin_amdgcn_s_memrealtime(); }
__device__ __forceinline__ unsigned f2bf(float f) { unsigned u = __builtin_bit_cast(unsigned, f); return (u + 0x7fffu + ((u >> 16) & 1u)) >> 16; }
__device__ __forceinline__ unsigned pk2(float lo, float hi) { return f2bf(lo) | (f2bf(hi) << 16); }
#define XB_TMO      128
#define XB_XCNT(j)  (256  + 64 * (j))
#define XB_XSUB(j)  (1280 + 64 * (j))
#define XB_XGEN(j)  (2304 + 64 * (j))
#define XB_TOP      3328
#define XB_TOPGEN   3392
#define XCD_BAR_WORDS 3456
#define XB_SPIN_CAP (1u << 18)

__device__ __forceinline__ unsigned xb_ld(unsigned* p)              { return __hip_atomic_load(p, __ATOMIC_RELAXED, __HIP_MEMORY_SCOPE_AGENT); }
__device__ __forceinline__ unsigned xb_add(unsigned* p, unsigned v) { return __hip_atomic_fetch_add(p, v, __ATOMIC_RELAXED, __HIP_MEMORY_SCOPE_AGENT); }
__device__ __forceinline__ unsigned xb_xcc_id() { return (unsigned)__builtin_amdgcn_s_getreg((3 << 11) | 20) & 0xFu; }
#define XB_SPIN(cond, bar) do { unsigned _sp = 0; while (cond) { __builtin_amdgcn_s_sleep(1); \
    if ((++_sp & 255u) == 0u) { if (xb_ld(&(bar)[XB_TMO])) break; if (_sp > XB_SPIN_CAP) { atomicAdd(&(bar)[XB_TMO], 1u); break; } } } } while (0)

struct XcdBarrier {
    unsigned* bar; unsigned x;
    volatile LAS unsigned* st;
};

__device__ __forceinline__ XcdBarrier xcd_barrier_post(unsigned* bar, volatile LAS unsigned* st) {
    XcdBarrier b; b.bar = bar; b.x = xb_xcc_id(); b.st = st;
    if (threadIdx.x == 0) (void)xb_add(&bar[XB_XCNT(b.x)], 1u);
    return b;
}
__device__ __forceinline__ void xcd_barrier_complete(unsigned* bar, unsigned x, unsigned& nloc, unsigned& nx) {
    const unsigned G = gridDim.x * gridDim.y * gridDim.z;
    unsigned sum, cnt, mine, sp = 0u;
    for (;;) {
        sum = 0u; cnt = 0u; mine = 0u;
#pragma unroll
        for (unsigned j = 0; j < 16; ++j) { const unsigned c = xb_ld(&bar[XB_XCNT(j)]); sum += c; cnt += (c > 0u) ? 1u : 0u; mine = (j == x) ? c : mine; }
        if (sum == G) break;
        __builtin_amdgcn_s_sleep(1);
        if ((++sp & 255u) == 0u) { if (xb_ld(&bar[XB_TMO])) break; if (sp > XB_SPIN_CAP) { atomicAdd(&bar[XB_TMO], 1u); break; } }
    }
    nloc = mine > 0u ? mine : 1u; nx = cnt > 0u ? cnt : 1u;
}

__device__ __forceinline__ void xcd_barrier(const XcdBarrier& b) {
    asm volatile("s_waitcnt vmcnt(0)" ::: "memory");
    __syncthreads();
    if (threadIdx.x == 0) {
        unsigned* bar = b.bar;
        __builtin_amdgcn_s_waitcnt(0);
        unsigned nloc = b.st[0], nx = b.st[1];
        if (nloc == 0u) { xcd_barrier_complete(bar, b.x, nloc, nx); b.st[0] = nloc; b.st[1] = nx; }
        const unsigned old = xb_add(&bar[XB_XSUB(b.x)], 1u);
        const unsigned gen = old / nloc;
        if (old + 1u == (gen + 1u) * nloc) {
            __builtin_amdgcn_fence(__ATOMIC_RELEASE, "agent");
            asm volatile("s_waitcnt vmcnt(0)" ::: "memory");
            const unsigned og = xb_add(&bar[XB_TOP], 1u);
            const unsigned tg = og / nx;
            if (og + 1u == (tg + 1u) * nx) xb_add(&bar[XB_TOPGEN], 1u);
            else XB_SPIN(xb_ld(&bar[XB_TOPGEN]) == tg, bar);
            __builtin_amdgcn_fence(__ATOMIC_ACQUIRE, "agent");
            xb_add(&bar[XB_XGEN(b.x)], 1u);
            asm volatile("s_waitcnt vmcnt(0)" ::: "memory");
        } else {
            XB_SPIN(xb_ld(&bar[XB_XGEN(b.x)]) == gen, bar);
            __builtin_amdgcn_fence(__ATOMIC_ACQUIRE, "agent");
            asm volatile("s_waitcnt vmcnt(0)" ::: "memory");
        }
    }
    __syncthreads();
}

constexpr int NWAVES = 8;
#ifndef REP_M2
#define REP_M2 1
#endif
#ifndef REP_M13
#define REP_M13 1
#endif
#ifndef REP_P0
#define REP_P0 1
#endif
#ifndef REP_P2
#define REP_P2 1
#endif
#ifndef REP_P3
#define REP_P3 1
#endif
#ifndef REP_BAR
#define REP_BAR 1
#endif
#ifndef REP_SCAN
#define REP_SCAN 1
#endif
#ifndef REP_P1
#define REP_P1 1
#endif
using pg8::RMS_EPS;
constexpr int BATCH = 8, T = 2048, D = 1024, FF = 2816, M = BATCH * T, NP = 3072;
constexpr int C_Q = 0, C_KC = 512, C_VC = 640, C_KS = 768, C_VS = 896, C_KW = 1024, C_VW = 1152, C_GQ = 1280, C_GK = 1536, C_GV = 1792, C_GR = 2304, C_GN = 2816, C_GA = 2840;
constexpr int SRC_NIN = 2856;
constexpr size_t MiB = 1u << 20;
constexpr size_t WS_CTL = 0, CTL_ZERO_BYTES = 1 * MiB;
constexpr size_t WS_W1GU = 1 * MiB, WS_W1D = 12 * MiB, WS_WIN = 18 * MiB, WS_WOUT = 24 * MiB, WS_W2GU = 26 * MiB, WS_W2D = 37 * MiB;
constexpr size_t WS_WC1K = 43 * MiB, WS_WC1V = 43 * MiB + 512 * 1024;
constexpr size_t WS_WC2K = 44 * MiB, WS_WC2V = 44 * MiB + 16384, WS_CBIAS = 44 * MiB + 32768  , WS_KC = 44 * MiB + 65536, WS_VTC = 44 * MiB + 65536 + 262144;
constexpr size_t WS_SSQ0 = 45 * MiB, WS_SSQA = 46 * MiB, WS_SSQB = 47 * MiB, WS_DEC = 48 * MiB;
constexpr size_t WS_XB = 50 * MiB, WS_KVT = WS_XB;
constexpr size_t WS_R = 82 * MiB;
constexpr size_t WS_MIX = 178 * MiB, WS_VTS = 210 * MiB, WS_VTW = 214 * MiB, WS_ST = 218 * MiB, WS_BG = 234 * MiB  , WS_END = 250 * MiB;
constexpr int CW_BAR = 4096;
constexpr int RING_OFF = 0, RING_BYTES = 131072, LDSCTL_OFF = RING_BYTES, MISC_OFF = LDSCTL_OFF + 320, LDS_BYTES = 147456;

typedef unsigned u32x2 __attribute__((ext_vector_type(2)));
typedef float f32x2_t __attribute__((ext_vector_type(2))); typedef __bf16 bf16x2_t __attribute__((ext_vector_type(2)));
__device__ __forceinline__ unsigned cvtpk(float lo, float hi) { f32x2_t v = {lo, hi}; bf16x2_t b = __builtin_convertvector(v, bf16x2_t); return __builtin_bit_cast(unsigned, b); }
__device__ __forceinline__ bf16 f2b(float x) { return (bf16)(cvtpk(x, 0.f) & 0xffffu); }
__device__ __forceinline__ float bf2f(bf16 h) { return __builtin_bit_cast(float, (unsigned)h << 16); }
__device__ __forceinline__ float blo(unsigned w) { return __builtin_bit_cast(float, w << 16); }
__device__ __forceinline__ float bhi(unsigned w) { return __builtin_bit_cast(float, w & 0xffff0000u); }
__device__ __forceinline__ float fexp(float x) { return __builtin_amdgcn_exp2f(x * 1.4426950408889634f); }
__device__ __forceinline__ bf16x8 pack8(f32x4 a, f32x4 b) { v4u w; w.x = cvtpk(a[0], a[1]); w.y = cvtpk(a[2], a[3]); w.z = cvtpk(b[0], b[1]); w.w = cvtpk(b[2], b[3]); return __builtin_bit_cast(bf16x8, w); }
__device__ __forceinline__ bf16x8 ld2x8(const bf16* p0, const bf16* p1) { const u32x2 a = *(const u32x2*)p0, b = *(const u32x2*)p1; v4u w; w.x = a.x; w.y = a.y; w.z = b.x; w.w = b.y; return __builtin_bit_cast(bf16x8, w); }
__device__ __forceinline__ bf16x8 ldb16(const void* ub, unsigned boff) { return *(const bf16x8*)((const char*)ub + boff); }
__device__ __forceinline__ bf16x8 ldb8x2(const void* ub, unsigned boff) { const u32x2 a = *(const u32x2*)((const char*)ub + boff), b = *(const u32x2*)((const char*)ub + boff + 32); v4u w; w.x = a.x; w.y = a.y; w.z = b.x; w.w = b.y; return __builtin_bit_cast(bf16x8, w); }
__device__ __forceinline__ float ldb_bf(const void* ub, unsigned boff) { return bf2f(*(const bf16*)((const char*)ub + boff)); }
#define OPAQUE(x) asm volatile("" : "+v"(x))
#define MFMA16(a, b, c) __builtin_amdgcn_mfma_f32_16x16x32_bf16((a), (b), (c), 0, 0, 0)
#define WAVE_LDS_FENCE() asm volatile("s_waitcnt lgkmcnt(0)" ::: "memory")

struct Frame {
    LAS unsigned char* lds;
    volatile LAS unsigned* MISC;
    gu32* ctl;
    int tid, lane, wave, vcu, G;
    const float* in[22];
    float* out;
    bf16 *W1GU, *W1D, *WIN, *WOUT, *W2GU, *W2D, *WC1K, *WC1V, *WC2K, *WC2V, *KC, *VTC, *XB, *H, *PROJ, *MIX, *VTS, *VTW, *ST;
    float *CBIAS, *SSQ0, *SSQA, *SSQB, *DEC, *KVT, *BG;
};

__device__ __forceinline__ float wave_sum(float v) {
#pragma unroll
    for (int o = 1; o < 64; o <<= 1) v += __shfl_xor(v, o);
    return v;
}

__device__ __forceinline__ int win_src_col(int n) { return n < 1280 ? n : (n < 2816 ? n + 24 : (n < 2840 ? n - 1536 : (n < 2856 ? n : -1))); }
__device__ __forceinline__ void p0_tr_item(const float* W, const float* W2, const float* gain, int K, int Nsrc, int mode, bf16* WT, LAS float* scr, int kb, int nb, int lane) {
    const int k0 = 64 * kb, n0 = 32 * nb, nd = n0 + (lane & 31);
    const float* src = W; int sc = nd;
    if (mode == 1) { const int tile = nd >> 8, c = nd & 255; if (c >= 128) { src = W2; sc = tile * 128 + c - 128; } else sc = tile * 128 + c; }
    else if (mode == 2) sc = win_src_col(nd);
#pragma unroll 8
    for (int i = 0; i < 32; ++i) { const int kk = 2 * i + (lane >> 5); float v = 0.f; if (sc >= 0) v = src[(size_t)(k0 + kk) * Nsrc + sc]; if (gain) v *= gain[k0 + kk]; scr[kk * 33 + (lane & 31)] = v; }
    LDS_WAIT(); asm volatile("" ::: "memory");
    const int c = lane & 7;
#pragma unroll
    for (int j = 0; j < 4; ++j) { const int n = (lane >> 3) + 8 * j; const LAS float* s = scr + (8 * c) * 33 + n;
        v4u o; o.x = pk2(s[0 * 33], s[1 * 33]); o.y = pk2(s[2 * 33], s[3 * 33]); o.z = pk2(s[4 * 33], s[5 * 33]); o.w = pk2(s[6 * 33], s[7 * 33]);
        *(GAS v4u*)(WT + (size_t)(n0 + n) * K + k0 + 8 * c) = o; }
    LDS_WAIT(); asm volatile("" ::: "memory");
}
__device__ __forceinline__ void p0_prologue(Frame& F) {
    LAS float* scr = (LAS float*)(F.lds + RING_OFF + F.wave * 16384);
    const int gw = F.vcu * NWAVES + F.wave, NGW = F.G * NWAVES;
    constexpr int I_GU = 16 * 176, I_DN = 44 * 32, I_IN = 16 * 96, I_OUT = 16 * 32, I_C1 = 32 * 4, I_C2 = 2 * 2;
    constexpr int NITEMS = 2 * I_GU + 2 * I_DN + I_IN + I_OUT + 2 * I_C1 + 2 * I_C2;
    for (int it = gw; it < NITEMS; it += NGW) {
        int r = it;
        if (r < I_GU) { p0_tr_item(F.in[2], F.in[3], F.in[1], 1024, FF, 1, F.W1GU, scr, r / 176, r % 176, F.lane); continue; } r -= I_GU;
        if (r < I_GU) { p0_tr_item(F.in[18], F.in[19], F.in[17], 1024, FF, 1, F.W2GU, scr, r / 176, r % 176, F.lane); continue; } r -= I_GU;
        if (r < I_DN) { p0_tr_item(F.in[4], nullptr, nullptr, FF, 1024, 0, F.W1D, scr, r / 32, r % 32, F.lane); continue; } r -= I_DN;
        if (r < I_DN) { p0_tr_item(F.in[20], nullptr, nullptr, FF, 1024, 0, F.W2D, scr, r / 32, r % 32, F.lane); continue; } r -= I_DN;
        if (r < I_IN) { p0_tr_item(F.in[6], nullptr, F.in[5], 1024, SRC_NIN, 2, F.WIN, scr, r / 96, r % 96, F.lane); continue; } r -= I_IN;
        if (r < I_OUT) { p0_tr_item(F.in[16], nullptr, nullptr, 1024, 1024, 0, F.WOUT, scr, r / 32, r % 32, F.lane); continue; } r -= I_OUT;
        if (r < I_C1) { p0_tr_item(F.in[8], nullptr, nullptr, 2048, 128, 0, F.WC1K, scr, r / 4, r % 4, F.lane); continue; } r -= I_C1;
        if (r < I_C1) { p0_tr_item(F.in[11], nullptr, nullptr, 2048, 128, 0, F.WC1V, scr, r / 4, r % 4, F.lane); continue; } r -= I_C1;
        if (r < I_C2) { p0_tr_item(F.in[9], nullptr, nullptr, 128, 64, 0, F.WC2K, scr, r / 2, r % 2, F.lane); continue; } r -= I_C2;
        p0_tr_item(F.in[12], nullptr, nullptr, 128, 64, 0, F.WC2V, scr, r / 2, r % 2, F.lane);
    }
    for (int m = gw; m < M; m += NGW) {
        const GAS f32x4* xr = (const GAS f32x4*)(F.in[0] + (size_t)m * D) + F.lane;
        f32x4 v[4]; float s = 0.f;
#pragma unroll
        for (int j = 0; j < 4; ++j) { v[j] = xr[64 * j]; s += (v[j].x * v[j].x + v[j].y * v[j].y) + (v[j].z * v[j].z + v[j].w * v[j].w); }
        s = wave_sum(s);
        if (F.lane == 0) F.SSQ0[m] = s;
        GAS unsigned long long* o8 = (GAS unsigned long long*)(F.XB + (size_t)m * D) + F.lane;
#pragma unroll
        for (int j = 0; j < 4; ++j) o8[64 * j] = (unsigned long long)cvtpk(v[j].x, v[j].y) | ((unsigned long long)cvtpk(v[j].z, v[j].w) << 32);
    }
    for (int it = gw; it < 64; it += NGW) {
        const int kv = it >> 5, ch = it & 31; const float* W = (kv ? F.in[11] : F.in[8]) + (size_t)ch * 64 * 128 + F.lane; const float* pe = (kv ? F.in[10] : F.in[7]) + ch * 64;
        float s0 = 0.f, s1 = 0.f;
#pragma unroll 16
        for (int k = 0; k < 64; ++k) { const float p = pe[k]; s0 += p * W[k * 128]; s1 += p * W[k * 128 + 64]; }
        F.CBIAS[(kv * 32 + ch) * 128 + F.lane] = s0; F.CBIAS[(kv * 32 + ch) * 128 + 64 + F.lane] = s1;
    }
}

__device__ __forceinline__ void m1_compress(Frame& F, int ci) {
    const int kv = ci >> 7, b = (ci >> 4) & 7, g = (ci >> 3) & 1, rg = ci & 7;
    const int lane = F.lane, q = lane & 15, gl = lane >> 4, w = F.wave;
    LAS float* red = (LAS float*)(F.lds + RING_OFF);
    LAS bf16* hidb = (LAS bf16*)(F.lds + RING_OFF + 65536);
    const bf16* W1 = kv ? F.WC1V : F.WC1K; const bf16* W2 = kv ? F.WC2V : F.WC2K;
    const int ccol = (kv ? C_VC : C_KC) + g * 64;
    f32x4 acc[8];
#pragma unroll
    for (int nt = 0; nt < 8; ++nt) acc[nt] = (f32x4){0.f, 0.f, 0.f, 0.f};
#pragma unroll
    for (int ks = 0; ks < 8; ++ks) {
        const int l = 4 * w + (ks >> 1), dbase = 32 * (ks & 1) + 8 * gl;
        int tok = 16 * (16 * rg + q) + l; tok = tok > T - 1 ? T - 1 : tok;
        const bf16x8 a = *(const bf16x8*)(F.PROJ + ((size_t)b * T + tok) * NP + ccol + dbase);
        const int kg = 64 * l + dbase;
#pragma unroll
        for (int nt = 0; nt < 8; ++nt) { const bf16x8 bw = *(const bf16x8*)(W1 + (size_t)(16 * nt + q) * 2048 + kg); acc[nt] = MFMA16(a, bw, acc[nt]); }
    }
#pragma unroll
    for (int nt = 0; nt < 8; ++nt)
#pragma unroll
        for (int reg = 0; reg < 4; ++reg) red[(w * 16 + 4 * gl + reg) * 128 + 16 * nt + q] = acc[nt][reg];
    __syncthreads();
    {
        const int idx = F.tid * 4, r = idx >> 7, n = idx & 127;
        f32x4 s = (f32x4){0.f, 0.f, 0.f, 0.f};
#pragma unroll 8
        for (int ch = 0; ch < 32; ++ch) s += *(const f32x4*)(F.CBIAS + (kv * 32 + ch) * 128 + n);
#pragma unroll
        for (int ww = 0; ww < 8; ++ww) s += *(const LAS f32x4*)(red + (ww * 16 + r) * 128 + n);
        float o[4];
#pragma unroll
        for (int i = 0; i < 4; ++i) { const float x = s[i]; const float u2 = 2.0f * 0.7978845608028654f * (x + 0.044715f * x * x * x);
            const float th = 1.0f - 2.0f * __builtin_amdgcn_rcpf(fexp(u2) + 1.0f); o[i] = 0.5f * x * (1.0f + th); }
        u32x2 pw; pw.x = cvtpk(o[0], o[1]); pw.y = cvtpk(o[2], o[3]);
        *(LAS u32x2*)(hidb + r * 136 + n) = pw;
    }
    __syncthreads();
    if (w < 4) {
        f32x4 a2 = (f32x4){0.f, 0.f, 0.f, 0.f};
#pragma unroll
        for (int ks = 0; ks < 4; ++ks) { const bf16x8 a = *(const LAS bf16x8*)(hidb + q * 136 + 32 * ks + 8 * gl);
            const bf16x8 bw = *(const bf16x8*)(W2 + (size_t)(16 * w + q) * 128 + 32 * ks + 8 * gl); a2 = MFMA16(a, bw, a2); }
        const int d = 16 * w + q;
#pragma unroll
        for (int reg = 0; reg < 4; ++reg) { const int i = 16 * rg + 4 * gl + reg; const bf16 val = (i <= 126) ? f2b(a2[reg]) : (bf16)0;
            if (kv == 0) F.KC[((size_t)(b * 2 + g) * 128 + i) * 64 + d] = val; else F.VTC[((size_t)(b * 2 + g) * 64 + d) * 128 + i] = val; }
    }
    __syncthreads();
}

__device__ __forceinline__ void gla_prep(Frame& F, int b, int h, int n, LAS float* bm, LAS float* seg) {
    const int tid = F.tid, d = tid & 63, sg = tid >> 6;
    const float* wa = F.in[13] + h * 64 + d;
    float w[16];
#pragma unroll
    for (int r = 0; r < 16; ++r) w[r] = wa[r * 256];
    const float ba = F.in[14][h * 64 + d];
    float c[8]; float run = 0.f;
#pragma unroll
    for (int i = 0; i < 8; ++i) {
        const size_t row = (size_t)b * T + 64 * n + 8 * sg + i;
        const bf16* gp = F.PROJ + row * NP + C_GA;
        const v4u g0 = *(const v4u*)gp, g1 = *(const v4u*)(gp + 8);
        float z = ba;
        z += blo(g0.x) * w[0] + bhi(g0.x) * w[1] + blo(g0.y) * w[2] + bhi(g0.y) * w[3] + blo(g0.z) * w[4] + bhi(g0.z) * w[5] + blo(g0.w) * w[6] + bhi(g0.w) * w[7];
        z += blo(g1.x) * w[8] + bhi(g1.x) * w[9] + blo(g1.y) * w[10] + bhi(g1.y) * w[11] + blo(g1.z) * w[12] + bhi(g1.z) * w[13] + blo(g1.w) * w[14] + bhi(g1.w) * w[15];
        const float ls = fminf(z, 0.f) - __logf(1.0f + __expf(-fabsf(z)));
        run += ls * (1.0f / 16.0f); c[i] = run;
    }
    seg[sg * 64 + d] = run; __syncthreads();
    float pre = 0.f;
#pragma unroll
    for (int s2 = 0; s2 < 7; ++s2) pre += (s2 < sg) ? seg[s2 * 64 + d] : 0.f;
#pragma unroll
    for (int i = 0; i < 8; ++i) bm[(8 * sg + i) * 65 + d] = pre + c[i];
    __syncthreads();
}
__device__ __forceinline__ void gla_load_vt(Frame& F, size_t row, int h, int j, int c8, LAS bf16* VTl) {
    const bf16* vp = F.PROJ + row * NP + C_GV + h * 128 + 16 * c8;
    const v4u v0 = *(const v4u*)vp, v1 = *(const v4u*)(vp + 8);
    LAS bf16* dst = VTl + (16 * c8) * 72 + j;
    dst[0 * 72] = (bf16)(v0.x & 0xffffu); dst[1 * 72] = (bf16)(v0.x >> 16); dst[2 * 72] = (bf16)(v0.y & 0xffffu); dst[3 * 72] = (bf16)(v0.y >> 16);
    dst[4 * 72] = (bf16)(v0.z & 0xffffu); dst[5 * 72] = (bf16)(v0.z >> 16); dst[6 * 72] = (bf16)(v0.w & 0xffffu); dst[7 * 72] = (bf16)(v0.w >> 16);
    dst[8 * 72] = (bf16)(v1.x & 0xffffu); dst[9 * 72] = (bf16)(v1.x >> 16); dst[10 * 72] = (bf16)(v1.y & 0xffffu); dst[11 * 72] = (bf16)(v1.y >> 16);
    dst[12 * 72] = (bf16)(v1.z & 0xffffu); dst[13 * 72] = (bf16)(v1.z >> 16); dst[14 * 72] = (bf16)(v1.w & 0xffffu); dst[15 * 72] = (bf16)(v1.w >> 16);
}
__device__ __forceinline__ void m1_gla_kv(Frame& F, int item) {
    const int n = item & 31, h = (item >> 5) & 3, b = item >> 7;
    const int lane = F.lane, q = lane & 15, gl = lane >> 4, w = F.wave, tid = F.tid;
    LAS float* bm = (LAS float*)(F.lds + RING_OFF); LAS float* seg = (LAS float*)(F.lds + RING_OFF + 16640);
    LAS bf16* KstT = (LAS bf16*)(F.lds + RING_OFF + 18688); LAS bf16* VTl = (LAS bf16*)(F.lds + RING_OFF + 27904);
    gla_prep(F, b, h, n, bm, seg);
    const int j = tid >> 3, c8 = tid & 7; const size_t row = (size_t)b * T + 64 * n + j;
    {
        const v4u kk = *(const v4u*)(F.PROJ + row * NP + C_GK + h * 64 + 8 * c8);
        float kf[8] = {blo(kk.x), bhi(kk.x), blo(kk.y), bhi(kk.y), blo(kk.z), bhi(kk.z), blo(kk.w), bhi(kk.w)};
#pragma unroll
        for (int i = 0; i < 8; ++i) { const int d = 8 * c8 + i; const float e = fexp(bm[63 * 65 + d] - bm[j * 65 + d]); KstT[d * 72 + j] = f2b(kf[i] * e); }
    }
    gla_load_vt(F, row, h, j, c8, VTl);
    __syncthreads();
#pragma unroll
    for (int dt = 0; dt < 4; ++dt) {
        f32x4 acc = (f32x4){0.f, 0.f, 0.f, 0.f};
#pragma unroll
        for (int ks = 0; ks < 2; ++ks) { const bf16x8 a = *(const LAS bf16x8*)(KstT + (16 * dt + q) * 72 + 32 * ks + 8 * gl);
            const bf16x8 bv = *(const LAS bf16x8*)(VTl + (16 * w + q) * 72 + 32 * ks + 8 * gl); acc = MFMA16(a, bv, acc); }
        *(f32x4*)(F.KVT + ((size_t)item * 128 + 16 * w + q) * 64 + 16 * dt + 4 * gl) = acc;
    }
    if (tid < 64) F.DEC[(size_t)item * 64 + tid] = fexp(bm[63 * 65 + tid]);
    __syncthreads();
}
typedef short v4i16_t __attribute__((ext_vector_type(4)));
__device__ __forceinline__ bf16x8 tr2(const LAS bf16* p0, const LAS bf16* p1) {
    const v4i16_t a = __builtin_amdgcn_ds_read_tr16_b64_v4i16((LAS v4i16_t*)p0), b = __builtin_amdgcn_ds_read_tr16_b64_v4i16((LAS v4i16_t*)p1);
    return (bf16x8){a[0], a[1], a[2], a[3], b[0], b[1], b[2], b[3]};
}
__device__ __forceinline__ float log_sig16(float z) { return (fminf(z, 0.f) - __logf(1.0f + __expf(-fabsf(z)))) * (1.0f / 16.0f); }
__device__ __forceinline__ void m1_gla_kv4(Frame& F, int bn) {
    const int b = bn >> 5, n = bn & 31;
    int tid = F.tid; OPAQUE(tid); const int lane = tid & 63, w = F.wave;
    LAS float* qtot = (LAS float*)(F.lds + RING_OFF);
    LAS bf16* KstL = (LAS bf16*)(F.lds + RING_OFF + 4096);
    LAS bf16* Vl = (LAS bf16*)(F.lds + RING_OFF + 4096 + 33792);
    const size_t row0 = (size_t)b * T + 64 * n;
    v4u vreg[8];
#pragma unroll
    for (int i = 0; i < 8; ++i) { const int id = tid + 512 * i; vreg[i] = *(const v4u*)(F.PROJ + (row0 + (id >> 6)) * NP + C_GV + 8 * (id & 63)); }
    const int cp = tid & 127, tq = tid >> 7, col = 2 * cp;
    float w0[16], w1[16];
#pragma unroll
    for (int r = 0; r < 16; ++r) { const f32x2_t ww = *(const f32x2_t*)(F.in[13] + r * 256 + col); w0[r] = ww.x; w1[r] = ww.y; }
    const f32x2_t bb = *(const f32x2_t*)(F.in[14] + col);
    float c0[16], c1[16]; float run0 = 0.f, run1 = 0.f;
#pragma unroll
    for (int i = 0; i < 16; ++i) {
        const bf16* gp = F.PROJ + (row0 + 16 * tq + i) * NP + C_GA;
        const v4u g0 = *(const v4u*)gp, g1 = *(const v4u*)(gp + 8);
        const float ga[16] = {blo(g0.x), bhi(g0.x), blo(g0.y), bhi(g0.y), blo(g0.z), bhi(g0.z), blo(g0.w), bhi(g0.w), blo(g1.x), bhi(g1.x), blo(g1.y), bhi(g1.y), blo(g1.z), bhi(g1.z), blo(g1.w), bhi(g1.w)};
        float z0 = bb.x, z1 = bb.y;
#pragma unroll
        for (int r = 0; r < 16; ++r) { z0 += ga[r] * w0[r]; z1 += ga[r] * w1[r]; }
        run0 += log_sig16(z0); run1 += log_sig16(z1); c0[i] = run0; c1[i] = run1;
    }
    *(LAS f32x2_t*)(qtot + tq * 256 + col) = (f32x2_t){run0, run1};
#pragma unroll
    for (int i = 0; i < 8; ++i) { const int id = tid + 512 * i; *(LAS v4u*)(Vl + (id >> 6) * 520 + 8 * (id & 63)) = vreg[i]; }
    __syncthreads();
    float pre0 = 0.f, pre1 = 0.f, tot0 = 0.f, tot1 = 0.f;
#pragma unroll
    for (int q2 = 0; q2 < 4; ++q2) { const f32x2_t a = *(const LAS f32x2_t*)(qtot + q2 * 256 + col); tot0 += a.x; tot1 += a.y; pre0 += (q2 < tq) ? a.x : 0.f; pre1 += (q2 < tq) ? a.y : 0.f; }
#pragma unroll
    for (int i = 0; i < 16; ++i) {
        const size_t row = row0 + 16 * tq + i; const float b0 = pre0 + c0[i], b1 = pre1 + c1[i];
        *(f32x2_t*)(F.BG + row * 256 + col) = (f32x2_t){b0, b1};
        const unsigned kk = *(const unsigned*)(F.PROJ + row * NP + C_GK + col);
        *(LAS unsigned*)(KstL + (16 * tq + i) * 264 + col) = cvtpk(blo(kk) * fexp(tot0 - b0), bhi(kk) * fexp(tot1 - b1));
    }
    if (tq == 0) *(f32x2_t*)(F.DEC + ((size_t)((b * 4 + (col >> 6)) * 32 + n)) * 64 + (col & 63)) = (f32x2_t){fexp(tot0), fexp(tot1)};
    __syncthreads();
    const int h = w >> 1, vh = w & 1, g = lane >> 4, il = lane & 15, qp = il >> 2, p = il & 3;
    f32x4 acc[4][4];
#pragma unroll
    for (int dt = 0; dt < 4; ++dt)
#pragma unroll
        for (int v4 = 0; v4 < 4; ++v4) acc[dt][v4] = (f32x4){0.f, 0.f, 0.f, 0.f};
#pragma unroll
    for (int ks = 0; ks < 2; ++ks) {
        bf16x8 af[4], bfr[4];
#pragma unroll
        for (int dt = 0; dt < 4; ++dt) { const LAS bf16* a0 = KstL + (32 * ks + 8 * g + qp) * 264 + h * 64 + 16 * dt + 4 * p; af[dt] = tr2(a0, a0 + 4 * 264); }
#pragma unroll
        for (int v4 = 0; v4 < 4; ++v4) { const LAS bf16* b0 = Vl + (32 * ks + 8 * g + qp) * 520 + h * 128 + 16 * (4 * vh + v4) + 4 * p; bfr[v4] = tr2(b0, b0 + 4 * 520); }
#pragma unroll
        for (int dt = 0; dt < 4; ++dt)
#pragma unroll
            for (int v4 = 0; v4 < 4; ++v4) acc[dt][v4] = MFMA16(af[dt], bfr[v4], acc[dt][v4]);
    }
    const size_t item_h = (size_t)(b * 4 + h) * 32 + n;
#pragma unroll
    for (int dt = 0; dt < 4; ++dt)
#pragma unroll
        for (int v4 = 0; v4 < 4; ++v4) *(f32x4*)(F.KVT + (item_h * 128 + 16 * (4 * vh + v4) + il) * 64 + 16 * dt + 4 * g) = acc[dt][v4];
    __syncthreads();
}
__device__ __forceinline__ void m3_gla_out2(Frame& F, int item) {
    const int hp = item & 1, bn = item >> 1, b = bn >> 5, n = bn & 31;
    int tid = F.tid; OPAQUE(tid); const int lane = tid & 63, w = F.wave;
    LAS bf16* Qin = (LAS bf16*)(F.lds + RING_OFF);
    LAS bf16* Kin = (LAS bf16*)(F.lds + RING_OFF + 18432);
    LAS bf16* Vl = (LAS bf16*)(F.lds + RING_OFF + 36864);
    const size_t row0 = (size_t)b * T + 64 * n;
    {
        const int j = tid >> 3, c8 = tid & 7; const size_t row = row0 + j;
#pragma unroll
        for (int hh = 0; hh < 2; ++hh) { const int hc = (2 * hp + hh) * 64 + 8 * c8;
            const v4u qq = *(const v4u*)(F.PROJ + row * NP + C_GQ + hc), kk = *(const v4u*)(F.PROJ + row * NP + C_GK + hc);
            const f32x4 ba = *(const f32x4*)(F.BG + row * 256 + hc), bc = *(const f32x4*)(F.BG + row * 256 + hc + 4);
            float qf[8] = {blo(qq.x), bhi(qq.x), blo(qq.y), bhi(qq.y), blo(qq.z), bhi(qq.z), blo(qq.w), bhi(qq.w)};
            float kf[8] = {blo(kk.x), bhi(kk.x), blo(kk.y), bhi(kk.y), blo(kk.z), bhi(kk.z), blo(kk.w), bhi(kk.w)};
            const float bv[8] = {ba[0], ba[1], ba[2], ba[3], bc[0], bc[1], bc[2], bc[3]};
#pragma unroll
            for (int i = 0; i < 8; ++i) { qf[i] = qf[i] * 0.125f * fexp(bv[i]); kf[i] = kf[i] * fexp(-bv[i]); }
            v4u pq, pk; pq.x = cvtpk(qf[0], qf[1]); pq.y = cvtpk(qf[2], qf[3]); pq.z = cvtpk(qf[4], qf[5]); pq.w = cvtpk(qf[6], qf[7]);
            pk.x = cvtpk(kf[0], kf[1]); pk.y = cvtpk(kf[2], kf[3]); pk.z = cvtpk(kf[4], kf[5]); pk.w = cvtpk(kf[6], kf[7]);
            *(LAS v4u*)(Qin + hh * 4608 + j * 72 + 8 * c8) = pq; *(LAS v4u*)(Kin + hh * 4608 + j * 72 + 8 * c8) = pk; }
#pragma unroll
        for (int i = 0; i < 4; ++i) { const int id = tid + 512 * i, hh = id >> 10, r = (id >> 4) & 63, ch = id & 15;
            *(LAS v4u*)(Vl + hh * 8704 + r * 136 + 8 * ch) = *(const v4u*)(F.PROJ + (row0 + r) * NP + C_GV + (2 * hp + hh) * 128 + 8 * ch); }
    }
    __syncthreads();
    const int hh = w >> 2, it = w & 3, h = 2 * hp + hh, g = lane >> 4, il = lane & 15, qp = il >> 2, p = il & 3;
    const LAS bf16* Qh = Qin + hh * 4608; const LAS bf16* Kh = Kin + hh * 4608; const LAS bf16* Vh = Vl + hh * 8704;
    const size_t item_h = (size_t)(b * 4 + h) * 32 + n;
    bf16x8 qb[2];
#pragma unroll
    for (int ks = 0; ks < 2; ++ks) qb[ks] = *(const LAS bf16x8*)(Qh + (16 * it + il) * 72 + 32 * ks + 8 * g);
    bf16x8 sf[8][2];
#pragma unroll
    for (int vt = 0; vt < 8; ++vt)
#pragma unroll
        for (int ks = 0; ks < 2; ++ks) sf[vt][ks] = *(const bf16x8*)(F.ST + (item_h * 128 + 16 * vt + il) * 64 + 32 * ks + 8 * g);
    f32x4 acc[8];
#pragma unroll
    for (int vt = 0; vt < 8; ++vt) acc[vt] = (f32x4){0.f, 0.f, 0.f, 0.f};
    const int iabs = 16 * it + il;
#pragma unroll
    for (int jp = 0; jp < 2; ++jp) {
        const int jt0 = 2 * jp, jt1 = 2 * jp + 1;
        if (jt0 <= it) {
            f32x4 c0 = (f32x4){0.f, 0.f, 0.f, 0.f}, c1 = (f32x4){0.f, 0.f, 0.f, 0.f};
#pragma unroll
            for (int ks = 0; ks < 2; ++ks) c0 = MFMA16(*(const LAS bf16x8*)(Kh + (16 * jt0 + il) * 72 + 32 * ks + 8 * g), qb[ks], c0);
            if (jt1 <= it) {
#pragma unroll
                for (int ks = 0; ks < 2; ++ks) c1 = MFMA16(*(const LAS bf16x8*)(Kh + (16 * jt1 + il) * 72 + 32 * ks + 8 * g), qb[ks], c1);
            }
#pragma unroll
            for (int reg = 0; reg < 4; ++reg) { if (16 * jt0 + 4 * g + reg > iabs) c0[reg] = 0.f; if (16 * jt1 + 4 * g + reg > iabs) c1[reg] = 0.f; }
            const bf16x8 pb = pack8(c0, c1);
#pragma unroll
            for (int vt = 0; vt < 8; ++vt) acc[vt] = MFMA16(tr2(Vh + (16 * jt0 + 4 * g + qp) * 136 + 16 * vt + 4 * p, Vh + (16 * jt1 + 4 * g + qp) * 136 + 16 * vt + 4 * p), pb, acc[vt]);
        }
    }
#pragma unroll
    for (int ks = 0; ks < 2; ++ks)
#pragma unroll
        for (int vt = 0; vt < 8; ++vt) acc[vt] = MFMA16(sf[vt][ks], qb[ks], acc[vt]);
    float ss = 0.f;
#pragma unroll
    for (int vt = 0; vt < 8; ++vt) ss += (acc[vt][0] * acc[vt][0] + acc[vt][1] * acc[vt][1]) + (acc[vt][2] * acc[vt][2] + acc[vt][3] * acc[vt][3]);
    ss += __shfl_xor(ss, 16); ss += __shfl_xor(ss, 32);
    const float rs = __builtin_amdgcn_rsqf(ss * (1.0f / 128.0f) + RMS_EPS);
    const size_t row = row0 + iabs;
#pragma unroll
    for (int vt = 0; vt < 8; ++vt) {
        const u32x2 grw = *(const u32x2*)(F.PROJ + row * NP + C_GR + h * 128 + 16 * vt + 4 * g);
        const f32x4 gg = *(const f32x4*)(F.in[15] + 16 * vt + 4 * g);
        const float gr[4] = {blo(grw.x), bhi(grw.x), blo(grw.y), bhi(grw.y)}; float o[4];
#pragma unroll
        for (int e = 0; e < 4; ++e) o[e] = acc[vt][e] * rs * gg[e] * (gr[e] * __builtin_amdgcn_rcpf(1.0f + fexp(-gr[e])));
        u32x2 wv; wv.x = cvtpk(o[0], o[1]); wv.y = cvtpk(o[2], o[3]);
        *(u32x2*)(F.MIX + row * 1024 + 512 + h * 128 + 16 * vt + 4 * g) = wv;
    }
    __syncthreads();
}
__device__ __forceinline__ void m1_transpose(Frame& F, int ti) {
    const int which = ti >> 9, rem = ti & 511, b = rem >> 6, g = (rem >> 5) & 1, tt = rem & 31;
    const bf16* src = F.PROJ + ((size_t)b * T + 64 * tt + F.lane) * NP + (which ? C_VW : C_VS) + g * 64;
    v4u x[8];
#pragma unroll
    for (int i = 0; i < 8; ++i) x[i] = *(const v4u*)(src + 8 * i);
    bf16* dst = (which ? F.VTW : F.VTS) + ((size_t)(b * 2 + g) * 64) * T + 64 * tt + F.lane;
#pragma unroll
    for (int d = 0; d < 64; ++d) { const unsigned wv = x[d >> 3][(d >> 1) & 3]; dst[(size_t)d * T] = (bf16)((d & 1) ? (wv >> 16) : (wv & 0xffffu)); }
}
__device__ __forceinline__ void m2_scan(Frame& F, int si) {
    const int bh = si >> 5, part = si & 31, qd = part * 64 + F.lane, v = qd >> 4, dq = qd & 15;
    f32x4 S = (f32x4){0.f, 0.f, 0.f, 0.f};
#pragma unroll 8
    for (int n = 0; n < 32; ++n) {
        const size_t item = (size_t)bh * 32 + n;
        const f32x4 kvv = *(const f32x4*)(F.KVT + (item * 128 + v) * 64 + 4 * dq);
        const f32x4 dc = *(const f32x4*)(F.DEC + item * 64 + 4 * dq);
        u32x2 wv; wv.x = cvtpk(S[0], S[1]); wv.y = cvtpk(S[2], S[3]);
        *(u32x2*)(F.ST + (item * 128 + v) * 64 + 4 * dq) = wv;
        S = S * dc + kvv;
    }
}
__device__ __forceinline__ void m3_gla_out(Frame& F, int item) {
    const int n = item & 31, h = (item >> 5) & 3, b = item >> 7;
    const int lane = F.lane, q = lane & 15, gl = lane >> 4, w = F.wave, tid = F.tid;
    LAS float* bm = (LAS float*)(F.lds + RING_OFF); LAS float* seg = (LAS float*)(F.lds + RING_OFF + 16640);
    LAS bf16* Qin = (LAS bf16*)(F.lds + RING_OFF + 18688); LAS bf16* Kin = (LAS bf16*)(F.lds + RING_OFF + 27904);
    LAS bf16* VTl = (LAS bf16*)(F.lds + RING_OFF + 37120); LAS bf16* Am = (LAS bf16*)(F.lds + RING_OFF + 55552);
    LAS float* ssqw = (LAS float*)(F.lds + RING_OFF + 64768);
    gla_prep(F, b, h, n, bm, seg);
    const int j = tid >> 3, c8 = tid & 7; const size_t row = (size_t)b * T + 64 * n + j;
    {
        const v4u qq = *(const v4u*)(F.PROJ + row * NP + C_GQ + h * 64 + 8 * c8);
        const v4u kk = *(const v4u*)(F.PROJ + row * NP + C_GK + h * 64 + 8 * c8);
        float qf[8] = {blo(qq.x), bhi(qq.x), blo(qq.y), bhi(qq.y), blo(qq.z), bhi(qq.z), blo(qq.w), bhi(qq.w)};
        float kf[8] = {blo(kk.x), bhi(kk.x), blo(kk.y), bhi(kk.y), blo(kk.z), bhi(kk.z), blo(kk.w), bhi(kk.w)};
#pragma unroll
        for (int i = 0; i < 8; ++i) { const float bb = bm[j * 65 + 8 * c8 + i]; qf[i] = qf[i] * 0.125f * fexp(bb); kf[i] = kf[i] * fexp(-bb); }
        v4u pq, pk; pq.x = cvtpk(qf[0], qf[1]); pq.y = cvtpk(qf[2], qf[3]); pq.z = cvtpk(qf[4], qf[5]); pq.w = cvtpk(qf[6], qf[7]);
        pk.x = cvtpk(kf[0], kf[1]); pk.y = cvtpk(kf[2], kf[3]); pk.z = cvtpk(kf[4], kf[5]); pk.w = cvtpk(kf[6], kf[7]);
        *(LAS v4u*)(Qin + j * 72 + 8 * c8) = pq; *(LAS v4u*)(Kin + j * 72 + 8 * c8) = pk;
    }
    gla_load_vt(F, row, h, j, c8, VTl);
    __syncthreads();
    {
        const int it = w >> 1;
#pragma unroll
        for (int jj = 0; jj < 2; ++jj) { const int jt = 2 * (w & 1) + jj; f32x4 a = (f32x4){0.f, 0.f, 0.f, 0.f};
            if (jt <= it) {
#pragma unroll
                for (int ks = 0; ks < 2; ++ks) a = MFMA16(*(const LAS bf16x8*)(Qin + (16 * it + q) * 72 + 32 * ks + 8 * gl), *(const LAS bf16x8*)(Kin + (16 * jt + q) * 72 + 32 * ks + 8 * gl), a);
            }
#pragma unroll
            for (int reg = 0; reg < 4; ++reg) { const int i = 16 * it + 4 * gl + reg, jx = 16 * jt + q; Am[i * 72 + jx] = (i >= jx) ? f2b(a[reg]) : (bf16)0; } }
    }
    __syncthreads();
    f32x4 acc[4];
#pragma unroll
    for (int it = 0; it < 4; ++it) acc[it] = (f32x4){0.f, 0.f, 0.f, 0.f};
#pragma unroll
    for (int ks = 0; ks < 2; ++ks) {
        const bf16x8 bv = *(const LAS bf16x8*)(VTl + (16 * w + q) * 72 + 32 * ks + 8 * gl);
        const bf16x8 bs = *(const bf16x8*)(F.ST + ((size_t)item * 128 + 16 * w + q) * 64 + 32 * ks + 8 * gl);
#pragma unroll
        for (int it = 0; it < 4; ++it) { acc[it] = MFMA16(*(const LAS bf16x8*)(Am + (16 * it + q) * 72 + 32 * ks + 8 * gl), bv, acc[it]);
            acc[it] = MFMA16(*(const LAS bf16x8*)(Qin + (16 * it + q) * 72 + 32 * ks + 8 * gl), bs, acc[it]); }
    }
#pragma unroll
    for (int it = 0; it < 4; ++it)
#pragma unroll
        for (int reg = 0; reg < 4; ++reg) { float s = acc[it][reg] * acc[it][reg]; s += __shfl_xor(s, 1); s += __shfl_xor(s, 2); s += __shfl_xor(s, 4); s += __shfl_xor(s, 8);
            if (q == 0) ssqw[w * 64 + 16 * it + 4 * gl + reg] = s; }
    __syncthreads();
    const float gg = F.in[15][16 * w + q];
#pragma unroll
    for (int it = 0; it < 4; ++it)
#pragma unroll
        for (int reg = 0; reg < 4; ++reg) { const int i = 16 * it + 4 * gl + reg; float tot = 0.f;
#pragma unroll
            for (int w2 = 0; w2 < 8; ++w2) tot += ssqw[w2 * 64 + i];
            const float rs = __builtin_amdgcn_rsqf(tot * (1.0f / 128.0f) + RMS_EPS);
            const size_t r2 = (size_t)b * T + 64 * n + i;
            const float gr = bf2f(F.PROJ[r2 * NP + C_GR + h * 128 + 16 * w + q]);
            const float sl = gr * __builtin_amdgcn_rcpf(1.0f + fexp(-gr));
            F.MIX[r2 * 1024 + 512 + h * 128 + 16 * w + q] = f2b(acc[it][reg] * rs * gg * sl); }
    __syncthreads();
}

constexpr float NSA_C2 = 0.125f * 1.4426950408889634f, NSA_THR = 8.0f;
constexpr int NSA_STAGE_BYTES = 16384, NSA_VOFF = 8192, NSA_NSTAGE = 4, NSA_KC_OFF = NSA_NSTAGE * NSA_STAGE_BYTES, NSA_VC_OFF = NSA_KC_OFF + 18432, NSA_UM_OFF = NSA_VC_OFF + 17408;
__device__ __forceinline__ bf16x8 scale8(bf16x8 x, float c) { const v4u w = __builtin_bit_cast(v4u, x); v4u o;
    o.x = cvtpk(blo(w.x) * c, bhi(w.x) * c); o.y = cvtpk(blo(w.y) * c, bhi(w.y) * c); o.z = cvtpk(blo(w.z) * c, bhi(w.z) * c); o.w = cvtpk(blo(w.w) * c, bhi(w.w) * c); return __builtin_bit_cast(bf16x8, o); }
__device__ __forceinline__ float dot8(bf16x8 a, bf16x8 b) { const v4u x = __builtin_bit_cast(v4u, a), y = __builtin_bit_cast(v4u, b);
    return ((blo(x.x) * blo(y.x) + bhi(x.x) * bhi(y.x)) + (blo(x.y) * blo(y.y) + bhi(x.y) * bhi(y.y))) + ((blo(x.z) * blo(y.z) + bhi(x.z) * bhi(y.z)) + (blo(x.w) * blo(y.w) + bhi(x.w) * bhi(y.w))); }
__device__ __forceinline__ float max3f(float a, float b, float c) { float r; asm("v_max3_f32 %0, %1, %2, %3" : "=v"(r) : "v"(a), "v"(b), "v"(c)); return r; }
struct NsaState { f32x4 O[2][4]; float m[2], l[2]; };
__device__ __forceinline__ void nsa_init(NsaState& st, const bf16x8 (&qf)[2][2], const bf16* Kself  , unsigned voK) {
    const bf16x8 k0 = ldb16(Kself, voK), k1 = ldb16(Kself + 32, voK);
#pragma unroll
    for (int r = 0; r < 2; ++r) { float s = dot8(qf[r][0], k0) + dot8(qf[r][1], k1); s += __shfl_xor(s, 16); s += __shfl_xor(s, 32); st.m[r] = s; st.l[r] = 0.f;
#pragma unroll
        for (int dt = 0; dt < 4; ++dt) st.O[r][dt] = (f32x4){0.f, 0.f, 0.f, 0.f}; }
}
__device__ __forceinline__ void nsa_tile(NsaState& st, const bf16x8 (&qf)[2][2], const float (&slope2)[2], const LAS bf16* Ks, const LAS bf16* Vs, int key0, int t, int q, int gl, bool selbit, int wlim, bool need_mask) {
#pragma unroll 1
    for (int half = 0; half < 2; ++half) {
        bf16x8 kf[2][2], vf[4];
#pragma unroll
        for (int kt = 0; kt < 2; ++kt)
#pragma unroll
            for (int ks = 0; ks < 2; ++ks) kf[kt][ks] = *(const LAS bf16x8*)((const LAS unsigned char*)Ks + (32 * half + 16 * kt + q) * 128 + 16 * ((4 * ks + gl) ^ (q >> 1)));
#pragma unroll
        for (int dt = 0; dt < 4; ++dt) { const LAS unsigned char* vr = (const LAS unsigned char*)Vs + (16 * dt + q) * 128 + 8 * (gl & 1); const int c0 = 4 * half + (gl >> 1);
            const u32x2 a = *(const LAS u32x2*)(vr + 16 * (c0 ^ (q >> 1))), c = *(const LAS u32x2*)(vr + 16 * ((c0 + 2) ^ (q >> 1)));
            v4u wv; wv.x = a.x; wv.y = a.y; wv.z = c.x; wv.w = c.y; vf[dt] = __builtin_bit_cast(bf16x8, wv); }
        const int kbase = key0 + 32 * half + 4 * gl;
        const float kb = (float)(kbase - t);
#pragma unroll
        for (int r = 0; r < 2; ++r) {
            const float c1 = selbit ? (slope2[r] * kb - st.m[r]) : -INFINITY;
            f32x4 s0, s1;
#pragma unroll
            for (int reg = 0; reg < 4; ++reg) { s0[reg] = slope2[r] * (float)reg + c1; s1[reg] = slope2[r] * (float)(16 + reg) + c1; }
            s0 = MFMA16(kf[0][0], qf[r][0], s0); s0 = MFMA16(kf[0][1], qf[r][1], s0);
            s1 = MFMA16(kf[1][0], qf[r][0], s1); s1 = MFMA16(kf[1][1], qf[r][1], s1);
            if (need_mask) {
#pragma unroll
                for (int reg = 0; reg < 4; ++reg) { const int d0 = t - (kbase + reg), d1 = d0 - 16;
                    s0[reg] = (d0 >= 0 && d0 < wlim) ? s0[reg] : -INFINITY; s1[reg] = (d1 >= 0 && d1 < wlim) ? s1[reg] : -INFINITY; }
            }
            const float lmax = max3f(max3f(s0[0], s0[1], s0[2]), max3f(s0[3], s1[0], s1[1]), max3f(s1[2], s1[3], s1[3]));
            if (__ballot(lmax > NSA_THR) != 0ull) {
                float rm = fmaxf(lmax, __shfl_xor(lmax, 16)); rm = fmaxf(rm, __shfl_xor(rm, 32));
                const float dl = fmaxf(rm, 0.f), f = __builtin_amdgcn_exp2f(-dl);
                st.m[r] += dl; st.l[r] *= f;
#pragma unroll
                for (int reg = 0; reg < 4; ++reg) { s0[reg] -= dl; s1[reg] -= dl; }
#pragma unroll
                for (int dt = 0; dt < 4; ++dt) st.O[r][dt] *= f;
            }
            float ps = 0.f;
#pragma unroll
            for (int reg = 0; reg < 4; ++reg) { s0[reg] = __builtin_amdgcn_exp2f(s0[reg]); s1[reg] = __builtin_amdgcn_exp2f(s1[reg]); ps += s0[reg] + s1[reg]; }
            st.l[r] += ps;
            const bf16x8 pb = pack8(s0, s1);
#pragma unroll
            for (int dt = 0; dt < 4; ++dt) st.O[r][dt] = MFMA16(vf[dt], pb, st.O[r][dt]);
        }
    }
}
__device__ __forceinline__ void nsa_flush(NsaState& st, f32x4 (&tot)[2][4], const bf16* Pg  , int c, unsigned voG) {
#pragma unroll
    for (int r = 0; r < 2; ++r) { float l = st.l[r]; l += __shfl_xor(l, 16); l += __shfl_xor(l, 32);
        const float gate = __builtin_amdgcn_rcpf(1.0f + fexp(-ldb_bf(Pg + r * 3 + c, voG)));
        const float sc = gate * __builtin_amdgcn_rcpf(l);
#pragma unroll
        for (int dt = 0; dt < 4; ++dt) tot[r][dt] += st.O[r][dt] * sc; }
}
__device__ __forceinline__ void m2_nsa_unit(Frame& F, int b, int g, int cur) {
    int tid = F.tid; OPAQUE(tid);
    const int lane = tid & 63, q = lane & 15, gl = lane >> 4, w = F.wave;
    const int tgi = w & 3, pair = w >> 2;
    const int t0 = 64 * cur + 16 * tgi, t = t0 + q;
    const bf16* Pr = F.PROJ + ((size_t)b * T + t0) * NP;
    const bf16* Pq = Pr + C_Q + 4 * g * 64; const bf16* Pg = Pr + C_GN + (4 * g + 2 * pair) * 3;
    LAS unsigned char* L = F.lds + RING_OFF;
    LAS unsigned* um = (LAS unsigned*)(L + NSA_UM_OFF);
    const unsigned voQ = (unsigned)(q * NP + 8 * gl) * 2u, voG = (unsigned)(q * NP) * 2u;
    const float tf = (float)t;
    const int jw0 = (cur - 8) < 0 ? 0 : (cur - 8), nwin = cur + 1 - jw0;
    const bf16* Ksg = F.PROJ + (size_t)b * T * NP + C_KS + g * 64; const bf16* Kwg = F.PROJ + (size_t)b * T * NP + C_KW + g * 64;
    const bf16* VTs = F.VTS + (size_t)(b * 2 + g) * 64 * T; const bf16* VTw = F.VTW + (size_t)(b * 2 + g) * 64 * T;
    const int srow = 8 * w + (lane >> 3), sc = (lane & 7) ^ ((srow >> 1) & 7);
    const unsigned gK = (unsigned)(srow * NP + 8 * sc) * 2u, gV = (unsigned)(srow * T + 8 * sc) * 2u;
    unsigned remF = (cur <= 7) ? ((2u << cur) - 1u) : 0u; int fi = 0;
#define NSA_ISSUE() do { int j_; const bf16 *kp_, *vp_; if (fi < nwin) { j_ = jw0 + fi; kp_ = Kwg; vp_ = VTw; } else { j_ = __builtin_ctz(remF); remF &= remF - 1u; kp_ = Ksg; vp_ = VTs; } \
        LAS unsigned char* sb_ = L + (fi & 3) * NSA_STAGE_BYTES + w * 1024; ++fi; \
        __builtin_amdgcn_global_load_lds((const unsigned*)((const char*)(kp_ + (size_t)j_ * 64 * NP) + gK), (LAS unsigned*)sb_, 16, 0, 0); \
        __builtin_amdgcn_global_load_lds((const unsigned*)((const char*)(vp_ + j_ * 64) + gV), (LAS unsigned*)(sb_ + NSA_VOFF), 16, 0, 0); } while (0)
#define NSA_WAITV(n) asm volatile("s_waitcnt vmcnt(" #n ")" ::: "memory")
#define NSA_BAR() do { asm volatile("s_waitcnt lgkmcnt(0)" ::: "memory"); __builtin_amdgcn_s_barrier(); asm volatile("" ::: "memory"); } while (0)
    NSA_ISSUE(); NSA_ISSUE();
    if (cur >= 1) NSA_ISSUE();
    {
        const bf16* KCg = F.KC + (size_t)(b * 2 + g) * 128 * 64; const bf16* VCg = F.VTC + (size_t)(b * 2 + g) * 64 * 128;
#pragma unroll
        for (int i = 0; i < 2; ++i) { const int c = tid + 512 * i;
            *(LAS v4u*)(L + NSA_KC_OFF + ((c >> 3) * 72 + 8 * (c & 7)) * 2) = *(const v4u*)(KCg + 8 * c);
            *(LAS v4u*)(L + NSA_VC_OFF + ((c >> 4) * 136 + 8 * (c & 15)) * 2) = *(const v4u*)(VCg + 8 * c); }
    }
    __syncthreads();
    f32x4 tot[2][4];
    unsigned mask;
    {
        const LAS bf16* KCs = (const LAS bf16*)(L + NSA_KC_OFF); const LAS bf16* VCs = (const LAS bf16*)(L + NSA_VC_OFF);
        f32x4 psum[8];
#pragma unroll
        for (int nt = 0; nt < 8; ++nt) psum[nt] = (f32x4){0.f, 0.f, 0.f, 0.f};
#pragma unroll 1
        for (int r = 0; r < 4; ++r) {
            int glo = gl; OPAQUE(glo);
            const bf16x8 q0 = scale8(ldb16(Pq + r * 64, voQ), NSA_C2), q1 = scale8(ldb16(Pq + r * 64 + 32, voQ), NSA_C2);
            const float sl2 = __builtin_amdgcn_exp2f(-(float)(4 * g + r + 1)) * 1.4426950408889634f;
            f32x4 S[8]; const f32x4 z = (f32x4){0.f, 0.f, 0.f, 0.f};
#pragma unroll
            for (int nt = 0; nt < 8; ++nt) { const LAS bf16* kp = KCs + (16 * nt + q) * 72 + 8 * gl; S[nt] = MFMA16(*(const LAS bf16x8*)kp, q0, z); S[nt] = MFMA16(*(const LAS bf16x8*)(kp + 32), q1, S[nt]); }
            float mx = -1e30f;
#pragma unroll
            for (int nt = 0; nt < 8; ++nt)
#pragma unroll
                for (int reg = 0; reg < 4; ++reg) { const int n = 16 * nt + 4 * glo + reg; const bool valid = (16 * n + 31 <= t);
                    const float s = S[nt][reg] - sl2 * (tf - (16.0f * (float)n + 15.5f)); S[nt][reg] = valid ? s : -1e30f; mx = fmaxf(mx, S[nt][reg]); }
            mx = fmaxf(mx, __shfl_xor(mx, 16)); mx = fmaxf(mx, __shfl_xor(mx, 32));
            float sum = 0.f;
#pragma unroll
            for (int nt = 0; nt < 8; ++nt)
#pragma unroll
                for (int reg = 0; reg < 4; ++reg) { const float p = (S[nt][reg] > -1e29f) ? __builtin_amdgcn_exp2f(S[nt][reg] - mx) : 0.f; S[nt][reg] = p; sum += p; }
            sum += __shfl_xor(sum, 16); sum += __shfl_xor(sum, 32);
            const float inv = sum > 0.f ? 1.0f / sum : 0.f;
#pragma unroll
            for (int nt = 0; nt < 8; ++nt) { S[nt] = S[nt] * inv; psum[nt] += S[nt]; }
            if ((r >> 1) == pair) {
                f32x4 oc[4];
#pragma unroll
                for (int dt = 0; dt < 4; ++dt) oc[dt] = (f32x4){0.f, 0.f, 0.f, 0.f};
#pragma unroll
                for (int kp = 0; kp < 4; ++kp) { const bf16x8 pb = pack8(S[2 * kp], S[2 * kp + 1]);
#pragma unroll
                    for (int dt = 0; dt < 4; ++dt) { const LAS bf16* vp = VCs + (16 * dt + q) * 136 + 32 * kp + 4 * gl; const u32x2 a = *(const LAS u32x2*)vp, c = *(const LAS u32x2*)(vp + 16);
                        v4u wv; wv.x = a.x; wv.y = a.y; wv.z = c.x; wv.w = c.y; oc[dt] = MFMA16(__builtin_bit_cast(bf16x8, wv), pb, oc[dt]); } }
                const float gate = __builtin_amdgcn_rcpf(1.0f + fexp(-ldb_bf(Pg + (r & 1) * 3, voG)));
                if (r & 1) {
#pragma unroll
                    for (int dt = 0; dt < 4; ++dt) tot[1][dt] = oc[dt] * gate;
                } else {
#pragma unroll
                    for (int dt = 0; dt < 4; ++dt) tot[0][dt] = oc[dt] * gate;
                }
            }
        }
        if (cur <= 7) mask = (2u << cur) - 1u;
        else {
            float v[8]; float shp = 0.f;
#pragma unroll
            for (int nt = 0; nt < 8; ++nt) { const float sh = __shfl(psum[nt][3], (lane + 48) & 63);
                const float pterm = (gl > 0) ? sh : shp; shp = sh;
                v[nt] = pterm + ((psum[nt][0] + psum[nt][1]) + (psum[nt][2] + psum[nt][3])); }
            mask = 1u | (1u << cur) | (1u << (cur - 1));
            unsigned taken = 0u;
#pragma unroll
            for (int round = 0; round < 5; ++round) {
                float bv = -1.f; int bi = 99;
#pragma unroll
                for (int i = 0; i < 8; ++i) { const int s = 4 * i + gl; const bool ok = (s >= 1) && (s <= cur - 2) && (((taken >> i) & 1u) == 0u); if (ok && v[i] > bv) { bv = v[i]; bi = s; } }
#pragma unroll
                for (int off = 16; off <= 32; off <<= 1) { const float ov = __shfl_xor(bv, off); const int oi = __shfl_xor(bi, off); if (ov > bv || (ov == bv && oi < bi)) { bv = ov; bi = oi; } }
                if (bi < 32) { mask |= 1u << bi; if ((bi & 3) == gl) taken |= 1u << (bi >> 2); }
            }
        }
    }
    unsigned wm = 0u;
#pragma unroll
    for (int j = 0; j < 32; ++j) wm |= (__ballot((mask >> j) & 1u) != 0ull) ? (1u << j) : 0u;
    if (lane == 0) um[w] = wm;
    __syncthreads();
    unsigned U = 0u;
#pragma unroll
    for (int i = 0; i < 8; ++i) U |= um[i];
    U = __builtin_amdgcn_readfirstlane(U);
    if (cur > 7) remF = U;
    const int nsel = __builtin_popcount(U), NT = nwin + nsel;
    bf16x8 qf[2][2]; float slope2[2];
#pragma unroll
    for (int r = 0; r < 2; ++r) { slope2[r] = __builtin_amdgcn_exp2f(-(float)(4 * g + 2 * pair + r + 1)) * 1.4426950408889634f;
#pragma unroll
        for (int ks = 0; ks < 2; ++ks) qf[r][ks] = scale8(ldb16(Pq + (2 * pair + r) * 64 + 32 * ks, voQ), NSA_C2); }
    NsaState st;
    const unsigned voK = (unsigned)(q * NP + 8 * gl) * 2u;
    nsa_init(st, qf, Pr + C_KW + g * 64, voK);
    unsigned remC = U;
    NSA_WAITV(0); NSA_BAR();
    for (int i = 0; i < NT; ++i) {
        if (i + 3 < NT) NSA_ISSUE();
        const LAS bf16* Ks = (const LAS bf16*)(L + (i & 3) * NSA_STAGE_BYTES); const LAS bf16* Vs = Ks + NSA_VOFF / 2;
        int key0, wlim; bool selbit, need_mask, run;
        if (i < nwin) {
            const int j = jw0 + i; key0 = 64 * j; wlim = 512; selbit = true;
            run = (key0 + 63 >= t0 - 511) && (key0 <= t0 + 15); need_mask = !(key0 >= t0 + 15 - 511 && key0 + 63 <= t0);
        } else {
            if (i == nwin) { nsa_flush(st, tot, Pg, 2, voG); nsa_init(st, qf, Pr + C_KS + g * 64, voK); }
            const int j = __builtin_ctz(remC); remC &= remC - 1u;
            selbit = ((mask >> j) & 1u) != 0u; const unsigned long long bal = __ballot(selbit);
            key0 = 64 * j; wlim = 0x7fffffff; run = (bal != 0ull); need_mask = (j == cur);
        }
#ifdef PROBE_TILE2
        if (run) { NsaState st2 = st; nsa_tile(st2, qf, slope2, Ks, Vs, key0, t, q, gl, selbit, wlim, need_mask);
#pragma unroll
            for (int r_ = 0; r_ < 2; ++r_) { asm volatile("" :: "v"(st2.m[r_]), "v"(st2.l[r_]));
#pragma unroll
                for (int d_ = 0; d_ < 4; ++d_) asm volatile("" :: "v"(st2.O[r_][d_])); } }
#endif
        if (run) nsa_tile(st, qf, slope2, Ks, Vs, key0, t, q, gl, selbit, wlim, need_mask);
        if (i + 3 < NT) NSA_WAITV(4); else if (i + 2 < NT) NSA_WAITV(2); else NSA_WAITV(0);
        NSA_BAR();
    }
    nsa_flush(st, tot, Pg, 1, voG);
    bf16* Mo = F.MIX + ((size_t)b * T + t0) * 1024 + (4 * g + 2 * pair) * 64; const unsigned voM = (unsigned)(q * 1024 + 4 * gl) * 2u;
#pragma unroll
    for (int r = 0; r < 2; ++r)
#pragma unroll
        for (int dt = 0; dt < 4; ++dt) { const f32x4 o = tot[r][dt]; u32x2 wv; wv.x = cvtpk(o[0], o[1]); wv.y = cvtpk(o[2], o[3]); *(u32x2*)((char*)(Mo + r * 64 + 16 * dt) + voM) = wv; }
#undef NSA_ISSUE
#undef NSA_WAITV
#undef NSA_BAR
}

__device__ __forceinline__ void p8_final_norm(Frame& F) {
    const int gw = F.vcu * NWAVES + F.wave, NGW = F.G * NWAVES;
    const GAS f32x4* gp = (const GAS f32x4*)F.in[21] + F.lane;
    f32x4 gv[4];
#pragma unroll
    for (int j = 0; j < 4; ++j) gv[j] = gp[64 * j];
    for (int m = gw; m < M; m += NGW) {
        GAS f32x4* xr = (GAS f32x4*)(F.out + (size_t)m * D) + F.lane;
        f32x4 v[4]; float s = 0.f;
#pragma unroll
        for (int j = 0; j < 4; ++j) { v[j] = xr[64 * j]; s += (v[j].x * v[j].x + v[j].y * v[j].y) + (v[j].z * v[j].z + v[j].w * v[j].w); }
        const float rs = __builtin_amdgcn_rsqf(wave_sum(s) * (1.0f / 1024.0f) + RMS_EPS);
#pragma unroll
        for (int j = 0; j < 4; ++j) xr[64 * j] = v[j] * rs * gv[j];
    }
}

struct Args { const float* in[22]; float* out; unsigned char* ws; };
__global__ void __launch_bounds__(NWAVES * 64, 2) hybrid_fwd(Args args) {
    extern __shared__ __attribute__((aligned(16))) unsigned char lds[];
    Frame F;
    F.lds = (LAS unsigned char*)lds;
    F.MISC = (volatile LAS unsigned*)(F.lds + MISC_OFF);
    F.tid = threadIdx.x; F.lane = F.tid & 63; F.wave = __builtin_amdgcn_readfirstlane(F.tid >> 6);
    F.G = gridDim.x; { const int bx = blockIdx.x; F.vcu = (F.G % 8 == 0) ? (bx % 8) * (F.G / 8) + bx / 8 : bx; }
    unsigned char* ws = args.ws;
    F.ctl = (gu32*)(ws + WS_CTL);
#pragma unroll
    for (int i = 0; i < 22; ++i) F.in[i] = args.in[i];
    F.out = args.out;
    F.W1GU = (bf16*)(ws + WS_W1GU); F.W1D = (bf16*)(ws + WS_W1D); F.WIN = (bf16*)(ws + WS_WIN); F.WOUT = (bf16*)(ws + WS_WOUT); F.W2GU = (bf16*)(ws + WS_W2GU); F.W2D = (bf16*)(ws + WS_W2D);
    F.WC1K = (bf16*)(ws + WS_WC1K); F.WC1V = (bf16*)(ws + WS_WC1V); F.WC2K = (bf16*)(ws + WS_WC2K); F.WC2V = (bf16*)(ws + WS_WC2V);
    F.KC = (bf16*)(ws + WS_KC); F.VTC = (bf16*)(ws + WS_VTC); F.XB = (bf16*)(ws + WS_XB); F.H = (bf16*)(ws + WS_R); F.PROJ = (bf16*)(ws + WS_R);
    F.MIX = (bf16*)(ws + WS_MIX); F.VTS = (bf16*)(ws + WS_VTS); F.VTW = (bf16*)(ws + WS_VTW); F.ST = (bf16*)(ws + WS_ST);
    F.CBIAS = (float*)(ws + WS_CBIAS); F.SSQ0 = (float*)(ws + WS_SSQ0); F.SSQA = (float*)(ws + WS_SSQA); F.SSQB = (float*)(ws + WS_SSQB); F.DEC = (float*)(ws + WS_DEC); F.KVT = (float*)(ws + WS_KVT); F.BG = (float*)(ws + WS_BG);
    for (int u = F.tid; u < (LDS_BYTES - LDSCTL_OFF) / 4; u += NWAVES * 64) ((LAS unsigned*)(F.lds + LDSCTL_OFF))[u] = 0u;
    __syncthreads();
    XcdBarrier bar = xcd_barrier_post((unsigned*)(F.ctl + CW_BAR), F.MISC + 8);
#define GRID_BAR() do { for (int rb_ = 0; rb_ < REP_BAR; ++rb_) xcd_barrier(bar); asm volatile("" : "+v"(F.tid)); F.lane = F.tid & 63; } while (0)
    const int gw = F.vcu * NWAVES + F.wave, NGW = F.G * NWAVES;

#ifndef NO_P0
    for (int rep = 0; rep < REP_P0; ++rep) p0_prologue(F);
#endif
    GRID_BAR();
#ifndef NO_GEMM
    { pg8::Gemm g{F.XB, F.W1GU, M, 2 * FF, D}; pg8::StaticOrder S; S.init(M, 2 * FF, F.G, (int)blockIdx.x);
      pg8::EpiSwiGLU<1> E{F.H, FF, F.SSQ0};
      for (int rep = 0; rep < REP_P1; ++rep) pg8::gemm_phase<pg8::EpiSwiGLU<1>, pg8::StaticOrder, true, true>(F.lds + RING_OFF, g, S, E); }
#endif
    GRID_BAR();
#ifndef NO_GEMM
    { pg8::Gemm g{F.H, F.W1D, M, D, FF}; pg8::StaticOrder S; S.init(M, D, F.G, (int)blockIdx.x);
      pg8::EpiResid<true> E{F.in[0], F.out, F.XB, F.SSQA, 0.5f};
      for (int rep = 0; rep < REP_P2; ++rep) pg8::gemm_phase<pg8::EpiResid<true>, pg8::StaticOrder, true, true>(F.lds + RING_OFF, g, S, E); }
#endif
    GRID_BAR();
#ifndef NO_GEMM
    { pg8::Gemm g{F.XB, F.WIN, M, NP, D}; pg8::StaticOrder S; S.init(M, NP, F.G, (int)blockIdx.x);
      pg8::EpiProj<16> E{F.PROJ, NP, F.SSQA};
      for (int rep = 0; rep < REP_P3; ++rep) pg8::gemm_phase<pg8::EpiProj<16>, pg8::StaticOrder, true, true>(F.lds + RING_OFF, g, S, E); }
#endif
    GRID_BAR();
#ifndef NO_M1
    for (int rep = 0; rep < REP_M13; ++rep) {
    for (int ci = F.vcu; ci < 256; ci += F.G) m1_compress(F, ci);
    for (int bn = F.vcu; bn < 256; bn += F.G) m1_gla_kv4(F, bn);
    for (int ti = gw; ti < 1024; ti += NGW) m1_transpose(F, ti);
    }
#endif
    GRID_BAR();
#ifndef NO_NSA
    for (int rep = 0; rep < REP_M2; ++rep)
    for (int wi = F.vcu; wi < 256; wi += F.G) { const int b = wi >> 5, g = (wi >> 4) & 1, x = wi & 15;
#pragma unroll 1
        for (int u = 0; u < 2; ++u) m2_nsa_unit(F, b, g, u ? x : 31 - x); }
#endif
#ifndef NO_SCAN
    for (int rep = 0; rep < REP_SCAN; ++rep)
    for (int k = gw; k < 2048; k += NGW) { const int wi = k >> 3; if ((wi & 15) < 8) m2_scan(F, (((wi >> 4) * 8 + (wi & 15)) * 8) + (k & 7)); }
#endif
    GRID_BAR();
#ifndef NO_GLA3
    for (int rep = 0; rep < REP_M13; ++rep)
    for (int it = F.vcu; it < 512; it += F.G) m3_gla_out2(F, it);
#endif
    GRID_BAR();
#ifndef NO_GEMM
    { pg8::Gemm g{F.MIX, F.WOUT, M, D, D}; pg8::StaticOrder S; S.init(M, D, F.G, (int)blockIdx.x);
      pg8::EpiResid<true> E{F.out, F.out, F.XB, F.SSQB, 1.0f};
      pg8::gemm_phase<pg8::EpiResid<true>, pg8::StaticOrder, true, true>(F.lds + RING_OFF, g, S, E); }
#endif
    GRID_BAR();
#ifndef NO_GEMM
    { pg8::Gemm g{F.XB, F.W2GU, M, 2 * FF, D}; pg8::StaticOrder S; S.init(M, 2 * FF, F.G, (int)blockIdx.x);
      pg8::EpiSwiGLU<16> E{F.H, FF, F.SSQB};
      pg8::gemm_phase<pg8::EpiSwiGLU<16>, pg8::StaticOrder, true, true>(F.lds + RING_OFF, g, S, E); }
#endif
    GRID_BAR();
#ifndef NO_GEMM
    { pg8::Gemm g{F.H, F.W2D, M, D, FF}; pg8::StaticOrder S; S.init(M, D, F.G, (int)blockIdx.x);
      pg8::EpiResid<false> E{F.out, F.out, nullptr, nullptr, 0.5f};
      pg8::gemm_phase<pg8::EpiResid<false>, pg8::StaticOrder, true, true>(F.lds + RING_OFF, g, S, E); }
#endif
    GRID_BAR();
#ifndef NO_P8
    p8_final_norm(F);
#endif
}

extern "C" void kernel_launch(void* const* d_in, const int* in_sizes, int n_in, void* d_out, int out_size, void* d_ws, size_t ws_size, hipStream_t stream) {
    static int grid = 0;
    if (grid == 0) {
        if (n_in != 22 || in_sizes[0] != M * D || out_size != M * D || ws_size < WS_END) { fprintf(stderr, "kernel_launch: unexpected shapes (n_in %d, in0 %d, out %d, ws %zu); nothing launched\n", n_in, n_in > 0 ? in_sizes[0] : -1, out_size, ws_size); grid = -1; return; }
        int dev = 0, cus = 0;
        if (hipGetDevice(&dev) != hipSuccess || hipDeviceGetAttribute(&cus, hipDeviceAttributeMultiprocessorCount, dev) != hipSuccess) { fprintf(stderr, "kernel_launch: device query failed\n"); grid = -1; return; }
        if (hipFuncSetAttribute((const void*)hybrid_fwd, hipFuncAttributeMaxDynamicSharedMemorySize, LDS_BYTES) != hipSuccess) { fprintf(stderr, "kernel_launch: hipFuncSetAttribute failed\n"); grid = -1; return; }
        (void)hipGetLastError();
        grid = cus;
    }
    if (grid < 0) return;
    if (hipMemsetAsync((char*)d_ws + WS_CTL, 0, CTL_ZERO_BYTES, stream) != hipSuccess) { fprintf(stderr, "kernel_launch: hipMemsetAsync failed\n"); return; }
    Args a{};
    for (int i = 0; i < 22; ++i) a.in[i] = (const float*)d_in[i];
    a.out = (float*)d_out; a.ws = (unsigned char*)d_ws;
    hipLaunchKernelGGL(hybrid_fwd, dim3(grid), dim3(NWAVES * 64), LDS_BYTES, stream, a);
}
```

```cpp
#include <hip/hip_runtime.h>
#include <cstdio>
#include <cstdint>
namespace pg8 {
#define PG8_LAS __attribute__((address_space(3)))
typedef unsigned short bf16_t;
typedef short bf16x8 __attribute__((ext_vector_type(8)));
typedef float f32x4 __attribute__((ext_vector_type(4)));
typedef unsigned u32x4 __attribute__((ext_vector_type(4)));
constexpr int BM = 256, BK = 64, HALF = 128, HTB = HALF * BK * 2  , STAGE_BYTES = 8 * HTB, NXCD = 8, WGM = 8;

__host__ __device__ __forceinline__ int lds_byte(int r, int c) { const int st = (r >> 4) * 2 + (c >> 5), rr = r & 15, cc = c & 31, ob = rr * 64 + cc * 2; return st * 1024 + (ob ^ (((ob >> 9) & 1) << 5)); }
__host__ __device__ __forceinline__ void stage_rc(int b, int& R, int& C) { const int st = b / 1024, sb = b % 1024, swz = sb ^ (((sb >> 9) & 1) << 5); R = (st >> 1) * 16 + swz / 64; C = (st & 1) * 32 + (swz % 64) / 2; }
__host__ __device__ __forceinline__ int perm32(int rho) { const int n = rho >> 4, i = rho & 15; return 8 * (i >> 2) + 4 * n + (i & 3); }

struct Unit { int pm, pn; };
struct Gemm { const bf16_t* A; const bf16_t* Bt; int M, N, K; };

struct StaticOrder {
    int nM, nN, nwg, G, c;
    __host__ __device__ void init(int M, int N, int G_, int c_) { nM = M / BM; nN = N / BM; nwg = nM * nN; G = G_; c = c_; }
    __host__ __device__ bool next(int i, Unit& u) const {
        const long L = (long)i * G + c; if (L >= nwg) return false;
        int wgid = (int)L; { const int q = nwg / NXCD, r = nwg % NXCD, xcd = wgid % NXCD, off = wgid / NXCD; wgid = (xcd < r ? xcd * (q + 1) : r * (q + 1) + (xcd - r) * q) + off; }
        const int nig = WGM * nN, gid = wgid / nig, fm = gid * WGM, gsz = (nM - fm) < WGM ? (nM - fm) : WGM;
        u.pm = fm + ((wgid % nig) % gsz); u.pn = (wgid % nig) / gsz; return true;
    }
    __device__ __forceinline__ void a_ready(const Unit&) const {}
    __device__ __forceinline__ void done(const Unit&) const {}
};
__device__ __forceinline__ unsigned cvt_pk_bf16(float lo, float hi) { unsigned r; asm volatile("v_cvt_pk_bf16_f32 %0, %1, %2" : "=v"(r) : "v"(lo), "v"(hi)); return r; }
typedef float f32x2 __attribute__((ext_vector_type(2)));
typedef unsigned u32x2 __attribute__((ext_vector_type(2)));
constexpr float RMS_EPS = 1e-6f;
template <int NPARTS> __device__ __forceinline__ float row_rstd(const float* ssq, int row) {
    float s;
    if (NPARTS == 1) s = ssq[row];
    else { const f32x4* p = (const f32x4*)(ssq + (size_t)row * 16); const f32x4 a = p[0], b = p[1], c = p[2], d = p[3]; const f32x4 t = (a + b) + (c + d); s = (t[0] + t[1]) + (t[2] + t[3]); }
    return __builtin_amdgcn_rsqf(s * (1.0f / 1024.0f) + RMS_EPS);
}
__device__ __forceinline__ float silu_f(float x) { return x * __builtin_amdgcn_rcpf(1.0f + __builtin_amdgcn_exp2f(-1.4426950408889634f * x)); }
template <int NPARTS> struct EpiSwiGLU {
    static constexpr bool PERM = true, AFTER_DRAIN = false;
    bf16_t* H; int ldh; const float* ssq;
    __device__ __forceinline__ void operator()(const f32x4 (&acc)[2][2][4][2], const Unit& u, int wr, int wc, int fr, int fq) const {
        const int row0 = u.pm * BM + wr * 64 + fr, col0 = u.pn * 128 + wc * 32 + 8 * fq;
#pragma unroll
        for (int ai = 0; ai < 2; ++ai)
#pragma unroll
            for (int m = 0; m < 4; ++m) { const int row = row0 + ai * HALF + m * 16; const float rs = row_rstd<NPARTS>(ssq, row);
                const f32x4 g0 = acc[ai][0][m][0] * rs, g1 = acc[ai][0][m][1] * rs, u0 = acc[ai][1][m][0] * rs, u1 = acc[ai][1][m][1] * rs;
                u32x4 w;
                w.x = cvt_pk_bf16(silu_f(g0[0]) * u0[0], silu_f(g0[1]) * u0[1]); w.y = cvt_pk_bf16(silu_f(g0[2]) * u0[2], silu_f(g0[3]) * u0[3]);
                w.z = cvt_pk_bf16(silu_f(g1[0]) * u1[0], silu_f(g1[1]) * u1[1]); w.w = cvt_pk_bf16(silu_f(g1[2]) * u1[2], silu_f(g1[3]) * u1[3]);
                *(u32x4*)(H + (size_t)row * ldh + col0) = w; if (m & 1) asm volatile("" ::: "memory"); }
    }
};
template <int NPARTS> struct EpiProj {
    static constexpr bool PERM = true, AFTER_DRAIN = false;
    bf16_t* O; int ldc; const float* ssq;
    __device__ __forceinline__ void operator()(const f32x4 (&acc)[2][2][4][2], const Unit& u, int wr, int wc, int fr, int fq) const {
        const int row0 = u.pm * BM + wr * 64 + fr, col0 = u.pn * BM + wc * 32 + 8 * fq;
#pragma unroll
        for (int ai = 0; ai < 2; ++ai)
#pragma unroll
            for (int m = 0; m < 4; ++m) { const int row = row0 + ai * HALF + m * 16; const float rs = row_rstd<NPARTS>(ssq, row);
#pragma unroll
                for (int bj = 0; bj < 2; ++bj) { const f32x4 v0 = acc[ai][bj][m][0] * rs, v1 = acc[ai][bj][m][1] * rs; u32x4 w;
                    w.x = cvt_pk_bf16(v0[0], v0[1]); w.y = cvt_pk_bf16(v0[2], v0[3]); w.z = cvt_pk_bf16(v1[0], v1[1]); w.w = cvt_pk_bf16(v1[2], v1[3]);
                    *(u32x4*)(O + (size_t)row * ldc + col0 + bj * HALF) = w; } if (m & 1) asm volatile("" ::: "memory"); }
    }
};
template <int MODE> struct EpiResid {
    static constexpr bool PERM = false, AFTER_DRAIN = false;
    const float* rin; float* out; bf16_t* xb; float* ssqp; float alpha;
    __device__ __forceinline__ void operator()(const f32x4 (&acc)[2][2][4][2], const Unit& u, int wr, int wc, int fr, int fq) const {
        const int row0 = u.pm * BM + wr * 64 + fr, col0 = u.pn * BM + wc * 32 + 4 * fq;
#pragma unroll
        for (int ai = 0; ai < 2; ++ai)
#pragma unroll
            for (int m = 0; m < 4; ++m) { const int row = row0 + ai * HALF + m * 16; float ss = 0.f;
#pragma unroll
                for (int bj = 0; bj < 2; ++bj)
#pragma unroll
                    for (int n = 0; n < 2; ++n) { const size_t off = (size_t)row * 1024 + col0 + bj * HALF + n * 16;
                        f32x4 r;
                        if (MODE == 0) r = *(const f32x4*)(rin + off);
                        else { const u32x2 rb = *(const u32x2*)(xb + off); r = (f32x4){__builtin_bit_cast(float, rb.x << 16), __builtin_bit_cast(float, rb.x & 0xffff0000u), __builtin_bit_cast(float, rb.y << 16), __builtin_bit_cast(float, rb.y & 0xffff0000u)}; }
                        const f32x4 o = r + acc[ai][bj][m][n] * alpha;
                        if (MODE == 2) *(f32x4*)(out + off) = o;
                        else { u32x2 w; w.x = cvt_pk_bf16(o[0], o[1]); w.y = cvt_pk_bf16(o[2], o[3]); *(u32x2*)(xb + off) = w; ss += (o[0] * o[0] + o[1] * o[1]) + (o[2] * o[2] + o[3] * o[3]); } }
                if (MODE != 2) { ss += __shfl_xor(ss, 16); ss += __shfl_xor(ss, 32); if (fq == 0) ssqp[(size_t)row * 16 + u.pn * 4 + wc] = ss; } asm volatile("" ::: "memory"); }
    }
};
template <class Epi, class Sched, bool ALIGN_EPI = false, bool SP2 = false>
__device__ __forceinline__ void gemm_phase(PG8_LAS unsigned char* lds, const Gemm g, const Sched& S, const Epi& E) {
    int tid_ = threadIdx.x; asm volatile("" : "+v"(tid_)); const int tid = tid_, wid = __builtin_amdgcn_readfirstlane(tid >> 6), lane = tid & 63, wr = wid >> 2, wc = wid & 3, fr = lane & 15, fq = lane >> 4;
    const int K = g.K, nt = K / BK;
    unsigned voffA[2], voffB[2];
#pragma unroll
    for (int i = 0; i < 2; ++i) { int R, C; stage_rc(tid * 16 + i * 8192, R, C); const int Rb = Epi::PERM ? ((R & ~31) + perm32(R & 31)) : R;
        voffA[i] = (unsigned)(R * K + C) * 2u; voffB[i] = (unsigned)(Rb * K + C) * 2u; }
    const size_t kstep = (size_t)(BK * 2);
    const size_t hstep = (size_t)HALF * K * 2;
    const size_t tstep = 2 * hstep;
    const unsigned ldsw = (unsigned)wid * 1024u;
    const int aoff = lds_byte(wr * 64 + fr, fq * 8), boff = lds_byte(wc * 32 + fr, fq * 8);
#define PG8_SA(b, h) (((b) * 2 + (h)) * HTB)
#define PG8_SB(b, h) ((4 + (b) * 2 + (h)) * HTB)
#define PG8_STAGE(bufoff, gbase, voff) do { _Pragma("unroll") for (int _i = 0; _i < 2; ++_i) \
        __builtin_amdgcn_global_load_lds((const unsigned*)((const char*)(gbase) + (voff)[_i]), (PG8_LAS unsigned*)(lds + (bufoff) + ldsw + _i * 8192), 16, 0, 0); } while (0)
#define PG8_LDA(dst, b, h) do { _Pragma("unroll") for (int m = 0; m < 4; ++m) _Pragma("unroll") for (int k = 0; k < 2; ++k) dst[m][k] = *(const PG8_LAS bf16x8*)(lds + PG8_SA(b, h) + aoff + m * 2048 + k * 1024); } while (0)
#define PG8_LDB(dst, b, h) do { _Pragma("unroll") for (int n = 0; n < 2; ++n) _Pragma("unroll") for (int k = 0; k < 2; ++k) dst[n][k] = *(const PG8_LAS bf16x8*)(lds + PG8_SB(b, h) + boff + n * 2048 + k * 1024); } while (0)
#define PG8_MMA(ai, bj, At, Bt) do { __builtin_amdgcn_s_setprio(1); _Pragma("unroll") for (int m = 0; m < 4; ++m) _Pragma("unroll") for (int n = 0; n < 2; ++n) _Pragma("unroll") for (int k = 0; k < 2; ++k) \
        acc[ai][bj][m][n] = __builtin_amdgcn_mfma_f32_16x16x32_bf16(Bt[n][k], At[m][k], acc[ai][bj][m][n], 0, 0, 0); __builtin_amdgcn_s_setprio(0); } while (0)
#define PG8_WAIT_V(n) asm volatile("s_waitcnt vmcnt(" #n ")" ::: "memory")
#define PG8_WAIT_L(n) asm volatile("s_waitcnt lgkmcnt(" #n ")" ::: "memory")
#define PG8_BAR __builtin_amdgcn_s_barrier()
#define PG8_SCHED __builtin_amdgcn_sched_barrier(0)
    Unit cur, nxt; int ui = 0;
    if (!S.next(0, cur)) return;
    f32x4 acc[2][2][4][2];
#pragma unroll
    for (int a = 0; a < 2; ++a)
#pragma unroll
        for (int b = 0; b < 2; ++b)
#pragma unroll
            for (int m = 0; m < 4; ++m)
#pragma unroll
                for (int n = 0; n < 2; ++n) acc[a][b][m][n] = (f32x4){0.f, 0.f, 0.f, 0.f};
    bf16x8 At[4][2], B0[2][2], B1[2][2];
    const char* cA = (const char*)g.A + (size_t)cur.pm * tstep; const char* cB = (const char*)g.Bt + (size_t)cur.pn * tstep;
    S.a_ready(cur);
    if constexpr (SP2) {
        PG8_STAGE(PG8_SB(0, 0), cB, voffB); PG8_STAGE(PG8_SB(0, 1), cB + hstep, voffB); PG8_STAGE(PG8_SA(0, 0), cA, voffA); PG8_STAGE(PG8_SA(0, 1), cA + hstep, voffA);
        if (wr == 1) PG8_BAR;
        PG8_WAIT_V(2); PG8_BAR;
        PG8_STAGE(PG8_SB(1, 0), cB + kstep, voffB); PG8_STAGE(PG8_SA(1, 0), cA + kstep, voffA); PG8_STAGE(PG8_SB(1, 1), cB + hstep + kstep, voffB);
        PG8_WAIT_V(6); PG8_BAR;
    } else {
        PG8_STAGE(PG8_SB(0, 0), cB, voffB); PG8_STAGE(PG8_SA(0, 0), cA, voffA); PG8_STAGE(PG8_SB(0, 1), cB + hstep, voffB); PG8_STAGE(PG8_SA(0, 1), cA + hstep, voffA);
        if (wr == 1) PG8_BAR;
        PG8_WAIT_V(4); PG8_BAR;
        PG8_STAGE(PG8_SB(1, 0), cB + kstep, voffB); PG8_STAGE(PG8_SA(1, 0), cA + kstep, voffA); PG8_STAGE(PG8_SB(1, 1), cB + hstep + kstep, voffB);
        PG8_WAIT_V(6); PG8_BAR;
    }
    for (;;) {
        const bool has_next = S.next(ui + 1, nxt);
        const char* nA = has_next ? (const char*)g.A + (size_t)nxt.pm * tstep : cA; const char* nB = has_next ? (const char*)g.Bt + (size_t)nxt.pn * tstep : cB;
        for (int t = 0; t < nt; t += 2) {
            const bool last = (t == nt - 2);
            const char* a1 = cA + (size_t)(t + 1) * kstep;
            const char* a2 = last ? nA : cA + (size_t)(t + 2) * kstep; const char* b2 = last ? nB : cB + (size_t)(t + 2) * kstep;
            const char* a3 = a2 + kstep; const char* b3 = b2 + kstep;
            if (last && has_next) S.a_ready(nxt);
            if constexpr (SP2) {
            PG8_LDB(B0, 0, 0); PG8_LDB(B1, 0, 1); PG8_SCHED; PG8_LDA(At, 0, 0); PG8_STAGE(PG8_SA(1, 1), a1 + hstep, voffA);
            PG8_WAIT_V(8); PG8_WAIT_L(0); PG8_BAR; PG8_MMA(0, 0, At, B0); PG8_MMA(0, 1, At, B1); PG8_BAR; PG8_SCHED;
            PG8_LDA(At, 0, 1); PG8_STAGE(PG8_SB(0, 0), b2, voffB); PG8_STAGE(PG8_SB(0, 1), b2 + hstep, voffB); PG8_STAGE(PG8_SA(0, 0), a2, voffA);
            PG8_WAIT_V(8); PG8_WAIT_L(0); PG8_BAR; PG8_MMA(1, 0, At, B0); PG8_MMA(1, 1, At, B1); PG8_BAR; PG8_SCHED;
            PG8_LDB(B0, 1, 0); PG8_LDB(B1, 1, 1); PG8_SCHED; PG8_LDA(At, 1, 0); PG8_STAGE(PG8_SA(0, 1), a2 + hstep, voffA);
            PG8_WAIT_V(8); PG8_WAIT_L(0); PG8_BAR; PG8_MMA(0, 0, At, B0); PG8_MMA(0, 1, At, B1); PG8_BAR; PG8_SCHED;
            PG8_LDA(At, 1, 1); PG8_STAGE(PG8_SB(1, 0), b3, voffB); PG8_STAGE(PG8_SB(1, 1), b3 + hstep, voffB); PG8_STAGE(PG8_SA(1, 0), a3, voffA);
            PG8_WAIT_V(8); PG8_WAIT_L(0); PG8_BAR; PG8_MMA(1, 0, At, B0); PG8_MMA(1, 1, At, B1); PG8_BAR; PG8_SCHED;
            } else {
            PG8_LDB(B0, 0, 0); PG8_SCHED; PG8_LDA(At, 0, 0); PG8_STAGE(PG8_SA(1, 1), a1 + hstep, voffA);
            PG8_WAIT_L(8); PG8_BAR; PG8_WAIT_L(0); PG8_MMA(0, 0, At, B0); PG8_BAR; PG8_SCHED;
            PG8_LDB(B1, 0, 1); PG8_STAGE(PG8_SB(0, 0), b2, voffB);
            PG8_BAR; PG8_WAIT_L(0); PG8_MMA(0, 1, At, B1); PG8_BAR;
            PG8_LDA(At, 0, 1); PG8_STAGE(PG8_SA(0, 0), a2, voffA);
            PG8_BAR; PG8_WAIT_L(0); PG8_MMA(1, 0, At, B0); PG8_BAR; PG8_SCHED;
            PG8_STAGE(PG8_SB(0, 1), b2 + hstep, voffB);
            PG8_WAIT_V(6); PG8_BAR; PG8_MMA(1, 1, At, B1); PG8_BAR;
            PG8_LDB(B0, 1, 0); PG8_SCHED; PG8_LDA(At, 1, 0); PG8_STAGE(PG8_SA(0, 1), a2 + hstep, voffA);
            PG8_WAIT_L(8); PG8_BAR; PG8_WAIT_L(0); PG8_MMA(0, 0, At, B0); PG8_BAR; PG8_SCHED;
            PG8_LDB(B1, 1, 1); PG8_STAGE(PG8_SB(1, 0), b3, voffB);
            PG8_BAR; PG8_WAIT_L(0); PG8_MMA(0, 1, At, B1); PG8_BAR;
            PG8_LDA(At, 1, 1); PG8_STAGE(PG8_SA(1, 0), a3, voffA);
            PG8_BAR; PG8_WAIT_L(0); PG8_MMA(1, 0, At, B0); PG8_BAR; PG8_SCHED;
            PG8_STAGE(PG8_SB(1, 1), b3 + hstep, voffB);
            PG8_WAIT_V(6); PG8_BAR; PG8_MMA(1, 1, At, B1); PG8_BAR;
            }
        }
        if constexpr (ALIGN_EPI) { if (wr == 0) PG8_BAR; }
        if constexpr (!Epi::AFTER_DRAIN) { E(acc, cur, wr, wc, fr, fq); S.done(cur); }
        if (!has_next) break;
#pragma unroll
        for (int a = 0; a < 2; ++a)
#pragma unroll
            for (int b = 0; b < 2; ++b)
#pragma unroll
                for (int m = 0; m < 4; ++m)
#pragma unroll
                    for (int n = 0; n < 2; ++n) acc[a][b][m][n] = (f32x4){0.f, 0.f, 0.f, 0.f};
        cur = nxt; cA = nA; cB = nB; ++ui;
        if constexpr (ALIGN_EPI) { if (wr == 1) PG8_BAR; }
    }
    PG8_WAIT_V(0);
    if constexpr (!ALIGN_EPI) { if (wr == 0) PG8_BAR; }
    PG8_BAR;
    if constexpr (Epi::AFTER_DRAIN) { E.fused(acc, cur, wr, wc, fr, fq, lds, wid, lane); S.done(cur); }
#undef PG8_SA
#undef PG8_SB
#undef PG8_STAGE
#undef PG8_LDA
#undef PG8_LDB
#undef PG8_MMA
#undef PG8_WAIT_V
#undef PG8_WAIT_L
#undef PG8_BAR
#undef PG8_SCHED
}
}

#define GAS __attribute__((address_space(1)))
#define LAS __attribute__((address_space(3)))
typedef unsigned short bf16;
typedef unsigned v4u __attribute__((ext_vector_type(4)));
typedef float f32x4 __attribute__((ext_vector_type(4)));
typedef short bf16x8 __attribute__((ext_vector_type(8)));
typedef GAS unsigned gu32;
typedef GAS unsigned long long gu64;
#define RLX_AGENT __ATOMIC_RELAXED, __HIP_MEMORY_SCOPE_AGENT
#define LDS_WAIT() asm volatile("s_waitcnt lgkmcnt(0)" ::: "memory")
#define VM_WAIT() asm volatile("s_waitcnt vmcnt(0)" ::: "memory")
__device__ __forceinline__ unsigned long long rt() { return __builtin_amdgcn_s_memrealtime(); }
__device__ __forceinline__ unsigned f2bf(float f) { unsigned u = __builtin_bit_cast(unsigned, f); return (u + 0x7fffu + ((u >> 16) & 1u)) >> 16; }
__device__ __forceinline__ unsigned pk2(float lo, float hi) { return f2bf(lo) | (f2bf(hi) << 16); }
#define XB_TMO      128
#define XB_XCNT(j)  (256  + 64 * (j))
#define XB_XSUB(j)  (1280 + 64 * (j))
#define XB_XGEN(j)  (2304 + 64 * (j))
#define XB_TOP      3328
#define XB_TOPGEN   3392
#define XCD_BAR_WORDS 3456
#define XB_SPIN_CAP (1u << 18)

__device__ __forceinline__ unsigned xb_ld(unsigned* p)              { return __hip_atomic_load(p, __ATOMIC_RELAXED, __HIP_MEMORY_SCOPE_AGENT); }
__device__ __forceinline__ unsigned xb_add(unsigned* p, unsigned v) { return __hip_atomic_fetch_add(p, v, __ATOMIC_RELAXED, __HIP_MEMORY_SCOPE_AGENT); }
__device__ __forceinline__ unsigned xb_xcc_id() { return (unsigned)__builtin_amdgcn_s_getreg((3 << 11) | 20) & 0xFu; }
#define XB_SPIN(cond, bar) do { unsigned _sp = 0; while (cond) { __builtin_amdgcn_s_sleep(1); \
    if ((++_sp & 255u) == 0u) { if (xb_ld(&(bar)[XB_TMO])) break; if (_sp > XB_SPIN_CAP) { atomicAdd(&(bar)[XB_TMO], 1u); break; } } } } while (0)

struct XcdBarrier {
    unsigned* bar; unsigned x;
    volatile LAS unsigned* st;
};

__device__ __forceinline__ XcdBarrier xcd_barrier_post(unsigned* bar, volatile LAS unsigned* st) {
    XcdBarrier b; b.bar = bar; b.x = xb_xcc_id(); b.st = st;
    if (threadIdx.x == 0) (void)xb_add(&bar[XB_XCNT(b.x)], 1u);
    return b;
}
__device__ __forceinline__ void xcd_barrier_complete(unsigned* bar, unsigned x, unsigned& nloc, unsigned& nx) {
    const unsigned G = gridDim.x * gridDim.y * gridDim.z;
    unsigned sum, cnt, mine, sp = 0u;
    for (;;) {
        sum = 0u; cnt = 0u; mine = 0u;
#pragma unroll
        for (unsigned j = 0; j < 16; ++j) { const unsigned c = xb_ld(&bar[XB_XCNT(j)]); sum += c; cnt += (c > 0u) ? 1u : 0u; mine = (j == x) ? c : mine; }
        if (sum == G) break;
        __builtin_amdgcn_s_sleep(1);
        if ((++sp & 255u) == 0u) { if (xb_ld(&bar[XB_TMO])) break; if (sp > XB_SPIN_CAP) { atomicAdd(&bar[XB_TMO], 1u); break; } }
    }
    nloc = mine > 0u ? mine : 1u; nx = cnt > 0u ? cnt : 1u;
}

__device__ __forceinline__ void xcd_barrier(const XcdBarrier& b) {
    asm volatile("s_waitcnt vmcnt(0)" ::: "memory");
    __syncthreads();
    if (threadIdx.x == 0) {
        unsigned* bar = b.bar;
        __builtin_amdgcn_s_waitcnt(0);
        unsigned nloc = b.st[0], nx = b.st[1];
        if (nloc == 0u) { xcd_barrier_complete(bar, b.x, nloc, nx); b.st[0] = nloc; b.st[1] = nx; }
        const unsigned old = xb_add(&bar[XB_XSUB(b.x)], 1u);
        const unsigned gen = old / nloc;
        if (old + 1u == (gen + 1u) * nloc) {
            __builtin_amdgcn_fence(__ATOMIC_RELEASE, "agent");
            asm volatile("s_waitcnt vmcnt(0)" ::: "memory");
            const unsigned og = xb_add(&bar[XB_TOP], 1u);
            const unsigned tg = og / nx;
            if (og + 1u == (tg + 1u) * nx) xb_add(&bar[XB_TOPGEN], 1u);
            else XB_SPIN(xb_ld(&bar[XB_TOPGEN]) == tg, bar);
            __builtin_amdgcn_fence(__ATOMIC_ACQUIRE, "agent");
            xb_add(&bar[XB_XGEN(b.x)], 1u);
            asm volatile("s_waitcnt vmcnt(0)" ::: "memory");
        } else {
            XB_SPIN(xb_ld(&bar[XB_XGEN(b.x)]) == gen, bar);
            __builtin_amdgcn_fence(__ATOMIC_ACQUIRE, "agent");
            asm volatile("s_waitcnt vmcnt(0)" ::: "memory");
        }
    }
    __syncthreads();
}

constexpr int NWAVES = 8;
#ifndef REP_M2
#define REP_M2 1
#endif
#ifndef REP_M13
#define REP_M13 1
#endif
#ifndef REP_P0
#define REP_P0 1
#endif
#ifndef REP_P2
#define REP_P2 1
#endif
#ifndef REP_P3
#define REP_P3 1
#endif
#ifndef REP_BAR
#define REP_BAR 1
#endif
#ifndef REP_SCAN
#define REP_SCAN 1
#endif
#ifndef REP_P1
#define REP_P1 1
#endif
using pg8::RMS_EPS;
constexpr int BATCH = 8, T = 2048, D = 1024, FF = 2816, M = BATCH * T, NP = 3072;
constexpr int C_Q = 0, C_KC = 512, C_VC = 640, C_KS = 768, C_VS = 896, C_KW = 1024, C_VW = 1152, C_GQ = 1280, C_GK = 1536, C_GV = 1792, C_GR = 2304, C_GN = 2816, C_GA = 2840;
constexpr int SRC_NIN = 2856;
constexpr size_t MiB = 1u << 20;
constexpr size_t WS_CTL = 0, CTL_ZERO_BYTES = 1 * MiB;
constexpr size_t WS_W1GU = 1 * MiB, WS_W1D = 12 * MiB, WS_WIN = 18 * MiB, WS_WOUT = 24 * MiB, WS_W2GU = 26 * MiB, WS_W2D = 37 * MiB;
constexpr size_t WS_WC1K = 43 * MiB, WS_WC1V = 43 * MiB + 512 * 1024;
constexpr size_t WS_WC2K = 44 * MiB, WS_WC2V = 44 * MiB + 16384, WS_CBIAS = 44 * MiB + 32768  , WS_KC = 44 * MiB + 65536, WS_VTC = 44 * MiB + 65536 + 262144;
constexpr size_t WS_SSQ0 = 45 * MiB, WS_SSQA = 46 * MiB, WS_SSQB = 47 * MiB, WS_DEC = 48 * MiB;
constexpr size_t WS_XB = 50 * MiB;
constexpr size_t WS_R = 82 * MiB;
constexpr size_t WS_MIX = 178 * MiB, WS_VTS = 210 * MiB, WS_VTW = 214 * MiB, WS_ST = 218 * MiB, WS_BG = 234 * MiB  , WS_END = 250 * MiB;
constexpr int CW_BAR = 4096;
constexpr int RING_OFF = 0, RING_BYTES = 131072, LDSCTL_OFF = RING_BYTES, MISC_OFF = LDSCTL_OFF + 320, LDS_BYTES = 147456;

typedef unsigned u32x2 __attribute__((ext_vector_type(2)));
typedef float f32x2_t __attribute__((ext_vector_type(2))); typedef __bf16 bf16x2_t __attribute__((ext_vector_type(2)));
__device__ __forceinline__ unsigned cvtpk(float lo, float hi) { f32x2_t v = {lo, hi}; bf16x2_t b = __builtin_convertvector(v, bf16x2_t); return __builtin_bit_cast(unsigned, b); }
__device__ __forceinline__ bf16 f2b(float x) { return (bf16)(cvtpk(x, 0.f) & 0xffffu); }
__device__ __forceinline__ float bf2f(bf16 h) { return __builtin_bit_cast(float, (unsigned)h << 16); }
__device__ __forceinline__ float blo(unsigned w) { return __builtin_bit_cast(float, w << 16); }
__device__ __forceinline__ float bhi(unsigned w) { return __builtin_bit_cast(float, w & 0xffff0000u); }
__device__ __forceinline__ float fexp(float x) { return __builtin_amdgcn_exp2f(x * 1.4426950408889634f); }
__device__ __forceinline__ bf16x8 pack8(f32x4 a, f32x4 b) { v4u w; w.x = cvtpk(a[0], a[1]); w.y = cvtpk(a[2], a[3]); w.z = cvtpk(b[0], b[1]); w.w = cvtpk(b[2], b[3]); return __builtin_bit_cast(bf16x8, w); }
__device__ __forceinline__ bf16x8 ld2x8(const bf16* p0, const bf16* p1) { const u32x2 a = *(const u32x2*)p0, b = *(const u32x2*)p1; v4u w; w.x = a.x; w.y = a.y; w.z = b.x; w.w = b.y; return __builtin_bit_cast(bf16x8, w); }
__device__ __forceinline__ bf16x8 ldb16(const void* ub, unsigned boff) { return *(const bf16x8*)((const char*)ub + boff); }
__device__ __forceinline__ bf16x8 ldb8x2(const void* ub, unsigned boff) { const u32x2 a = *(const u32x2*)((const char*)ub + boff), b = *(const u32x2*)((const char*)ub + boff + 32); v4u w; w.x = a.x; w.y = a.y; w.z = b.x; w.w = b.y; return __builtin_bit_cast(bf16x8, w); }
__device__ __forceinline__ float ldb_bf(const void* ub, unsigned boff) { return bf2f(*(const bf16*)((const char*)ub + boff)); }
#define OPAQUE(x) asm volatile("" : "+v"(x))
#define MFMA16(a, b, c) __builtin_amdgcn_mfma_f32_16x16x32_bf16((a), (b), (c), 0, 0, 0)
#define WAVE_LDS_FENCE() asm volatile("s_waitcnt lgkmcnt(0)" ::: "memory")

struct Frame {
    LAS unsigned char* lds;
    volatile LAS unsigned* MISC;
    gu32* ctl;
    int tid, lane, wave, vcu, G;
    const float* in[22];
    float* out;
    bf16 *W1GU, *W1D, *WIN, *WOUT, *W2GU, *W2D, *WC1K, *WC1V, *WC2K, *WC2V, *KC, *VTC, *XB, *H, *PROJ, *MIX, *VTS, *VTW, *ST;
    float *CBIAS, *SSQ0, *SSQA, *SSQB, *DEC, *KVT, *BG;
};

__device__ __forceinline__ float wave_sum(float v) {
#pragma unroll
    for (int o = 1; o < 64; o <<= 1) v += __shfl_xor(v, o);
    return v;
}

__device__ __forceinline__ int win_src_col(int n) { return n < 1280 ? n : (n < 2816 ? n + 24 : (n < 2840 ? n - 1536 : (n < 2856 ? n : -1))); }
__device__ __forceinline__ void p0_tr_item(const float* W, const float* W2, const float* gain, int K, int Nsrc, int mode, bf16* WT, LAS float* scr, int kb, int nb, int lane) {
    const int k0 = 64 * kb, n0 = 32 * nb, nd = n0 + (lane & 31);
    const float* src = W; int sc = nd;
    if (mode == 1) { const int tile = nd >> 8, c = nd & 255; if (c >= 128) { src = W2; sc = tile * 128 + c - 128; } else sc = tile * 128 + c; }
    else if (mode == 2) sc = win_src_col(nd);
#pragma unroll 8
    for (int i = 0; i < 32; ++i) { const int kk = 2 * i + (lane >> 5); float v = 0.f; if (sc >= 0) v = src[(size_t)(k0 + kk) * Nsrc + sc]; if (gain) v *= gain[k0 + kk]; scr[kk * 33 + (lane & 31)] = v; }
    LDS_WAIT(); asm volatile("" ::: "memory");
    const int c = lane & 7;
#pragma unroll
    for (int j = 0; j < 4; ++j) { const int n = (lane >> 3) + 8 * j; const LAS float* s = scr + (8 * c) * 33 + n;
        v4u o; o.x = pk2(s[0 * 33], s[1 * 33]); o.y = pk2(s[2 * 33], s[3 * 33]); o.z = pk2(s[4 * 33], s[5 * 33]); o.w = pk2(s[6 * 33], s[7 * 33]);
        *(GAS v4u*)(WT + (size_t)(n0 + n) * K + k0 + 8 * c) = o; }
    LDS_WAIT(); asm volatile("" ::: "memory");
}
__device__ __forceinline__ void p0_prologue(Frame& F) {
    LAS float* scr = (LAS float*)(F.lds + RING_OFF + F.wave * 16384);
    const int gw = F.vcu * NWAVES + F.wave, NGW = F.G * NWAVES;
    constexpr int I_GU = 16 * 176, I_DN = 44 * 32, I_IN = 16 * 96, I_OUT = 16 * 32, I_C1 = 32 * 4, I_C2 = 2 * 2;
    constexpr int NITEMS = 2 * I_GU + 2 * I_DN + I_IN + I_OUT + 2 * I_C1 + 2 * I_C2;
    for (int it = gw; it < NITEMS; it += NGW) {
        int r = it;
        if (r < I_GU) { p0_tr_item(F.in[2], F.in[3], F.in[1], 1024, FF, 1, F.W1GU, scr, r / 176, r % 176, F.lane); continue; } r -= I_GU;
        if (r < I_GU) { p0_tr_item(F.in[18], F.in[19], F.in[17], 1024, FF, 1, F.W2GU, scr, r / 176, r % 176, F.lane); continue; } r -= I_GU;
        if (r < I_DN) { p0_tr_item(F.in[4], nullptr, nullptr, FF, 1024, 0, F.W1D, scr, r / 32, r % 32, F.lane); continue; } r -= I_DN;
        if (r < I_DN) { p0_tr_item(F.in[20], nullptr, nullptr, FF, 1024, 0, F.W2D, scr, r / 32, r % 32, F.lane); continue; } r -= I_DN;
        if (r < I_IN) { p0_tr_item(F.in[6], nullptr, F.in[5], 1024, SRC_NIN, 2, F.WIN, scr, r / 96, r % 96, F.lane); continue; } r -= I_IN;
        if (r < I_OUT) { p0_tr_item(F.in[16], nullptr, nullptr, 1024, 1024, 0, F.WOUT, scr, r / 32, r % 32, F.lane); continue; } r -= I_OUT;
        if (r < I_C1) { p0_tr_item(F.in[8], nullptr, nullptr, 2048, 128, 0, F.WC1K, scr, r / 4, r % 4, F.lane); continue; } r -= I_C1;
        if (r < I_C1) { p0_tr_item(F.in[11], nullptr, nullptr, 2048, 128, 0, F.WC1V, scr, r / 4, r % 4, F.lane); continue; } r -= I_C1;
        if (r < I_C2) { p0_tr_item(F.in[9], nullptr, nullptr, 128, 64, 0, F.WC2K, scr, r / 2, r % 2, F.lane); continue; } r -= I_C2;
        p0_tr_item(F.in[12], nullptr, nullptr, 128, 64, 0, F.WC2V, scr, r / 2, r % 2, F.lane);
    }
    for (int m = gw; m < M; m += NGW) {
        const GAS f32x4* xr = (const GAS f32x4*)(F.in[0] + (size_t)m * D) + F.lane;
        f32x4 v[4]; float s = 0.f;
#pragma unroll
        for (int j = 0; j < 4; ++j) { v[j] = xr[64 * j]; s += (v[j].x * v[j].x + v[j].y * v[j].y) + (v[j].z * v[j].z + v[j].w * v[j].w); }
        s = wave_sum(s);
        if (F.lane == 0) F.SSQ0[m] = s;
        GAS unsigned long long* o8 = (GAS unsigned long long*)(F.XB + (size_t)m * D) + F.lane;
#pragma unroll
        for (int j = 0; j < 4; ++j) o8[64 * j] = (unsigned long long)cvtpk(v[j].x, v[j].y) | ((unsigned long long)cvtpk(v[j].z, v[j].w) << 32);
    }
    for (int it = gw; it < 64; it += NGW) {
        const int kv = it >> 5, ch = it & 31; const float* W = (kv ? F.in[11] : F.in[8]) + (size_t)ch * 64 * 128 + F.lane; const float* pe = (kv ? F.in[10] : F.in[7]) + ch * 64;
        float s0 = 0.f, s1 = 0.f;
#pragma unroll 16
        for (int k = 0; k < 64; ++k) { const float p = pe[k]; s0 += p * W[k * 128]; s1 += p * W[k * 128 + 64]; }
        F.CBIAS[(kv * 32 + ch) * 128 + F.lane] = s0; F.CBIAS[(kv * 32 + ch) * 128 + 64 + F.lane] = s1;
    }
}

__device__ __forceinline__ void m1_compress(Frame& F, int ci) {
    const int kv = ci >> 7, b = (ci >> 4) & 7, g = (ci >> 3) & 1, rg = ci & 7;
    const int lane = F.lane, q = lane & 15, gl = lane >> 4, w = F.wave;
    LAS float* red = (LAS float*)(F.lds + RING_OFF);
    LAS bf16* hidb = (LAS bf16*)(F.lds + RING_OFF + 65536);
    const bf16* W1 = kv ? F.WC1V : F.WC1K; const bf16* W2 = kv ? F.WC2V : F.WC2K;
    const int ccol = (kv ? C_VC : C_KC) + g * 64;
    f32x4 acc[8];
#pragma unroll
    for (int nt = 0; nt < 8; ++nt) acc[nt] = (f32x4){0.f, 0.f, 0.f, 0.f};
#pragma unroll
    for (int ks = 0; ks < 8; ++ks) {
        const int l = 4 * w + (ks >> 1), dbase = 32 * (ks & 1) + 8 * gl;
        int tok = 16 * (16 * rg + q) + l; tok = tok > T - 1 ? T - 1 : tok;
        const bf16x8 a = *(const bf16x8*)(F.PROJ + ((size_t)b * T + tok) * NP + ccol + dbase);
        const int kg = 64 * l + dbase;
#pragma unroll
        for (int nt = 0; nt < 8; ++nt) { const bf16x8 bw = *(const bf16x8*)(W1 + (size_t)(16 * nt + q) * 2048 + kg); acc[nt] = MFMA16(a, bw, acc[nt]); }
    }
#pragma unroll
    for (int nt = 0; nt < 8; ++nt)
#pragma unroll
        for (int reg = 0; reg < 4; ++reg) red[(w * 16 + 4 * gl + reg) * 128 + 16 * nt + q] = acc[nt][reg];
    __syncthreads();
    {
        const int idx = F.tid * 4, r = idx >> 7, n = idx & 127;
        f32x4 s = (f32x4){0.f, 0.f, 0.f, 0.f};
#pragma unroll 8
        for (int ch = 0; ch < 32; ++ch) s += *(const f32x4*)(F.CBIAS + (kv * 32 + ch) * 128 + n);
#pragma unroll
        for (int ww = 0; ww < 8; ++ww) s += *(const LAS f32x4*)(red + (ww * 16 + r) * 128 + n);
        float o[4];
#pragma unroll
        for (int i = 0; i < 4; ++i) { const float x = s[i]; const float u2 = 2.0f * 0.7978845608028654f * (x + 0.044715f * x * x * x);
            const float th = 1.0f - 2.0f * __builtin_amdgcn_rcpf(fexp(u2) + 1.0f); o[i] = 0.5f * x * (1.0f + th); }
        u32x2 pw; pw.x = cvtpk(o[0], o[1]); pw.y = cvtpk(o[2], o[3]);
        *(LAS u32x2*)(hidb + r * 136 + n) = pw;
    }
    __syncthreads();
    if (w < 4) {
        f32x4 a2 = (f32x4){0.f, 0.f, 0.f, 0.f};
#pragma unroll
        for (int ks = 0; ks < 4; ++ks) { const bf16x8 a = *(const LAS bf16x8*)(hidb + q * 136 + 32 * ks + 8 * gl);
            const bf16x8 bw = *(const bf16x8*)(W2 + (size_t)(16 * w + q) * 128 + 32 * ks + 8 * gl); a2 = MFMA16(a, bw, a2); }
        const int d = 16 * w + q;
#pragma unroll
        for (int reg = 0; reg < 4; ++reg) { const int i = 16 * rg + 4 * gl + reg; const bf16 val = (i <= 126) ? f2b(a2[reg]) : (bf16)0;
            if (kv == 0) F.KC[((size_t)(b * 2 + g) * 128 + i) * 64 + d] = val; else F.VTC[((size_t)(b * 2 + g) * 64 + d) * 128 + i] = val; }
    }
    __syncthreads();
}

__device__ __forceinline__ void gla_prep(Frame& F, int b, int h, int n, LAS float* bm, LAS float* seg) {
    const int tid = F.tid, d = tid & 63, sg = tid >> 6;
    const float* wa = F.in[13] + h * 64 + d;
    float w[16];
#pragma unroll
    for (int r = 0; r < 16; ++r) w[r] = wa[r * 256];
    const float ba = F.in[14][h * 64 + d];
    float c[8]; float run = 0.f;
#pragma unroll
    for (int i = 0; i < 8; ++i) {
        const size_t row = (size_t)b * T + 64 * n + 8 * sg + i;
        const bf16* gp = F.PROJ + row * NP + C_GA;
        const v4u g0 = *(const v4u*)gp, g1 = *(const v4u*)(gp + 8);
        float z = ba;
        z += blo(g0.x) * w[0] + bhi(g0.x) * w[1] + blo(g0.y) * w[2] + bhi(g0.y) * w[3] + blo(g0.z) * w[4] + bhi(g0.z) * w[5] + blo(g0.w) * w[6] + bhi(g0.w) * w[7];
        z += blo(g1.x) * w[8] + bhi(g1.x) * w[9] + blo(g1.y) * w[10] + bhi(g1.y) * w[11] + blo(g1.z) * w[12] + bhi(g1.z) * w[13] + blo(g1.w) * w[14] + bhi(g1.w) * w[15];
        const float ls = fminf(z, 0.f) - __logf(1.0f + __expf(-fabsf(z)));
        run += ls * (1.0f / 16.0f); c[i] = run;
    }
    seg[sg * 64 + d] = run; __syncthreads();
    float pre = 0.f;
#pragma unroll
    for (int s2 = 0; s2 < 7; ++s2) pre += (s2 < sg) ? seg[s2 * 64 + d] : 0.f;
#pragma unroll
    for (int i = 0; i < 8; ++i) bm[(8 * sg + i) * 65 + d] = pre + c[i];
    __syncthreads();
}
__device__ __forceinline__ void gla_load_vt(Frame& F, size_t row, int h, int j, int c8, LAS bf16* VTl) {
    const bf16* vp = F.PROJ + row * NP + C_GV + h * 128 + 16 * c8;
    const v4u v0 = *(const v4u*)vp, v1 = *(const v4u*)(vp + 8);
    LAS bf16* dst = VTl + (16 * c8) * 72 + j;
    dst[0 * 72] = (bf16)(v0.x & 0xffffu); dst[1 * 72] = (bf16)(v0.x >> 16); dst[2 * 72] = (bf16)(v0.y & 0xffffu); dst[3 * 72] = (bf16)(v0.y >> 16);
    dst[4 * 72] = (bf16)(v0.z & 0xffffu); dst[5 * 72] = (bf16)(v0.z >> 16); dst[6 * 72] = (bf16)(v0.w & 0xffffu); dst[7 * 72] = (bf16)(v0.w >> 16);
    dst[8 * 72] = (bf16)(v1.x & 0xffffu); dst[9 * 72] = (bf16)(v1.x >> 16); dst[10 * 72] = (bf16)(v1.y & 0xffffu); dst[11 * 72] = (bf16)(v1.y >> 16);
    dst[12 * 72] = (bf16)(v1.z & 0xffffu); dst[13 * 72] = (bf16)(v1.z >> 16); dst[14 * 72] = (bf16)(v1.w & 0xffffu); dst[15 * 72] = (bf16)(v1.w >> 16);
}
__device__ __forceinline__ void m1_gla_kv(Frame& F, int item) {
    const int n = item & 31, h = (item >> 5) & 3, b = item >> 7;
    const int lane = F.lane, q = lane & 15, gl = lane >> 4, w = F.wave, tid = F.tid;
    LAS float* bm = (LAS float*)(F.lds + RING_OFF); LAS float* seg = (LAS float*)(F.lds + RING_OFF + 16640);
    LAS bf16* KstT = (LAS bf16*)(F.lds + RING_OFF + 18688); LAS bf16* VTl = (LAS bf16*)(F.lds + RING_OFF + 27904);
    gla_prep(F, b, h, n, bm, seg);
    const int j = tid >> 3, c8 = tid & 7; const size_t row = (size_t)b * T + 64 * n + j;
    {
        const v4u kk = *(const v4u*)(F.PROJ + row * NP + C_GK + h * 64 + 8 * c8);
        float kf[8] = {blo(kk.x), bhi(kk.x), blo(kk.y), bhi(kk.y), blo(kk.z), bhi(kk.z), blo(kk.w), bhi(kk.w)};
#pragma unroll
        for (int i = 0; i < 8; ++i) { const int d = 8 * c8 + i; const float e = fexp(bm[63 * 65 + d] - bm[j * 65 + d]); KstT[d * 72 + j] = f2b(kf[i] * e); }
    }
    gla_load_vt(F, row, h, j, c8, VTl);
    __syncthreads();
#pragma unroll
    for (int dt = 0; dt < 4; ++dt) {
        f32x4 acc = (f32x4){0.f, 0.f, 0.f, 0.f};
#pragma unroll
        for (int ks = 0; ks < 2; ++ks) { const bf16x8 a = *(const LAS bf16x8*)(KstT + (16 * dt + q) * 72 + 32 * ks + 8 * gl);
            const bf16x8 bv = *(const LAS bf16x8*)(VTl + (16 * w + q) * 72 + 32 * ks + 8 * gl); acc = MFMA16(a, bv, acc); }
        *(f32x4*)(F.KVT + ((size_t)item * 128 + 16 * w + q) * 64 + 16 * dt + 4 * gl) = acc;
    }
    if (tid < 64) F.DEC[(size_t)item * 64 + tid] = fexp(bm[63 * 65 + tid]);
    __syncthreads();
}
typedef short v4i16_t __attribute__((ext_vector_type(4)));
__device__ __forceinline__ bf16x8 tr2(const LAS bf16* p0, const LAS bf16* p1) {
    const v4i16_t a = __builtin_amdgcn_ds_read_tr16_b64_v4i16((LAS v4i16_t*)p0), b = __builtin_amdgcn_ds_read_tr16_b64_v4i16((LAS v4i16_t*)p1);
    return (bf16x8){a[0], a[1], a[2], a[3], b[0], b[1], b[2], b[3]};
}
__device__ __forceinline__ float log_sig16(float z) { return (fminf(z, 0.f) - __logf(1.0f + __expf(-fabsf(z)))) * (1.0f / 16.0f); }
__device__ __forceinline__ void m1_gla_kv4(Frame& F, int bn) {
    const int b = bn >> 5, n = bn & 31;
    int tid = F.tid; OPAQUE(tid); const int lane = tid & 63, w = F.wave;
    LAS float* qtot = (LAS float*)(F.lds + RING_OFF);
    LAS bf16* KstL = (LAS bf16*)(F.lds + RING_OFF + 4096);
    LAS bf16* Vl = (LAS bf16*)(F.lds + RING_OFF + 4096 + 33792);
    const size_t row0 = (size_t)b * T + 64 * n;
    v4u vreg[8];
#pragma unroll
    for (int i = 0; i < 8; ++i) { const int id = tid + 512 * i; vreg[i] = *(const v4u*)(F.PROJ + (row0 + (id >> 6)) * NP + C_GV + 8 * (id & 63)); }
    const int cp = tid & 127, tq = tid >> 7, col = 2 * cp;
    float w0[16], w1[16];
#pragma unroll
    for (int r = 0; r < 16; ++r) { const f32x2_t ww = *(const f32x2_t*)(F.in[13] + r * 256 + col); w0[r] = ww.x; w1[r] = ww.y; }
    const f32x2_t bb = *(const f32x2_t*)(F.in[14] + col);
    float c0[16], c1[16]; float run0 = 0.f, run1 = 0.f;
#pragma unroll
    for (int i = 0; i < 16; ++i) {
        const bf16* gp = F.PROJ + (row0 + 16 * tq + i) * NP + C_GA;
        const v4u g0 = *(const v4u*)gp, g1 = *(const v4u*)(gp + 8);
        const float ga[16] = {blo(g0.x), bhi(g0.x), blo(g0.y), bhi(g0.y), blo(g0.z), bhi(g0.z), blo(g0.w), bhi(g0.w), blo(g1.x), bhi(g1.x), blo(g1.y), bhi(g1.y), blo(g1.z), bhi(g1.z), blo(g1.w), bhi(g1.w)};
        float z0 = bb.x, z1 = bb.y;
#pragma unroll
        for (int r = 0; r < 16; ++r) { z0 += ga[r] * w0[r]; z1 += ga[r] * w1[r]; }
        run0 += log_sig16(z0); run1 += log_sig16(z1); c0[i] = run0; c1[i] = run1;
    }
    *(LAS f32x2_t*)(qtot + tq * 256 + col) = (f32x2_t){run0, run1};
#pragma unroll
    for (int i = 0; i < 8; ++i) { const int id = tid + 512 * i; *(LAS v4u*)(Vl + (id >> 6) * 520 + 8 * (id & 63)) = vreg[i]; }
    __syncthreads();
    float pre0 = 0.f, pre1 = 0.f, tot0 = 0.f, tot1 = 0.f;
#pragma unroll
    for (int q2 = 0; q2 < 4; ++q2) { const f32x2_t a = *(const LAS f32x2_t*)(qtot + q2 * 256 + col); tot0 += a.x; tot1 += a.y; pre0 += (q2 < tq) ? a.x : 0.f; pre1 += (q2 < tq) ? a.y : 0.f; }
#pragma unroll
    for (int i = 0; i < 16; ++i) {
        const size_t row = row0 + 16 * tq + i; const float b0 = pre0 + c0[i], b1 = pre1 + c1[i];
        *(f32x2_t*)(F.BG + row * 256 + col) = (f32x2_t){b0, b1};
        const unsigned kk = *(const unsigned*)(F.PROJ + row * NP + C_GK + col);
        *(LAS unsigned*)(KstL + (16 * tq + i) * 264 + col) = cvtpk(blo(kk) * fexp(tot0 - b0), bhi(kk) * fexp(tot1 - b1));
    }
    if (tq == 0) *(f32x2_t*)(F.DEC + ((size_t)((b * 4 + (col >> 6)) * 32 + n)) * 64 + (col & 63)) = (f32x2_t){fexp(tot0), fexp(tot1)};
    __syncthreads();
    const int h = w >> 1, vh = w & 1, g = lane >> 4, il = lane & 15, qp = il >> 2, p = il & 3;
    f32x4 acc[4][4];
#pragma unroll
    for (int dt = 0; dt < 4; ++dt)
#pragma unroll
        for (int v4 = 0; v4 < 4; ++v4) acc[dt][v4] = (f32x4){0.f, 0.f, 0.f, 0.f};
#pragma unroll
    for (int ks = 0; ks < 2; ++ks) {
        bf16x8 af[4], bfr[4];
#pragma unroll
        for (int dt = 0; dt < 4; ++dt) { const LAS bf16* a0 = KstL + (32 * ks + 8 * g + qp) * 264 + h * 64 + 16 * dt + 4 * p; af[dt] = tr2(a0, a0 + 4 * 264); }
#pragma unroll
        for (int v4 = 0; v4 < 4; ++v4) { const LAS bf16* b0 = Vl + (32 * ks + 8 * g + qp) * 520 + h * 128 + 16 * (4 * vh + v4) + 4 * p; bfr[v4] = tr2(b0, b0 + 4 * 520); }
#pragma unroll
        for (int dt = 0; dt < 4; ++dt)
#pragma unroll
            for (int v4 = 0; v4 < 4; ++v4) acc[dt][v4] = MFMA16(af[dt], bfr[v4], acc[dt][v4]);
    }
    const size_t item_h = (size_t)(b * 4 + h) * 32 + n;
#pragma unroll
    for (int dt = 0; dt < 4; ++dt)
#pragma unroll
        for (int v4 = 0; v4 < 4; ++v4) *(f32x4*)(F.KVT + (item_h * 128 + 16 * (4 * vh + v4) + il) * 64 + 16 * dt + 4 * g) = acc[dt][v4];
    __syncthreads();
}
__device__ __forceinline__ void m3_gla_out2(Frame& F, int item) {
    const int hp = item & 1, bn = item >> 1, b = bn >> 5, n = bn & 31;
    int tid = F.tid; OPAQUE(tid); const int lane = tid & 63, w = F.wave;
    LAS bf16* Qin = (LAS bf16*)(F.lds + RING_OFF);
    LAS bf16* Kin = (LAS bf16*)(F.lds + RING_OFF + 18432);
    LAS bf16* Vl = (LAS bf16*)(F.lds + RING_OFF + 36864);
    const size_t row0 = (size_t)b * T + 64 * n;
    {
        const int j = tid >> 3, c8 = tid & 7; const size_t row = row0 + j;
#pragma unroll
        for (int hh = 0; hh < 2; ++hh) { const int hc = (2 * hp + hh) * 64 + 8 * c8;
            const v4u qq = *(const v4u*)(F.PROJ + row * NP + C_GQ + hc), kk = *(const v4u*)(F.PROJ + row * NP + C_GK + hc);
            const f32x4 ba = *(const f32x4*)(F.BG + row * 256 + hc), bc = *(const f32x4*)(F.BG + row * 256 + hc + 4);
            float qf[8] = {blo(qq.x), bhi(qq.x), blo(qq.y), bhi(qq.y), blo(qq.z), bhi(qq.z), blo(qq.w), bhi(qq.w)};
            float kf[8] = {blo(kk.x), bhi(kk.x), blo(kk.y), bhi(kk.y), blo(kk.z), bhi(kk.z), blo(kk.w), bhi(kk.w)};
            const float bv[8] = {ba[0], ba[1], ba[2], ba[3], bc[0], bc[1], bc[2], bc[3]};
#pragma unroll
            for (int i = 0; i < 8; ++i) { qf[i] = qf[i] * 0.125f * fexp(bv[i]); kf[i] = kf[i] * fexp(-bv[i]); }
            v4u pq, pk; pq.x = cvtpk(qf[0], qf[1]); pq.y = cvtpk(qf[2], qf[3]); pq.z = cvtpk(qf[4], qf[5]); pq.w = cvtpk(qf[6], qf[7]);
            pk.x = cvtpk(kf[0], kf[1]); pk.y = cvtpk(kf[2], kf[3]); pk.z = cvtpk(kf[4], kf[5]); pk.w = cvtpk(kf[6], kf[7]);
            *(LAS v4u*)(Qin + hh * 4608 + j * 72 + 8 * c8) = pq; *(LAS v4u*)(Kin + hh * 4608 + j * 72 + 8 * c8) = pk; }
#pragma unroll
        for (int i = 0; i < 4; ++i) { const int id = tid + 512 * i, hh = id >> 10, r = (id >> 4) & 63, ch = id & 15;
            *(LAS v4u*)(Vl + hh * 8704 + r * 136 + 8 * ch) = *(const v4u*)(F.PROJ + (row0 + r) * NP + C_GV + (2 * hp + hh) * 128 + 8 * ch); }
    }
    __syncthreads();
    const int hh = w >> 2, it = w & 3, h = 2 * hp + hh, g = lane >> 4, il = lane & 15, qp = il >> 2, p = il & 3;
    const LAS bf16* Qh = Qin + hh * 4608; const LAS bf16* Kh = Kin + hh * 4608; const LAS bf16* Vh = Vl + hh * 8704;
    const size_t item_h = (size_t)(b * 4 + h) * 32 + n;
    bf16x8 qb[2];
#pragma unroll
    for (int ks = 0; ks < 2; ++ks) qb[ks] = *(const LAS bf16x8*)(Qh + (16 * it + il) * 72 + 32 * ks + 8 * g);
    bf16x8 sf[8][2];
#pragma unroll
    for (int vt = 0; vt < 8; ++vt)
#pragma unroll
        for (int ks = 0; ks < 2; ++ks) sf[vt][ks] = *(const bf16x8*)(F.ST + (item_h * 128 + 16 * vt + il) * 64 + 32 * ks + 8 * g);
    f32x4 acc[8];
#pragma unroll
    for (int vt = 0; vt < 8; ++vt) acc[vt] = (f32x4){0.f, 0.f, 0.f, 0.f};
    const int iabs = 16 * it + il;
#pragma unroll
    for (int jp = 0; jp < 2; ++jp) {
        const int jt0 = 2 * jp, jt1 = 2 * jp + 1;
        if (jt0 <= it) {
            f32x4 c0 = (f32x4){0.f, 0.f, 0.f, 0.f}, c1 = (f32x4){0.f, 0.f, 0.f, 0.f};
#pragma unroll
            for (int ks = 0; ks < 2; ++ks) c0 = MFMA16(*(const LAS bf16x8*)(Kh + (16 * jt0 + il) * 72 + 32 * ks + 8 * g), qb[ks], c0);
            if (jt1 <= it) {
#pragma unroll
                for (int ks = 0; ks < 2; ++ks) c1 = MFMA16(*(const LAS bf16x8*)(Kh + (16 * jt1 + il) * 72 + 32 * ks + 8 * g), qb[ks], c1);
            }
#pragma unroll
            for (int reg = 0; reg < 4; ++reg) { if (16 * jt0 + 4 * g + reg > iabs) c0[reg] = 0.f; if (16 * jt1 + 4 * g + reg > iabs) c1[reg] = 0.f; }
            const bf16x8 pb = pack8(c0, c1);
#pragma unroll
            for (int vt = 0; vt < 8; ++vt) acc[vt] = MFMA16(tr2(Vh + (16 * jt0 + 4 * g + qp) * 136 + 16 * vt + 4 * p, Vh + (16 * jt1 + 4 * g + qp) * 136 + 16 * vt + 4 * p), pb, acc[vt]);
        }
    }
#pragma unroll
    for (int ks = 0; ks < 2; ++ks)
#pragma unroll
        for (int vt = 0; vt < 8; ++vt) acc[vt] = MFMA16(sf[vt][ks], qb[ks], acc[vt]);
    float ss = 0.f;
#pragma unroll
    for (int vt = 0; vt < 8; ++vt) ss += (acc[vt][0] * acc[vt][0] + acc[vt][1] * acc[vt][1]) + (acc[vt][2] * acc[vt][2] + acc[vt][3] * acc[vt][3]);
    ss += __shfl_xor(ss, 16); ss += __shfl_xor(ss, 32);
    const float rs = __builtin_amdgcn_rsqf(ss * (1.0f / 128.0f) + RMS_EPS);
    const size_t row = row0 + iabs;
#pragma unroll
    for (int vt = 0; vt < 8; ++vt) {
        const u32x2 grw = *(const u32x2*)(F.PROJ + row * NP + C_GR + h * 128 + 16 * vt + 4 * g);
        const f32x4 gg = *(const f32x4*)(F.in[15] + 16 * vt + 4 * g);
        const float gr[4] = {blo(grw.x), bhi(grw.x), blo(grw.y), bhi(grw.y)}; float o[4];
#pragma unroll
        for (int e = 0; e < 4; ++e) o[e] = acc[vt][e] * rs * gg[e] * (gr[e] * __builtin_amdgcn_rcpf(1.0f + fexp(-gr[e])));
        u32x2 wv; wv.x = cvtpk(o[0], o[1]); wv.y = cvtpk(o[2], o[3]);
        *(u32x2*)(F.MIX + row * 1024 + 512 + h * 128 + 16 * vt + 4 * g) = wv;
    }
    __syncthreads();
}
__device__ __forceinline__ void m1_transpose(Frame& F, int ti) {
    const int which = ti >> 9, rem = ti & 511, b = rem >> 6, g = (rem >> 5) & 1, tt = rem & 31;
    const bf16* src = F.PROJ + ((size_t)b * T + 64 * tt + F.lane) * NP + (which ? C_VW : C_VS) + g * 64;
    v4u x[8];
#pragma unroll
    for (int i = 0; i < 8; ++i) x[i] = *(const v4u*)(src + 8 * i);
    bf16* dst = (which ? F.VTW : F.VTS) + ((size_t)(b * 2 + g) * 64) * T + 64 * tt + F.lane;
#pragma unroll
    for (int d = 0; d < 64; ++d) { const unsigned wv = x[d >> 3][(d >> 1) & 3]; dst[(size_t)d * T] = (bf16)((d & 1) ? (wv >> 16) : (wv & 0xffffu)); }
}
__device__ __forceinline__ void m2_scan(Frame& F, int si) {
    const int bh = si >> 5, part = si & 31, qd = part * 64 + F.lane, v = qd >> 4, dq = qd & 15;
    f32x4 S = (f32x4){0.f, 0.f, 0.f, 0.f};
#pragma unroll 8
    for (int n = 0; n < 32; ++n) {
        const size_t item = (size_t)bh * 32 + n;
        const f32x4 kvv = *(const f32x4*)(F.KVT + (item * 128 + v) * 64 + 4 * dq);
        const f32x4 dc = *(const f32x4*)(F.DEC + item * 64 + 4 * dq);
        u32x2 wv; wv.x = cvtpk(S[0], S[1]); wv.y = cvtpk(S[2], S[3]);
        *(u32x2*)(F.ST + (item * 128 + v) * 64 + 4 * dq) = wv;
        S = S * dc + kvv;
    }
}
__device__ __forceinline__ void m3_gla_out(Frame& F, int item) {
    const int n = item & 31, h = (item >> 5) & 3, b = item >> 7;
    const int lane = F.lane, q = lane & 15, gl = lane >> 4, w = F.wave, tid = F.tid;
    LAS float* bm = (LAS float*)(F.lds + RING_OFF); LAS float* seg = (LAS float*)(F.lds + RING_OFF + 16640);
    LAS bf16* Qin = (LAS bf16*)(F.lds + RING_OFF + 18688); LAS bf16* Kin = (LAS bf16*)(F.lds + RING_OFF + 27904);
    LAS bf16* VTl = (LAS bf16*)(F.lds + RING_OFF + 37120); LAS bf16* Am = (LAS bf16*)(F.lds + RING_OFF + 55552);
    LAS float* ssqw = (LAS float*)(F.lds + RING_OFF + 64768);
    gla_prep(F, b, h, n, bm, seg);
    const int j = tid >> 3, c8 = tid & 7; const size_t row = (size_t)b * T + 64 * n + j;
    {
        const v4u qq = *(const v4u*)(F.PROJ + row * NP + C_GQ + h * 64 + 8 * c8);
        const v4u kk = *(const v4u*)(F.PROJ + row * NP + C_GK + h * 64 + 8 * c8);
        float qf[8] = {blo(qq.x), bhi(qq.x), blo(qq.y), bhi(qq.y), blo(qq.z), bhi(qq.z), blo(qq.w), bhi(qq.w)};
        float kf[8] = {blo(kk.x), bhi(kk.x), blo(kk.y), bhi(kk.y), blo(kk.z), bhi(kk.z), blo(kk.w), bhi(kk.w)};
#pragma unroll
        for (int i = 0; i < 8; ++i) { const float bb = bm[j * 65 + 8 * c8 + i]; qf[i] = qf[i] * 0.125f * fexp(bb); kf[i] = kf[i] * fexp(-bb); }
        v4u pq, pk; pq.x = cvtpk(qf[0], qf[1]); pq.y = cvtpk(qf[2], qf[3]); pq.z = cvtpk(qf[4], qf[5]); pq.w = cvtpk(qf[6], qf[7]);
        pk.x = cvtpk(kf[0], kf[1]); pk.y = cvtpk(kf[2], kf[3]); pk.z = cvtpk(kf[4], kf[5]); pk.w = cvtpk(kf[6], kf[7]);
        *(LAS v4u*)(Qin + j * 72 + 8 * c8) = pq; *(LAS v4u*)(Kin + j * 72 + 8 * c8) = pk;
    }
    gla_load_vt(F, row, h, j, c8, VTl);
    __syncthreads();
    {
        const int it = w >> 1;
#pragma unroll
        for (int jj = 0; jj < 2; ++jj) { const int jt = 2 * (w & 1) + jj; f32x4 a = (f32x4){0.f, 0.f, 0.f, 0.f};
            if (jt <= it) {
#pragma unroll
                for (int ks = 0; ks < 2; ++ks) a = MFMA16(*(const LAS bf16x8*)(Qin + (16 * it + q) * 72 + 32 * ks + 8 * gl), *(const LAS bf16x8*)(Kin + (16 * jt + q) * 72 + 32 * ks + 8 * gl), a);
            }
#pragma unroll
            for (int reg = 0; reg < 4; ++reg) { const int i = 16 * it + 4 * gl + reg, jx = 16 * jt + q; Am[i * 72 + jx] = (i >= jx) ? f2b(a[reg]) : (bf16)0; } }
    }
    __syncthreads();
    f32x4 acc[4];
#pragma unroll
    for (int it = 0; it < 4; ++it) acc[it] = (f32x4){0.f, 0.f, 0.f, 0.f};
#pragma unroll
    for (int ks = 0; ks < 2; ++ks) {
        const bf16x8 bv = *(const LAS bf16x8*)(VTl + (16 * w + q) * 72 + 32 * ks + 8 * gl);
        const bf16x8 bs = *(const bf16x8*)(F.ST + ((size_t)item * 128 + 16 * w + q) * 64 + 32 * ks + 8 * gl);
#pragma unroll
        for (int it = 0; it < 4; ++it) { acc[it] = MFMA16(*(const LAS bf16x8*)(Am + (16 * it + q) * 72 + 32 * ks + 8 * gl), bv, acc[it]);
            acc[it] = MFMA16(*(const LAS bf16x8*)(Qin + (16 * it + q) * 72 + 32 * ks + 8 * gl), bs, acc[it]); }
    }
#pragma unroll
    for (int it = 0; it < 4; ++it)
#pragma unroll
        for (int reg = 0; reg < 4; ++reg) { float s = acc[it][reg] * acc[it][reg]; s += __shfl_xor(s, 1); s += __shfl_xor(s, 2); s += __shfl_xor(s, 4); s += __shfl_xor(s, 8);
            if (q == 0) ssqw[w * 64 + 16 * it + 4 * gl + reg] = s; }
    __syncthreads();
    const float gg = F.in[15][16 * w + q];
#pragma unroll
    for (int it = 0; it < 4; ++it)
#pragma unroll
        for (int reg = 0; reg < 4; ++reg) { const int i = 16 * it + 4 * gl + reg; float tot = 0.f;
#pragma unroll
            for (int w2 = 0; w2 < 8; ++w2) tot += ssqw[w2 * 64 + i];
            const float rs = __builtin_amdgcn_rsqf(tot * (1.0f / 128.0f) + RMS_EPS);
            const size_t r2 = (size_t)b * T + 64 * n + i;
            const float gr = bf2f(F.PROJ[r2 * NP + C_GR + h * 128 + 16 * w + q]);
            const float sl = gr * __builtin_amdgcn_rcpf(1.0f + fexp(-gr));
            F.MIX[r2 * 1024 + 512 + h * 128 + 16 * w + q] = f2b(acc[it][reg] * rs * gg * sl); }
    __syncthreads();
}

constexpr float NSA_C2 = 0.125f * 1.4426950408889634f, NSA_THR = 8.0f;
constexpr int NSA_STAGE_BYTES = 16384, NSA_VOFF = 8192, NSA_NSTAGE = 4, NSA_KC_OFF = NSA_NSTAGE * NSA_STAGE_BYTES, NSA_VC_OFF = NSA_KC_OFF + 18432, NSA_UM_OFF = NSA_VC_OFF + 17408;
__device__ __forceinline__ bf16x8 scale8(bf16x8 x, float c) { const v4u w = __builtin_bit_cast(v4u, x); v4u o;
    o.x = cvtpk(blo(w.x) * c, bhi(w.x) * c); o.y = cvtpk(blo(w.y) * c, bhi(w.y) * c); o.z = cvtpk(blo(w.z) * c, bhi(w.z) * c); o.w = cvtpk(blo(w.w) * c, bhi(w.w) * c); return __builtin_bit_cast(bf16x8, o); }
__device__ __forceinline__ float dot8(bf16x8 a, bf16x8 b) { const v4u x = __builtin_bit_cast(v4u, a), y = __builtin_bit_cast(v4u, b);
    return ((blo(x.x) * blo(y.x) + bhi(x.x) * bhi(y.x)) + (blo(x.y) * blo(y.y) + bhi(x.y) * bhi(y.y))) + ((blo(x.z) * blo(y.z) + bhi(x.z) * bhi(y.z)) + (blo(x.w) * blo(y.w) + bhi(x.w) * bhi(y.w))); }
__device__ __forceinline__ float max3f(float a, float b, float c) { float r; asm("v_max3_f32 %0, %1, %2, %3" : "=v"(r) : "v"(a), "v"(b), "v"(c)); return r; }
struct NsaState { f32x4 O[2][4]; float m[2], l[2]; };
__device__ __forceinline__ void nsa_init(NsaState& st, const bf16x8 (&qf)[2][2], const bf16* Kself  , unsigned voK) {
    const bf16x8 k0 = ldb16(Kself, voK), k1 = ldb16(Kself + 32, voK);
#pragma unroll
    for (int r = 0; r < 2; ++r) { float s = dot8(qf[r][0], k0) + dot8(qf[r][1], k1); s += __shfl_xor(s, 16); s += __shfl_xor(s, 32); st.m[r] = s; st.l[r] = 0.f;
#pragma unroll
        for (int dt = 0; dt < 4; ++dt) st.O[r][dt] = (f32x4){0.f, 0.f, 0.f, 0.f}; }
}
__device__ __forceinline__ void nsa_tile(NsaState& st, const bf16x8 (&qf)[2][2], const float (&slope2)[2], const LAS bf16* Ks, const LAS bf16* Vs, int key0, int t, int q, int gl, bool selbit, int wlim, bool need_mask) {
#pragma unroll 1
    for (int half = 0; half < 2; ++half) {
        bf16x8 kf[2][2], vf[4];
#pragma unroll
        for (int kt = 0; kt < 2; ++kt)
#pragma unroll
            for (int ks = 0; ks < 2; ++ks) kf[kt][ks] = *(const LAS bf16x8*)((const LAS unsigned char*)Ks + (32 * half + 16 * kt + q) * 128 + 16 * ((4 * ks + gl) ^ (q >> 1)));
#pragma unroll
        for (int dt = 0; dt < 4; ++dt) { const LAS unsigned char* vr = (const LAS unsigned char*)Vs + (16 * dt + q) * 128 + 8 * (gl & 1); const int c0 = 4 * half + (gl >> 1);
            const u32x2 a = *(const LAS u32x2*)(vr + 16 * (c0 ^ (q >> 1))), c = *(const LAS u32x2*)(vr + 16 * ((c0 + 2) ^ (q >> 1)));
            v4u wv; wv.x = a.x; wv.y = a.y; wv.z = c.x; wv.w = c.y; vf[dt] = __builtin_bit_cast(bf16x8, wv); }
        const int kbase = key0 + 32 * half + 4 * gl;
        const float kb = (float)(kbase - t);
#pragma unroll
        for (int r = 0; r < 2; ++r) {
            const float c1 = selbit ? (slope2[r] * kb - st.m[r]) : -INFINITY;
            f32x4 s0, s1;
#pragma unroll
            for (int reg = 0; reg < 4; ++reg) { s0[reg] = slope2[r] * (float)reg + c1; s1[reg] = slope2[r] * (float)(16 + reg) + c1; }
            s0 = MFMA16(kf[0][0], qf[r][0], s0); s0 = MFMA16(kf[0][1], qf[r][1], s0);
            s1 = MFMA16(kf[1][0], qf[r][0], s1); s1 = MFMA16(kf[1][1], qf[r][1], s1);
            if (need_mask) {
#pragma unroll
                for (int reg = 0; reg < 4; ++reg) { const int d0 = t - (kbase + reg), d1 = d0 - 16;
                    s0[reg] = (d0 >= 0 && d0 < wlim) ? s0[reg] : -INFINITY; s1[reg] = (d1 >= 0 && d1 < wlim) ? s1[reg] : -INFINITY; }
            }
            const float lmax = max3f(max3f(s0[0], s0[1], s0[2]), max3f(s0[3], s1[0], s1[1]), max3f(s1[2], s1[3], s1[3]));
            if (__ballot(lmax > NSA_THR) != 0ull) {
                float rm = fmaxf(lmax, __shfl_xor(lmax, 16)); rm = fmaxf(rm, __shfl_xor(rm, 32));
                const float dl = fmaxf(rm, 0.f), f = __builtin_amdgcn_exp2f(-dl);
                st.m[r] += dl; st.l[r] *= f;
#pragma unroll
                for (int reg = 0; reg < 4; ++reg) { s0[reg] -= dl; s1[reg] -= dl; }
#pragma unroll
                for (int dt = 0; dt < 4; ++dt) st.O[r][dt] *= f;
            }
            float ps = 0.f;
#pragma unroll
            for (int reg = 0; reg < 4; ++reg) { s0[reg] = __builtin_amdgcn_exp2f(s0[reg]); s1[reg] = __builtin_amdgcn_exp2f(s1[reg]); ps += s0[reg] + s1[reg]; }
            st.l[r] += ps;
            const bf16x8 pb = pack8(s0, s1);
#pragma unroll
            for (int dt = 0; dt < 4; ++dt) st.O[r][dt] = MFMA16(vf[dt], pb, st.O[r][dt]);
        }
    }
}
__device__ __forceinline__ void nsa_flush(NsaState& st, f32x4 (&tot)[2][4], const bf16* Pg  , int c, unsigned voG) {
#pragma unroll
    for (int r = 0; r < 2; ++r) { float l = st.l[r]; l += __shfl_xor(l, 16); l += __shfl_xor(l, 32);
        const float gate = __builtin_amdgcn_rcpf(1.0f + fexp(-ldb_bf(Pg + r * 3 + c, voG)));
        const float sc = gate * __builtin_amdgcn_rcpf(l);
#pragma unroll
        for (int dt = 0; dt < 4; ++dt) tot[r][dt] += st.O[r][dt] * sc; }
}
__device__ __forceinline__ void m2_nsa_unit(Frame& F, int b, int g, int cur) {
    int tid = F.tid; OPAQUE(tid);
    const int lane = tid & 63, q = lane & 15, gl = lane >> 4, w = F.wave;
    const int tgi = w & 3, pair = w >> 2;
    const int t0 = 64 * cur + 16 * tgi, t = t0 + q;
    const bf16* Pr = F.PROJ + ((size_t)b * T + t0) * NP;
    const bf16* Pq = Pr + C_Q + 4 * g * 64; const bf16* Pg = Pr + C_GN + (4 * g + 2 * pair) * 3;
    LAS unsigned char* L = F.lds + RING_OFF;
    LAS unsigned* um = (LAS unsigned*)(L + NSA_UM_OFF);
    const unsigned voQ = (unsigned)(q * NP + 8 * gl) * 2u, voG = (unsigned)(q * NP) * 2u;
    const float tf = (float)t;
    const int jw0 = (cur - 8) < 0 ? 0 : (cur - 8), nwin = cur + 1 - jw0;
    const bf16* Ksg = F.PROJ + (size_t)b * T * NP + C_KS + g * 64; const bf16* Kwg = F.PROJ + (size_t)b * T * NP + C_KW + g * 64;
    const bf16* VTs = F.VTS + (size_t)(b * 2 + g) * 64 * T; const bf16* VTw = F.VTW + (size_t)(b * 2 + g) * 64 * T;
    const int srow = 8 * w + (lane >> 3), sc = (lane & 7) ^ ((srow >> 1) & 7);
    const unsigned gK = (unsigned)(srow * NP + 8 * sc) * 2u, gV = (unsigned)(srow * T + 8 * sc) * 2u;
    unsigned remF = (cur <= 7) ? ((2u << cur) - 1u) : 0u; int fi = 0;
#define NSA_ISSUE() do { int j_; const bf16 *kp_, *vp_; if (fi < nwin) { j_ = jw0 + fi; kp_ = Kwg; vp_ = VTw; } else { j_ = __builtin_ctz(remF); remF &= remF - 1u; kp_ = Ksg; vp_ = VTs; } \
        LAS unsigned char* sb_ = L + (fi & 3) * NSA_STAGE_BYTES + w * 1024; ++fi; \
        __builtin_amdgcn_global_load_lds((const unsigned*)((const char*)(kp_ + (size_t)j_ * 64 * NP) + gK), (LAS unsigned*)sb_, 16, 0, 0); \
        __builtin_amdgcn_global_load_lds((const unsigned*)((const char*)(vp_ + j_ * 64) + gV), (LAS unsigned*)(sb_ + NSA_VOFF), 16, 0, 0); } while (0)
#define NSA_WAITV(n) asm volatile("s_waitcnt vmcnt(" #n ")" ::: "memory")
#define NSA_BAR() do { asm volatile("s_waitcnt lgkmcnt(0)" ::: "memory"); __builtin_amdgcn_s_barrier(); asm volatile("" ::: "memory"); } while (0)
    NSA_ISSUE(); NSA_ISSUE();
    if (cur >= 1) NSA_ISSUE();
    {
        const bf16* KCg = F.KC + (size_t)(b * 2 + g) * 128 * 64; const bf16* VCg = F.VTC + (size_t)(b * 2 + g) * 64 * 128;
#pragma unroll
        for (int i = 0; i < 2; ++i) { const int c = tid + 512 * i;
            *(LAS v4u*)(L + NSA_KC_OFF + ((c >> 3) * 72 + 8 * (c & 7)) * 2) = *(const v4u*)(KCg + 8 * c);
            *(LAS v4u*)(L + NSA_VC_OFF + ((c >> 4) * 136 + 8 * (c & 15)) * 2) = *(const v4u*)(VCg + 8 * c); }
    }
    __syncthreads();
    f32x4 tot[2][4];
    unsigned mask;
    {
        const LAS bf16* KCs = (const LAS bf16*)(L + NSA_KC_OFF); const LAS bf16* VCs = (const LAS bf16*)(L + NSA_VC_OFF);
        f32x4 psum[8];
#pragma unroll
        for (int nt = 0; nt < 8; ++nt) psum[nt] = (f32x4){0.f, 0.f, 0.f, 0.f};
#pragma unroll 1
        for (int r = 0; r < 4; ++r) {
            int glo = gl; OPAQUE(glo);
            const bf16x8 q0 = scale8(ldb16(Pq + r * 64, voQ), NSA_C2), q1 = scale8(ldb16(Pq + r * 64 + 32, voQ), NSA_C2);
            const float sl2 = __builtin_amdgcn_exp2f(-(float)(4 * g + r + 1)) * 1.4426950408889634f;
            f32x4 S[8]; const f32x4 z = (f32x4){0.f, 0.f, 0.f, 0.f};
#pragma unroll
            for (int nt = 0; nt < 8; ++nt) { const LAS bf16* kp = KCs + (16 * nt + q) * 72 + 8 * gl; S[nt] = MFMA16(*(const LAS bf16x8*)kp, q0, z); S[nt] = MFMA16(*(const LAS bf16x8*)(kp + 32), q1, S[nt]); }
            float mx = -1e30f;
#pragma unroll
            for (int nt = 0; nt < 8; ++nt)
#pragma unroll
                for (int reg = 0; reg < 4; ++reg) { const int n = 16 * nt + 4 * glo + reg; const bool valid = (16 * n + 31 <= t);
                    const float s = S[nt][reg] - sl2 * (tf - (16.0f * (float)n + 15.5f)); S[nt][reg] = valid ? s : -1e30f; mx = fmaxf(mx, S[nt][reg]); }
            mx = fmaxf(mx, __shfl_xor(mx, 16)); mx = fmaxf(mx, __shfl_xor(mx, 32));
            float sum = 0.f;
#pragma unroll
            for (int nt = 0; nt < 8; ++nt)
#pragma unroll
                for (int reg = 0; reg < 4; ++reg) { const float p = (S[nt][reg] > -1e29f) ? __builtin_amdgcn_exp2f(S[nt][reg] - mx) : 0.f; S[nt][reg] = p; sum += p; }
            sum += __shfl_xor(sum, 16); sum += __shfl_xor(sum, 32);
            const float inv = sum > 0.f ? 1.0f / sum : 0.f;
#pragma unroll
            for (int nt = 0; nt < 8; ++nt) { S[nt] = S[nt] * inv; psum[nt] += S[nt]; }
            if ((r >> 1) == pair) {
                f32x4 oc[4];
#pragma unroll
                for (int dt = 0; dt < 4; ++dt) oc[dt] = (f32x4){0.f, 0.f, 0.f, 0.f};
#pragma unroll
                for (int kp = 0; kp < 4; ++kp) { const bf16x8 pb = pack8(S[2 * kp], S[2 * kp + 1]);
#pragma unroll
                    for (int dt = 0; dt < 4; ++dt) { const LAS bf16* vp = VCs + (16 * dt + q) * 136 + 32 * kp + 4 * gl; const u32x2 a = *(const LAS u32x2*)vp, c = *(const LAS u32x2*)(vp + 16);
                        v4u wv; wv.x = a.x; wv.y = a.y; wv.z = c.x; wv.w = c.y; oc[dt] = MFMA16(__builtin_bit_cast(bf16x8, wv), pb, oc[dt]); } }
                const float gate = __builtin_amdgcn_rcpf(1.0f + fexp(-ldb_bf(Pg + (r & 1) * 3, voG)));
                if (r & 1) {
#pragma unroll
                    for (int dt = 0; dt < 4; ++dt) tot[1][dt] = oc[dt] * gate;
                } else {
#pragma unroll
                    for (int dt = 0; dt < 4; ++dt) tot[0][dt] = oc[dt] * gate;
                }
            }
        }
        if (cur <= 7) mask = (2u << cur) - 1u;
        else {
            float v[8]; float shp = 0.f;
#pragma unroll
            for (int nt = 0; nt < 8; ++nt) { const float sh = __shfl(psum[nt][3], (lane + 48) & 63);
                const float pterm = (gl > 0) ? sh : shp; shp = sh;
                v[nt] = pterm + ((psum[nt][0] + psum[nt][1]) + (psum[nt][2] + psum[nt][3])); }
            mask = 1u | (1u << cur) | (1u << (cur - 1));
            unsigned taken = 0u;
#pragma unroll
            for (int round = 0; round < 5; ++round) {
                float bv = -1.f; int bi = 99;
#pragma unroll
                for (int i = 0; i < 8; ++i) { const int s = 4 * i + gl; const bool ok = (s >= 1) && (s <= cur - 2) && (((taken >> i) & 1u) == 0u); if (ok && v[i] > bv) { bv = v[i]; bi = s; } }
#pragma unroll
                for (int off = 16; off <= 32; off <<= 1) { const float ov = __shfl_xor(bv, off); const int oi = __shfl_xor(bi, off); if (ov > bv || (ov == bv && oi < bi)) { bv = ov; bi = oi; } }
                if (bi < 32) { mask |= 1u << bi; if ((bi & 3) == gl) taken |= 1u << (bi >> 2); }
            }
        }
    }
    unsigned wm = 0u;
#pragma unroll
    for (int j = 0; j < 32; ++j) wm |= (__ballot((mask >> j) & 1u) != 0ull) ? (1u << j) : 0u;
    if (lane == 0) um[w] = wm;
    __syncthreads();
    unsigned U = 0u;
#pragma unroll
    for (int i = 0; i < 8; ++i) U |= um[i];
    U = __builtin_amdgcn_readfirstlane(U);
    if (cur > 7) remF = U;
    const int nsel = __builtin_popcount(U), NT = nwin + nsel;
    bf16x8 qf[2][2]; float slope2[2];
#pragma unroll
    for (int r = 0; r < 2; ++r) { slope2[r] = __builtin_amdgcn_exp2f(-(float)(4 * g + 2 * pair + r + 1)) * 1.4426950408889634f;
#pragma unroll
        for (int ks = 0; ks < 2; ++ks) qf[r][ks] = scale8(ldb16(Pq + (2 * pair + r) * 64 + 32 * ks, voQ), NSA_C2); }
    NsaState st;
    const unsigned voK = (unsigned)(q * NP + 8 * gl) * 2u;
    nsa_init(st, qf, Pr + C_KW + g * 64, voK);
    unsigned remC = U;
    NSA_WAITV(0); NSA_BAR();
    for (int i = 0; i < NT; ++i) {
        if (i + 3 < NT) NSA_ISSUE();
        const LAS bf16* Ks = (const LAS bf16*)(L + (i & 3) * NSA_STAGE_BYTES); const LAS bf16* Vs = Ks + NSA_VOFF / 2;
        int key0, wlim; bool selbit, need_mask, run;
        if (i < nwin) {
            const int j = jw0 + i; key0 = 64 * j; wlim = 512; selbit = true;
            run = (key0 + 63 >= t0 - 511) && (key0 <= t0 + 15); need_mask = !(key0 >= t0 + 15 - 511 && key0 + 63 <= t0);
        } else {
            if (i == nwin) { nsa_flush(st, tot, Pg, 2, voG); nsa_init(st, qf, Pr + C_KS + g * 64, voK); }
            const int j = __builtin_ctz(remC); remC &= remC - 1u;
            selbit = ((mask >> j) & 1u) != 0u; const unsigned long long bal = __ballot(selbit);
            key0 = 64 * j; wlim = 0x7fffffff; run = (bal != 0ull); need_mask = (j == cur);
        }
#ifdef PROBE_TILE2
        if (run) { NsaState st2 = st; nsa_tile(st2, qf, slope2, Ks, Vs, key0, t, q, gl, selbit, wlim, need_mask);
#pragma unroll
            for (int r_ = 0; r_ < 2; ++r_) { asm volatile("" :: "v"(st2.m[r_]), "v"(st2.l[r_]));
#pragma unroll
                for (int d_ = 0; d_ < 4; ++d_) asm volatile("" :: "v"(st2.O[r_][d_])); } }
#endif
        if (run) nsa_tile(st, qf, slope2, Ks, Vs, key0, t, q, gl, selbit, wlim, need_mask);
        if (i + 3 < NT) NSA_WAITV(4); else if (i + 2 < NT) NSA_WAITV(2); else NSA_WAITV(0);
        NSA_BAR();
    }
    nsa_flush(st, tot, Pg, 1, voG);
    bf16* Mo = F.MIX + ((size_t)b * T + t0) * 1024 + (4 * g + 2 * pair) * 64; const unsigned voM = (unsigned)(q * 1024 + 4 * gl) * 2u;
#pragma unroll
    for (int r = 0; r < 2; ++r)
#pragma unroll
        for (int dt = 0; dt < 4; ++dt) { const f32x4 o = tot[r][dt]; u32x2 wv; wv.x = cvtpk(o[0], o[1]); wv.y = cvtpk(o[2], o[3]); *(u32x2*)((char*)(Mo + r * 64 + 16 * dt) + voM) = wv; }
#undef NSA_ISSUE
#undef NSA_WAITV
#undef NSA_BAR
}

__device__ __forceinline__ void p8_final_norm(Frame& F) {
    const int gw = F.vcu * NWAVES + F.wave, NGW = F.G * NWAVES;
    const GAS f32x4* gp = (const GAS f32x4*)F.in[21] + F.lane;
    f32x4 gv[4];
#pragma unroll
    for (int j = 0; j < 4; ++j) gv[j] = gp[64 * j];
    for (int m = gw; m < M; m += NGW) {
        GAS f32x4* xr = (GAS f32x4*)(F.out + (size_t)m * D) + F.lane;
        f32x4 v[4]; float s = 0.f;
#pragma unroll
        for (int j = 0; j < 4; ++j) { v[j] = xr[64 * j]; s += (v[j].x * v[j].x + v[j].y * v[j].y) + (v[j].z * v[j].z + v[j].w * v[j].w); }
        const float rs = __builtin_amdgcn_rsqf(wave_sum(s) * (1.0f / 1024.0f) + RMS_EPS);
#pragma unroll
        for (int j = 0; j < 4; ++j) xr[64 * j] = v[j] * rs * gv[j];
    }
}

struct Args { const float* in[22]; float* out; unsigned char* ws; };
__global__ void __launch_bounds__(NWAVES * 64, 2) hybrid_fwd(Args args) {
    extern __shared__ __attribute__((aligned(16))) unsigned char lds[];
    Frame F;
    F.lds = (LAS unsigned char*)lds;
    F.MISC = (volatile LAS unsigned*)(F.lds + MISC_OFF);
    F.tid = threadIdx.x; F.lane = F.tid & 63; F.wave = __builtin_amdgcn_readfirstlane(F.tid >> 6);
    F.G = gridDim.x; { const int bx = blockIdx.x; F.vcu = (F.G % 8 == 0) ? (bx % 8) * (F.G / 8) + bx / 8 : bx; }
    unsigned char* ws = args.ws;
    F.ctl = (gu32*)(ws + WS_CTL);
#pragma unroll
    for (int i = 0; i < 22; ++i) F.in[i] = args.in[i];
    F.out = args.out;
    F.W1GU = (bf16*)(ws + WS_W1GU); F.W1D = (bf16*)(ws + WS_W1D); F.WIN = (bf16*)(ws + WS_WIN); F.WOUT = (bf16*)(ws + WS_WOUT); F.W2GU = (bf16*)(ws + WS_W2GU); F.W2D = (bf16*)(ws + WS_W2D);
    F.WC1K = (bf16*)(ws + WS_WC1K); F.WC1V = (bf16*)(ws + WS_WC1V); F.WC2K = (bf16*)(ws + WS_WC2K); F.WC2V = (bf16*)(ws + WS_WC2V);
    F.KC = (bf16*)(ws + WS_KC); F.VTC = (bf16*)(ws + WS_VTC); F.XB = (bf16*)(ws + WS_XB); F.H = (bf16*)(ws + WS_R); F.PROJ = (bf16*)(ws + WS_R);
    F.MIX = (bf16*)(ws + WS_MIX); F.VTS = (bf16*)(ws + WS_VTS); F.VTW = (bf16*)(ws + WS_VTW); F.ST = (bf16*)(ws + WS_ST);
    F.CBIAS = (float*)(ws + WS_CBIAS); F.SSQ0 = (float*)(ws + WS_SSQ0); F.SSQA = (float*)(ws + WS_SSQA); F.SSQB = (float*)(ws + WS_SSQB); F.DEC = (float*)(ws + WS_DEC); F.KVT = args.out;     F.BG = (float*)(ws + WS_BG);
    for (int u = F.tid; u < (LDS_BYTES - LDSCTL_OFF) / 4; u += NWAVES * 64) ((LAS unsigned*)(F.lds + LDSCTL_OFF))[u] = 0u;
    __syncthreads();
    XcdBarrier bar = xcd_barrier_post((unsigned*)(F.ctl + CW_BAR), F.MISC + 8);
#define GRID_BAR() do { for (int rb_ = 0; rb_ < REP_BAR; ++rb_) xcd_barrier(bar); asm volatile("" : "+v"(F.tid)); F.lane = F.tid & 63; } while (0)
    const int gw = F.vcu * NWAVES + F.wave, NGW = F.G * NWAVES;

#ifndef NO_P0
    for (int rep = 0; rep < REP_P0; ++rep) p0_prologue(F);
#endif
    GRID_BAR();
#ifndef NO_GEMM
    { pg8::Gemm g{F.XB, F.W1GU, M, 2 * FF, D}; pg8::StaticOrder S; S.init(M, 2 * FF, F.G, (int)blockIdx.x);
      pg8::EpiSwiGLU<1> E{F.H, FF, F.SSQ0};
      for (int rep = 0; rep < REP_P1; ++rep) pg8::gemm_phase<pg8::EpiSwiGLU<1>, pg8::StaticOrder, true, true>(F.lds + RING_OFF, g, S, E); }
#endif
    GRID_BAR();
#ifndef NO_GEMM
    { pg8::Gemm g{F.H, F.W1D, M, D, FF}; pg8::StaticOrder S; S.init(M, D, F.G, (int)blockIdx.x);
      pg8::EpiResid<0> E{F.in[0], nullptr, F.XB, F.SSQA, 0.5f};
      for (int rep = 0; rep < REP_P2; ++rep) pg8::gemm_phase<pg8::EpiResid<0>, pg8::StaticOrder, true, true>(F.lds + RING_OFF, g, S, E); }
#endif
    GRID_BAR();
#ifndef NO_GEMM
    { pg8::Gemm g{F.XB, F.WIN, M, NP, D}; pg8::StaticOrder S; S.init(M, NP, F.G, (int)blockIdx.x);
      pg8::EpiProj<16> E{F.PROJ, NP, F.SSQA};
      for (int rep = 0; rep < REP_P3; ++rep) pg8::gemm_phase<pg8::EpiProj<16>, pg8::StaticOrder, true, true>(F.lds + RING_OFF, g, S, E); }
#endif
    GRID_BAR();
#ifndef NO_M1
    for (int rep = 0; rep < REP_M13; ++rep) {
    for (int ci = F.vcu; ci < 256; ci += F.G) m1_compress(F, ci);
    for (int bn = F.vcu; bn < 256; bn += F.G) m1_gla_kv4(F, bn);
    for (int ti = gw; ti < 1024; ti += NGW) m1_transpose(F, ti);
    }
#endif
    GRID_BAR();
#ifndef NO_NSA
    for (int rep = 0; rep < REP_M2; ++rep)
    for (int wi = F.vcu; wi < 256; wi += F.G) { const int b = wi >> 5, g = (wi >> 4) & 1, x = wi & 15;
#pragma unroll 1
        for (int u = 0; u < 2; ++u) m2_nsa_unit(F, b, g, u ? x : 31 - x); }
#endif
#ifndef NO_SCAN
    for (int rep = 0; rep < REP_SCAN; ++rep)
    for (int k = gw; k < 2048; k += NGW) { const int wi = k >> 3; if ((wi & 15) < 8) m2_scan(F, (((wi >> 4) * 8 + (wi & 15)) * 8) + (k & 7)); }
#endif
    GRID_BAR();
#ifndef NO_GLA3
    for (int rep = 0; rep < REP_M13; ++rep)
    for (int it = F.vcu; it < 512; it += F.G) m3_gla_out2(F, it);
#endif
    GRID_BAR();
#ifndef NO_GEMM
    { pg8::Gemm g{F.MIX, F.WOUT, M, D, D}; pg8::StaticOrder S; S.init(M, D, F.G, (int)blockIdx.x);
      pg8::EpiResid<1> E{nullptr, nullptr, F.XB, F.SSQB, 1.0f};
      pg8::gemm_phase<pg8::EpiResid<1>, pg8::StaticOrder, true, true>(F.lds + RING_OFF, g, S, E); }
#endif
    GRID_BAR();
#ifndef NO_GEMM
    { pg8::Gemm g{F.XB, F.W2GU, M, 2 * FF, D}; pg8::StaticOrder S; S.init(M, 2 * FF, F.G, (int)blockIdx.x);
      pg8::EpiSwiGLU<16> E{F.H, FF, F.SSQB};
      pg8::gemm_phase<pg8::EpiSwiGLU<16>, pg8::StaticOrder, true, true>(F.lds + RING_OFF, g, S, E); }
#endif
    GRID_BAR();
#ifndef NO_GEMM
    { pg8::Gemm g{F.H, F.W2D, M, D, FF}; pg8::StaticOrder S; S.init(M, D, F.G, (int)blockIdx.x);
      pg8::EpiResid<2> E{nullptr, F.out, F.XB, nullptr, 0.5f};
      pg8::gemm_phase<pg8::EpiResid<2>, pg8::StaticOrder, true, true>(F.lds + RING_OFF, g, S, E); }
#endif
    GRID_BAR();
#ifndef NO_P8
    p8_final_norm(F);
#endif
}

extern "C" void kernel_launch(void* const* d_in, const int* in_sizes, int n_in, void* d_out, int out_size, void* d_ws, size_t ws_size, hipStream_t stream) {
    static int grid = 0;
    if (grid == 0) {
        if (n_in != 22 || in_sizes[0] != M * D || out_size != M * D || ws_size < WS_END) { fprintf(stderr, "kernel_launch: unexpected shapes (n_in %d, in0 %d, out %d, ws %zu); nothing launched\n", n_in, n_in > 0 ? in_sizes[0] : -1, out_size, ws_size); grid = -1; return; }
        int dev = 0, cus = 0;
        if (hipGetDevice(&dev) != hipSuccess || hipDeviceGetAttribute(&cus, hipDeviceAttributeMultiprocessorCount, dev) != hipSuccess) { fprintf(stderr, "kernel_launch: device query failed\n"); grid = -1; return; }
        if (hipFuncSetAttribute((const void*)hybrid_fwd, hipFuncAttributeMaxDynamicSharedMemorySize, LDS_BYTES) != hipSuccess) { fprintf(stderr, "kernel_launch: hipFuncSetAttribute failed\n"); grid = -1; return; }
        (void)hipGetLastError();
        grid = cus;
    }
    if (grid < 0) return;
    if (hipMemsetAsync((char*)d_ws + WS_CTL, 0, CTL_ZERO_BYTES, stream) != hipSuccess) { fprintf(stderr, "kernel_launch: hipMemsetAsync failed\n"); return; }
    Args a{};
    for (int i = 0; i < 22; ++i) a.in[i] = (const float*)d_in[i];
    a.out = (float*)d_out; a.ws = (unsigned char*)d_ws;
    hipLaunchKernelGGL(hybrid_fwd, dim3(grid), dim3(NWAVES * 64), LDS_BYTES, stream, a);
}
```
